# Optimizing an MI355X kernel written in HIP

```python
import math
import numpy as np
import jax
import jax.numpy as jnp
from jax import lax


D_MODEL = 1024
BATCH = 16
SEQ = 2048
DEPTH = 2

HEAD_DIM = 64
Q_BLOCK = 128
ROPE_THETA = 10000.0
NORM_EPS = 1e-6
NEG_INF = -1e30
MACARON_WEIGHT = 0.5
FFN_DIM = 2816
MEM_LEN = 256
XA_HEADS = 4
XA_HEAD_DIM = D_MODEL // XA_HEADS

MLA_HEADS = 4
MLA_Q_LORA = 192
MLA_KV_LORA = 128
MLA_NOPE_DIM = 64
MLA_ROPE_DIM = 32
MLA_V_DIM = 64

NSA_HEADS = 4
NSA_CMP_LEN = 32
NSA_CMP_STRIDE = 16
NSA_CMP_HIDDEN = 256
NSA_SEL_LEN = 64
NSA_SEL_BLOCKS = 8
NSA_SEL_Q_BLOCK = 64
NSA_WINDOW = 256
NSA_FORCE_SCORE = 1e4

FOX_HEADS = 4

S5_WIDTH = 256
S5_GROUP = 16
S5_GROUPS = S5_WIDTH // S5_GROUP
S5_STATE = 64
S5_DT_MIN = 1e-3
S5_DT_MAX = 1e-1

N_MIXERS = 4
GROUP_WIDTH = 256
MIX_WIDTH = N_MIXERS * GROUP_WIDTH
MLA_IN = MLA_Q_LORA + MLA_KV_LORA + MLA_ROPE_DIM
NSA_IN = NSA_HEADS * HEAD_DIM + 6 * HEAD_DIM + 3 * NSA_HEADS
FOX_IN = 3 * FOX_HEADS * HEAD_DIM + FOX_HEADS
S5_IN = S5_WIDTH
IN_WIDTH = MLA_IN + NSA_IN + FOX_IN + S5_IN

kernel_name = 'hybrid_parallel_mla_nsa_fox_s5_block'


def _rmsnorm(x, g):
    xf = x.astype(jnp.float32)
    y = xf * lax.rsqrt(jnp.mean(xf * xf, axis=-1, keepdims=True) + NORM_EPS)
    return (y * g.astype(jnp.float32)).astype(x.dtype)


def _rope_tables(n, dim):
    inv = 1.0 / (ROPE_THETA ** (jnp.arange(0, dim, 2, dtype=jnp.float32) / dim))
    ang = jnp.arange(n, dtype=jnp.float32)[:, None] * inv[None, :]
    return jnp.cos(ang), jnp.sin(ang)


def _rope(x, cos, sin):
    c = cos[:, None, :].astype(x.dtype)
    s = sin[:, None, :].astype(x.dtype)
    x1, x2 = jnp.split(x, 2, axis=-1)
    return jnp.concatenate([x1 * c - x2 * s, x1 * s + x2 * c], axis=-1)


def _masked_softmax(s, mask):
    s = jnp.where(mask, s, NEG_INF)
    m = jnp.max(s, axis=-1, keepdims=True)
    e = jnp.where(mask, jnp.exp(s - m), 0.0)
    return e / jnp.maximum(jnp.sum(e, axis=-1, keepdims=True), 1e-30)


def _swiglu(x, w_gate, w_up, w_down):
    return (jax.nn.silu(x @ w_gate) * (x @ w_up)) @ w_down


def _causal_block_attention(q, k, v, scale, cum_log_f=None):
    S = q.shape[1]
    pos = jnp.arange(S)
    cum_t = None if cum_log_f is None else jnp.transpose(cum_log_f, (0, 2, 1))
    outs = []
    for i in range(S // Q_BLOCK):
        lo, hi = i * Q_BLOCK, (i + 1) * Q_BLOCK
        s = jnp.einsum('bqhd,bkhd->bhqk', q[:, lo:hi], k[:, :hi]).astype(jnp.float32) * scale
        if cum_t is not None:
            s = s + cum_t[:, :, lo:hi, None] - cum_t[:, :, None, :hi]
        mask = pos[lo:hi, None] >= pos[None, :hi]
        p = _masked_softmax(s, mask)
        outs.append(jnp.einsum('bhqk,bkhd->bqhd', p.astype(v.dtype), v[:, :hi]))
    return jnp.concatenate(outs, axis=1)


def _mla(c_q, c_kv, k_pe, q_norm_g, w_uq, kv_norm_g, w_ukv, rope):
    B, S, _ = c_q.shape
    H = MLA_HEADS
    q = (_rmsnorm(c_q, q_norm_g) @ w_uq).reshape(B, S, H, MLA_NOPE_DIM + MLA_ROPE_DIM)
    q = jnp.concatenate([q[..., :MLA_NOPE_DIM], _rope(q[..., MLA_NOPE_DIM:], *rope)], axis=-1)
    kv = (_rmsnorm(c_kv, kv_norm_g) @ w_ukv).reshape(B, S, H, MLA_NOPE_DIM + MLA_V_DIM)
    k_pe = jnp.broadcast_to(_rope(k_pe[:, :, None, :], *rope), (B, S, H, MLA_ROPE_DIM))
    k = jnp.concatenate([kv[..., :MLA_NOPE_DIM], k_pe], axis=-1)
    o = _causal_block_attention(q, k, kv[..., MLA_NOPE_DIM:], (MLA_NOPE_DIM + MLA_ROPE_DIM) ** -0.5)
    return o.reshape(B, S, H * MLA_V_DIM)


def _nsa(q, k_cmp, v_cmp, k_slc, v_slc, k_swa, v_swa, gate_logit, cmp_pos, phi_w1, phi_b1, phi_w2, gate_b, rope):
    B, S, _ = q.shape
    H, d = NSA_HEADS, HEAD_DIM
    scale = d ** -0.5
    pos = jnp.arange(S)
    q = _rope(q.reshape(B, S, H, d), *rope)

    def rope1(t):
        return _rope(t[:, :, None, :], *rope)[:, :, 0, :]

    k_cmp, k_slc, k_swa = rope1(k_cmp), rope1(k_slc), rope1(k_swa)

    n_cmp = (S - NSA_CMP_LEN) // NSA_CMP_STRIDE + 1
    blk_idx = np.arange(n_cmp)[:, None] * NSA_CMP_STRIDE + np.arange(NSA_CMP_LEN)[None, :]

    def compress(t, j):
        blocks = t[:, blk_idx] + cmp_pos[j]
        hid = jax.nn.gelu(blocks.reshape(B, n_cmp, NSA_CMP_LEN * d) @ phi_w1[j] + phi_b1[j])
        return hid @ phi_w2[j]

    kc, vc = compress(k_cmp, 0), compress(v_cmp, 1)
    cmp_end = jnp.arange(n_cmp) * NSA_CMP_STRIDE + NSA_CMP_LEN - 1
    s_c = jnp.einsum('bshd,bcd->bhsc', q, kc).astype(jnp.float32) * scale
    p_c = _masked_softmax(s_c, pos[:, None] >= cmp_end[None, :])
    o_cmp = jnp.einsum('bhsc,bcd->bshd', p_c.astype(vc.dtype), vc)

    n_blk = S // NSA_SEL_LEN
    n_sel = min(NSA_SEL_BLOCKS, n_blk)
    cs = np.arange(n_cmp) * NSA_CMP_STRIDE
    ss = np.arange(n_blk) * NSA_SEL_LEN
    overlap = ((cs[:, None] < ss[None, :] + NSA_SEL_LEN) & (cs[:, None] + NSA_CMP_LEN > ss[None, :])).astype(np.float32)
    imp = jnp.einsum('bhsc,cj->bsj', p_c, jnp.asarray(overlap))
    blk = jnp.arange(n_blk)[None, :]
    cur = (pos // NSA_SEL_LEN)[:, None]
    forced = (blk == 0) | (blk == cur) | (blk == cur - 1)
    score = jnp.where(forced, NSA_FORCE_SCORE, imp)
    score = jnp.where(blk <= cur, score, NEG_INF)
    _, sel_idx = lax.top_k(score, n_sel)

    kb = k_slc.reshape(B, n_blk, NSA_SEL_LEN, d)
    vb = v_slc.reshape(B, n_blk, NSA_SEL_LEN, d)
    nqb = S // NSA_SEL_Q_BLOCK
    q_blocks = q.reshape(B, nqb, NSA_SEL_Q_BLOCK, H, d).transpose(1, 0, 2, 3, 4)
    idx_blocks = sel_idx.reshape(B, nqb, NSA_SEL_Q_BLOCK, n_sel).transpose(1, 0, 2, 3)
    t_blocks = pos.reshape(nqb, NSA_SEL_Q_BLOCK)
    n_keys = n_sel * NSA_SEL_LEN

    def sel_attend(args):
        qb, ib, tb = args
        ks = jax.vmap(lambda kk, ii: kk[ii])(kb, ib)
        vs = jax.vmap(lambda vv, ii: vv[ii])(vb, ib)
        kpos = ib[..., None] * NSA_SEL_LEN + jnp.arange(NSA_SEL_LEN)
        mask = (kpos <= tb[None, :, None, None]).reshape(B, 1, NSA_SEL_Q_BLOCK, n_keys)
        s = jnp.einsum('bqhd,bqnld->bhqnl', qb, ks).astype(jnp.float32).reshape(B, H, NSA_SEL_Q_BLOCK, n_keys) * scale
        p = _masked_softmax(s, mask)
        return jnp.einsum('bhqm,bqmd->bqhd', p.astype(vs.dtype), vs.reshape(B, NSA_SEL_Q_BLOCK, n_keys, d))

    o_slc = lax.map(sel_attend, (q_blocks, idx_blocks, t_blocks))
    o_slc = o_slc.transpose(1, 0, 2, 3, 4).reshape(B, S, H, d)

    nqw = S // Q_BLOCK
    n_prev = NSA_WINDOW // Q_BLOCK
    pad = ((0, 0), (NSA_WINDOW, 0), (0, 0))
    kp = jnp.pad(k_swa, pad).reshape(B, nqw + n_prev, Q_BLOCK, d)
    vp = jnp.pad(v_swa, pad).reshape(B, nqw + n_prev, Q_BLOCK, d)
    kw = jnp.concatenate([kp[:, o:o + nqw] for o in range(n_prev + 1)], axis=2)
    vw = jnp.concatenate([vp[:, o:o + nqw] for o in range(n_prev + 1)], axis=2)
    qpos = pos.reshape(nqw, Q_BLOCK)
    kpos = (jnp.arange(nqw) * Q_BLOCK - NSA_WINDOW)[:, None] + jnp.arange((n_prev + 1) * Q_BLOCK)[None, :]
    kq = kpos[:, None, :]
    tq = qpos[:, :, None]
    wmask = (kq <= tq) & (kq > tq - NSA_WINDOW) & (kq >= 0)
    s_w = jnp.einsum('bnqhd,bnkd->bnhqk', q.reshape(B, nqw, Q_BLOCK, H, d), kw).astype(jnp.float32) * scale
    p_w = _masked_softmax(s_w, wmask[None, :, None])
    o_swa = jnp.einsum('bnhqk,bnkd->bnqhd', p_w.astype(vw.dtype), vw).reshape(B, S, H, d)

    g = jax.nn.sigmoid((gate_logit + gate_b).astype(jnp.float32)).reshape(B, S, 3, H)
    out = g[:, :, 0, :, None] * o_cmp + g[:, :, 1, :, None] * o_slc + g[:, :, 2, :, None] * o_swa
    return out.reshape(B, S, H * d).astype(q.dtype)


def _fox(q, k, v, f_logit, f_b):
    B, S, _ = q.shape
    shp = (B, S, FOX_HEADS, HEAD_DIM)
    log_f = jax.nn.log_sigmoid((f_logit + f_b).astype(jnp.float32))
    cum = jnp.cumsum(log_f, axis=1)
    o = _causal_block_attention(q.reshape(shp), k.reshape(shp), v.reshape(shp), HEAD_DIM ** -0.5, cum)
    return o.reshape(B, S, FOX_HEADS * HEAD_DIM)


def _s5(u, lam_re, lam_im, log_dt, b_re, b_im, c_re, c_im, d_skip, glu_w, glu_b):
    B, S, _ = u.shape
    f32 = jnp.float32
    uf = u.astype(f32).reshape(B, S, S5_GROUPS, S5_GROUP)
    dt = jnp.exp(log_dt.astype(f32))[:, None]
    lr, li = lam_re.astype(f32), lam_im.astype(f32)
    mag = jnp.exp(lr * dt)
    ar, ai = mag * jnp.cos(li * dt), mag * jnp.sin(li * dt)
    den = lr * lr + li * li
    kr = ((ar - 1.0) * lr + ai * li) / den
    ki = (ai * lr - (ar - 1.0) * li) / den
    bu_r = jnp.einsum('bsgc,gpc->bsgp', uf, b_re.astype(f32))
    bu_i = jnp.einsum('bsgc,gpc->bsgp', uf, b_im.astype(f32))
    br = kr * bu_r - ki * bu_i
    bi = kr * bu_i + ki * bu_r
    a_r = jnp.broadcast_to(ar, (1, S, S5_GROUPS, S5_STATE))
    a_i = jnp.broadcast_to(ai, (1, S, S5_GROUPS, S5_STATE))

    def combine(e1, e2):
        a1r, a1i, b1r, b1i = e1
        a2r, a2i, b2r, b2i = e2
        return (a2r * a1r - a2i * a1i, a2r * a1i + a2i * a1r,
                a2r * b1r - a2i * b1i + b2r, a2r * b1i + a2i * b1r + b2i)

    _, _, xr, xi = lax.associative_scan(combine, (a_r, a_i, br, bi), axis=1)
    y = (jnp.einsum('bsgp,gcp->bsgc', xr, c_re.astype(f32))
         - jnp.einsum('bsgp,gcp->bsgc', xi, c_im.astype(f32))
         + d_skip.astype(f32) * uf)
    y = jax.nn.gelu(y.reshape(B, S, S5_WIDTH))
    out = y * jax.nn.sigmoid(y @ glu_w.astype(f32) + glu_b.astype(f32))
    return out.astype(u.dtype)


def _token_mixing(u, w_in, mla_q_norm_g, mla_w_uq, mla_kv_norm_g, mla_w_ukv,
                  nsa_cmp_pos, nsa_phi_w1, nsa_phi_b1, nsa_phi_w2, nsa_gate_b, fox_f_b,
                  s5_lambda_re, s5_lambda_im, s5_log_dt, s5_b_re, s5_b_im, s5_c_re, s5_c_im,
                  s5_d, s5_glu_w, s5_glu_b, group_g, w_out, rope_mla, rope_nsa):
    B, S, _ = u.shape
    proj = u @ w_in
    p_mla, p_nsa, p_fox, p_s5 = jnp.split(proj, [MLA_IN, MLA_IN + NSA_IN, MLA_IN + NSA_IN + FOX_IN], axis=-1)
    c_q, c_kv, k_pe = jnp.split(p_mla, [MLA_Q_LORA, MLA_Q_LORA + MLA_KV_LORA], axis=-1)
    o_mla = _mla(c_q, c_kv, k_pe, mla_q_norm_g, mla_w_uq, mla_kv_norm_g, mla_w_ukv, rope_mla)
    nq = NSA_HEADS * HEAD_DIM
    q_n, kc, vc, ksl, vsl, kw, vw, g_n = jnp.split(p_nsa, [nq + i * HEAD_DIM for i in range(7)], axis=-1)
    o_nsa = _nsa(q_n, kc, vc, ksl, vsl, kw, vw, g_n, nsa_cmp_pos, nsa_phi_w1, nsa_phi_b1, nsa_phi_w2, nsa_gate_b, rope_nsa)
    fw = FOX_HEADS * HEAD_DIM
    q_f, k_f, v_f, f_f = jnp.split(p_fox, [fw, 2 * fw, 3 * fw], axis=-1)
    o_fox = _fox(q_f, k_f, v_f, f_f, fox_f_b)
    o_s5 = _s5(p_s5, s5_lambda_re, s5_lambda_im, s5_log_dt, s5_b_re, s5_b_im, s5_c_re, s5_c_im, s5_d, s5_glu_w, s5_glu_b)
    y = jnp.stack([o_mla, o_nsa, o_fox, o_s5], axis=2)
    y = _rmsnorm(y, group_g).reshape(B, S, MIX_WIDTH)
    return y @ w_out


def _cross_attention(h, mem_n, w_q, w_kv, w_o):
    B, S, _ = h.shape
    M = mem_n.shape[1]
    q = (h @ w_q).reshape(B, S, XA_HEADS, XA_HEAD_DIM)
    kv = (mem_n @ w_kv).reshape(B, M, 2, XA_HEADS, XA_HEAD_DIM)
    s = jnp.einsum('bshd,bmhd->bhsm', q, kv[:, :, 0]).astype(jnp.float32) * XA_HEAD_DIM ** -0.5
    p = jax.nn.softmax(s, axis=-1)
    o = jnp.einsum('bhsm,bmhd->bshd', p.astype(kv.dtype), kv[:, :, 1]).reshape(B, S, XA_HEADS * XA_HEAD_DIM)
    return o @ w_o


def setup_inputs(seed: int = 0) -> dict:
    key = jax.random.key(seed)
    ks = iter(jax.random.split(key, 64))
    f32 = jnp.float32
    L, G, P = DEPTH, S5_GROUPS, S5_STATE

    def nrm(shape, scale):
        return jax.random.normal(next(ks), shape, f32) * scale

    def gain(shape):
        return 1.0 + 0.02 * jax.random.normal(next(ks), shape, f32)

    n_idx = jnp.arange(P, dtype=f32)
    return {
        'x': nrm((BATCH, SEQ, D_MODEL), 1.0),
        'mem': nrm((BATCH, MEM_LEN, D_MODEL), 1.0),
        'ffn1_pre_g': gain((L, D_MODEL)),
        'ffn1_w_gate': nrm((L, D_MODEL, FFN_DIM), D_MODEL ** -0.5),
        'ffn1_w_up': nrm((L, D_MODEL, FFN_DIM), D_MODEL ** -0.5),
        'ffn1_w_down': nrm((L, FFN_DIM, D_MODEL), FFN_DIM ** -0.5),
        'ffn1_post_g': gain((L, D_MODEL)),
        'mix_pre_g': gain((L, D_MODEL)),
        'mix_w_in': nrm((L, D_MODEL, IN_WIDTH), D_MODEL ** -0.5),
        'mla_q_norm_g': gain((L, MLA_Q_LORA)),
        'mla_w_uq': nrm((L, MLA_Q_LORA, MLA_HEADS * (MLA_NOPE_DIM + MLA_ROPE_DIM)), MLA_Q_LORA ** -0.5),
        'mla_kv_norm_g': gain((L, MLA_KV_LORA)),
        'mla_w_ukv': nrm((L, MLA_KV_LORA, MLA_HEADS * (MLA_NOPE_DIM + MLA_V_DIM)), MLA_KV_LORA ** -0.5),
        'nsa_cmp_pos': nrm((L, 2, NSA_CMP_LEN, HEAD_DIM), 0.1),
        'nsa_phi_w1': nrm((L, 2, NSA_CMP_LEN * HEAD_DIM, NSA_CMP_HIDDEN), (NSA_CMP_LEN * HEAD_DIM) ** -0.5),
        'nsa_phi_b1': nrm((L, 2, NSA_CMP_HIDDEN), 0.02),
        'nsa_phi_w2': nrm((L, 2, NSA_CMP_HIDDEN, HEAD_DIM), NSA_CMP_HIDDEN ** -0.5),
        'nsa_gate_b': nrm((L, 3 * NSA_HEADS), 0.02),
        'fox_f_b': 2.0 + nrm((L, FOX_HEADS), 0.5),
        's5_lambda_re': -0.5 * (1.0 + nrm((L, G, P), 0.01)),
        's5_lambda_im': jnp.pi * n_idx * (1.0 + nrm((L, G, P), 0.01)),
        's5_log_dt': jax.random.uniform(next(ks), (L, G), f32, math.log(S5_DT_MIN), math.log(S5_DT_MAX)),
        's5_b_re': nrm((L, G, P, S5_GROUP), S5_GROUP ** -0.5),
        's5_b_im': nrm((L, G, P, S5_GROUP), S5_GROUP ** -0.5),
        's5_c_re': nrm((L, G, S5_GROUP, P), P ** -0.5),
        's5_c_im': nrm((L, G, S5_GROUP, P), P ** -0.5),
        's5_d': nrm((L, G, S5_GROUP), 0.1),
        's5_glu_w': nrm((L, S5_WIDTH, S5_WIDTH), S5_WIDTH ** -0.5),
        's5_glu_b': nrm((L, S5_WIDTH), 0.02),
        'mix_group_g': gain((L, N_MIXERS, GROUP_WIDTH)),
        'mix_w_out': nrm((L, MIX_WIDTH, D_MODEL), MIX_WIDTH ** -0.5),
        'mix_post_g': gain((L, D_MODEL)),
        'xa_pre_g': gain((L, D_MODEL)),
        'xa_mem_g': gain((L, D_MODEL)),
        'xa_w_q': nrm((L, D_MODEL, XA_HEADS * XA_HEAD_DIM), D_MODEL ** -0.5),
        'xa_w_kv': nrm((L, D_MODEL, 2 * XA_HEADS * XA_HEAD_DIM), D_MODEL ** -0.5),
        'xa_w_o': nrm((L, XA_HEADS * XA_HEAD_DIM, D_MODEL), (XA_HEADS * XA_HEAD_DIM) ** -0.5),
        'xa_post_g': gain((L, D_MODEL)),
        'ffn2_pre_g': gain((L, D_MODEL)),
        'ffn2_w_gate': nrm((L, D_MODEL, FFN_DIM), D_MODEL ** -0.5),
        'ffn2_w_up': nrm((L, D_MODEL, FFN_DIM), D_MODEL ** -0.5),
        'ffn2_w_down': nrm((L, FFN_DIM, D_MODEL), FFN_DIM ** -0.5),
        'ffn2_post_g': gain((L, D_MODEL)),
    }


def reference(x, mem, ffn1_pre_g, ffn1_w_gate, ffn1_w_up, ffn1_w_down, ffn1_post_g,
              mix_pre_g, mix_w_in, mla_q_norm_g, mla_w_uq, mla_kv_norm_g, mla_w_ukv,
              nsa_cmp_pos, nsa_phi_w1, nsa_phi_b1, nsa_phi_w2, nsa_gate_b, fox_f_b,
              s5_lambda_re, s5_lambda_im, s5_log_dt, s5_b_re, s5_b_im, s5_c_re, s5_c_im,
              s5_d, s5_glu_w, s5_glu_b, mix_group_g, mix_w_out, mix_post_g,
              xa_pre_g, xa_mem_g, xa_w_q, xa_w_kv, xa_w_o, xa_post_g,
              ffn2_pre_g, ffn2_w_gate, ffn2_w_up, ffn2_w_down, ffn2_post_g):
    S = x.shape[1]
    rope_mla = _rope_tables(S, MLA_ROPE_DIM)
    rope_nsa = _rope_tables(S, HEAD_DIM)
    h = x
    for l in range(DEPTH):
        u = _rmsnorm(h, ffn1_pre_g[l])
        h = h + MACARON_WEIGHT * _rmsnorm(_swiglu(u, ffn1_w_gate[l], ffn1_w_up[l], ffn1_w_down[l]), ffn1_post_g[l])

        u = _rmsnorm(h, mix_pre_g[l])
        y = _token_mixing(u, mix_w_in[l], mla_q_norm_g[l], mla_w_uq[l], mla_kv_norm_g[l], mla_w_ukv[l],
                          nsa_cmp_pos[l], nsa_phi_w1[l], nsa_phi_b1[l], nsa_phi_w2[l], nsa_gate_b[l], fox_f_b[l],
                          s5_lambda_re[l], s5_lambda_im[l], s5_log_dt[l], s5_b_re[l], s5_b_im[l],
                          s5_c_re[l], s5_c_im[l], s5_d[l], s5_glu_w[l], s5_glu_b[l],
                          mix_group_g[l], mix_w_out[l], rope_mla, rope_nsa)
        h = h + _rmsnorm(y, mix_post_g[l])

        u = _rmsnorm(h, xa_pre_g[l])
        m = _rmsnorm(mem, xa_mem_g[l])
        h = h + _rmsnorm(_cross_attention(u, m, xa_w_q[l], xa_w_kv[l], xa_w_o[l]), xa_post_g[l])

        u = _rmsnorm(h, ffn2_pre_g[l])
        h = h + MACARON_WEIGHT * _rmsnorm(_swiglu(u, ffn2_w_gate[l], ffn2_w_up[l], ffn2_w_down[l]), ffn2_post_g[l])
    return h
```

```cpp
#include <hip/hip_runtime.h>
#include <cstdio>
#include <cstdint>

#ifndef MK_ONE_LAUNCH
#define MK_ONE_LAUNCH 1
#endif
#ifndef MK_REPEAT_N
#define MK_REPEAT_N 2
#endif
#ifndef MK_STOP_PHASE
#define MK_STOP_PHASE 9999
#endif

namespace pg8 {
#define PG8_LAS __attribute__((address_space(3)))
#define PG8_GAS __attribute__((address_space(1)))
typedef unsigned short bf16_t;
typedef short bf16x8 __attribute__((ext_vector_type(8)));
typedef float f32x4 __attribute__((ext_vector_type(4)));
typedef unsigned u32x4 __attribute__((ext_vector_type(4)));
constexpr int BM = 256, BK = 64, HALF = 128, HTB = HALF * BK * 2  , STAGE_BYTES = 8 * HTB, NXCD = 8, WGM = 8;

__host__ __device__ __forceinline__ int lds_byte(int r, int c) { const int st = (r >> 4) * 2 + (c >> 5), rr = r & 15, cc = c & 31, ob = rr * 64 + cc * 2; return st * 1024 + (ob ^ (((ob >> 9) & 1) << 5)); }
__host__ __device__ __forceinline__ void stage_rc(int b, int& R, int& C) { const int st = b / 1024, sb = b % 1024, swz = sb ^ (((sb >> 9) & 1) << 5); R = (st >> 1) * 16 + swz / 64; C = (st & 1) * 32 + (swz % 64) / 2; }
__host__ __device__ __forceinline__ int perm32(int rho) { const int n = rho >> 4, i = rho & 15; return 8 * (i >> 2) + 4 * n + (i & 3); }

struct Unit { int pm, pn, par; };
template <class T, class = void> struct has_rowstage { static constexpr bool value = false; };
template <class T> struct has_rowstage<T, decltype((void)T::ROWSTAGE)> { static constexpr bool value = T::ROWSTAGE; };
template <class T, class = void> struct has_hpref { static constexpr bool value = false; };
template <class T> struct has_hpref<T, decltype((void)T::HPREF)> { static constexpr bool value = T::HPREF; };
constexpr int PF_OFF = 131072 + 1024 + 8192 + 8192;
constexpr int XR_OFF = 131072 + 1024 + 8192;
struct Gemm { const bf16_t* A; const bf16_t* Bt; int M, N, K, lda; };

struct StaticOrder {
    int nM, nN, nwg, G, c;
    __host__ __device__ void init(int M, int N, int G_, int c_) { nM = M / BM; nN = N / BM; nwg = nM * nN; G = G_; c = c_; }
    __host__ __device__ bool next(int i, Unit& u) const {
        const long L = (long)i * G + c; if (L >= nwg) return false;
        int wgid = (int)L; { const int q = nwg / NXCD, r = nwg % NXCD, xcd = wgid % NXCD, off = wgid / NXCD; wgid = (xcd < r ? xcd * (q + 1) : r * (q + 1) + (xcd - r) * q) + off; }
        const int nig = WGM * nN, gid = wgid / nig, fm = gid * WGM, gsz = (nM - fm) < WGM ? (nM - fm) : WGM;
        u.pm = fm + ((wgid % nig) % gsz); u.pn = (wgid % nig) / gsz; return true;
    }
    __device__ __forceinline__ void a_ready(const Unit&) const {}
    __device__ __forceinline__ void done(const Unit&) const {}
};
__device__ __forceinline__ unsigned cvt_pk_bf16(float lo, float hi) { unsigned r; asm volatile("v_cvt_pk_bf16_f32 %0, %1, %2" : "=v"(r) : "v"(lo), "v"(hi)); return r; }
typedef float f32x2 __attribute__((ext_vector_type(2)));
__device__ __forceinline__ float fast_sigmoid(float x) { return __builtin_amdgcn_rcpf(1.f + __expf(-x)); }
__device__ __forceinline__ float gelu_tanh(float x) { const float u = 0.7978845608028654f * (x + 0.044715f * x * x * x); return x * __builtin_amdgcn_rcpf(1.f + __expf(-2.f * u)); }
__device__ __forceinline__ float bf2f(unsigned short b) { return __builtin_bit_cast(float, (unsigned)b << 16); }
__device__ __forceinline__ float rs4l(const PG8_LAS float* XR, int lrow) { const f32x4 q = *(const PG8_LAS f32x4*)(XR + 4 * lrow); return __builtin_amdgcn_rsqf(((q[0] + q[1]) + (q[2] + q[3])) * (1.f / 1024.f) + 1e-6f); }
__device__ __forceinline__ float rs4(const float* RS4, int row) { const f32x4 q = *(const f32x4*)(RS4 + 4 * (size_t)row); return __builtin_amdgcn_rsqf(((q[0] + q[1]) + (q[2] + q[3])) * (1.f / 1024.f) + 1e-6f); }

struct BatchOrder {
    int nb, tm, tn, G, c, pn_mul, pn_add;
    __host__ __device__ void init(int nb_, int tm_, int tn_, int G_, int c_) { nb = nb_; tm = tm_; tn = tn_; G = G_; c = c_; pn_mul = tn_; pn_add = 0; }
    __host__ __device__ void init2(int nb_, int tm_, int tn_, int G_, int c_, int mul_, int add_) { nb = nb_; tm = tm_; tn = tn_; G = G_; c = c_; pn_mul = mul_; pn_add = add_; }
    __host__ __device__ __forceinline__ bool next(int i, Unit& u) const {
        const long L = (long)i * G + c; if (L >= (long)nb * tm * tn) return false;
        const int per = tm * tn, bt = (int)(L / per), r = (int)(L % per); u.pm = bt * tm + r / tn; u.pn = bt * pn_mul + pn_add + r % tn; return true;
    }
    __device__ __forceinline__ void a_ready(const Unit&) const {}
    __device__ __forceinline__ void done(const Unit&) const {}
};

struct EpiStoreBf16 {
    static constexpr bool PERM = true, AFTER_DRAIN = false;
    bf16_t* O; int ldc; const float* RS;
    __device__ __forceinline__ void operator()(const f32x4 (&acc)[2][2][4][2], const Unit& u, int wr, int wc, int fr, int fq) const {
        const int row0 = u.pm * BM + wr * 64 + fr, col0 = u.pn * BM + wc * 32 + 8 * fq;
        float rsv[2][4];
#pragma unroll
        for (int ai = 0; ai < 2; ++ai)
#pragma unroll
            for (int m = 0; m < 4; ++m) rsv[ai][m] = RS ? RS[row0 + ai * HALF + m * 16] : 1.f;
#pragma unroll
        for (int ai = 0; ai < 2; ++ai)
#pragma unroll
            for (int m = 0; m < 4; ++m) { const int row = row0 + ai * HALF + m * 16; bf16_t* rowp = O + (size_t)row * ldc + col0; const float rs = rsv[ai][m];
#pragma unroll
                for (int bj = 0; bj < 2; ++bj) { const f32x4 v0 = acc[ai][bj][m][0] * rs, v1 = acc[ai][bj][m][1] * rs;
                    u32x4 w; w.x = cvt_pk_bf16(v0[0], v0[1]); w.y = cvt_pk_bf16(v0[2], v0[3]); w.z = cvt_pk_bf16(v1[0], v1[1]); w.w = cvt_pk_bf16(v1[2], v1[3]);
                    *(u32x4*)(rowp + bj * HALF) = w; } }
    }
};
struct EpiStoreF32 {
    static constexpr bool PERM = true, AFTER_DRAIN = false;
    float* O; int ldc;
    __device__ __forceinline__ void operator()(const f32x4 (&acc)[2][2][4][2], const Unit& u, int wr, int wc, int fr, int fq) const {
        const int row0 = u.pm * BM + wr * 64 + fr, col0 = u.pn * BM + wc * 32 + 8 * fq;
#pragma unroll
        for (int ai = 0; ai < 2; ++ai)
#pragma unroll
            for (int m = 0; m < 4; ++m) { float* rowp = O + (size_t)(row0 + ai * HALF + m * 16) * ldc + col0;
#pragma unroll
                for (int bj = 0; bj < 2; ++bj) { *(f32x4*)(rowp + bj * HALF) = acc[ai][bj][m][0]; *(f32x4*)(rowp + bj * HALF + 4) = acc[ai][bj][m][1]; } }
    }
};
struct EpiSwiGLU {
    static constexpr bool PERM = true, AFTER_DRAIN = false;
    static constexpr bool ROWSTAGE = true;
    bf16_t* O; int ldc; const float* RS; const PG8_LAS float* XR;
    __device__ __forceinline__ void operator()(const f32x4 (&acc)[2][2][4][2], const Unit& u, int wr, int wc, int fr, int fq) const {
        const int row0 = u.pm * BM + wr * 64 + fr, col0 = u.pn * HALF + wc * 32 + 8 * fq;
        float rsv[2][4];
#pragma unroll
        for (int ai = 0; ai < 2; ++ai)
#pragma unroll
            for (int m = 0; m < 4; ++m) rsv[ai][m] = rs4l(XR + u.par * 1024, ai * HALF + wr * 64 + m * 16 + fr);
#pragma unroll
        for (int ai = 0; ai < 2; ++ai)
#pragma unroll
            for (int m = 0; m < 4; ++m) { const int row = row0 + ai * HALF + m * 16; bf16_t* rowp = O + (size_t)row * ldc + col0; const float rs = rsv[ai][m];
                float r[8];
#pragma unroll
                for (int n = 0; n < 2; ++n)
#pragma unroll
                    for (int e = 0; e < 4; ++e) { const float g = acc[ai][0][m][n][e] * rs, up = acc[ai][1][m][n][e] * rs; r[n * 4 + e] = g * fast_sigmoid(g) * up; }
                u32x4 w; w.x = cvt_pk_bf16(r[0], r[1]); w.y = cvt_pk_bf16(r[2], r[3]); w.z = cvt_pk_bf16(r[4], r[5]); w.w = cvt_pk_bf16(r[6], r[7]);
                *(u32x4*)rowp = w; }
    }
};
struct EpiGeluBias {
    static constexpr bool PERM = true, AFTER_DRAIN = false;
    bf16_t* O; int ldc; const float* bias;
    __device__ __forceinline__ void operator()(const f32x4 (&acc)[2][2][4][2], const Unit& u, int wr, int wc, int fr, int fq) const {
        const int row0 = u.pm * BM + wr * 64 + fr, col0 = u.pn * BM + wc * 32 + 8 * fq;
#pragma unroll
        for (int bj = 0; bj < 2; ++bj) { const f32x4 b0 = *(const f32x4*)(bias + col0 + bj * HALF), b1 = *(const f32x4*)(bias + col0 + bj * HALF + 4);
#pragma unroll
            for (int ai = 0; ai < 2; ++ai)
#pragma unroll
                for (int m = 0; m < 4; ++m) { bf16_t* rowp = O + (size_t)(row0 + ai * HALF + m * 16) * ldc + col0 + bj * HALF;
                    const f32x4 v0 = acc[ai][bj][m][0] + b0, v1 = acc[ai][bj][m][1] + b1;
                    u32x4 w; w.x = cvt_pk_bf16(gelu_tanh(v0[0]), gelu_tanh(v0[1])); w.y = cvt_pk_bf16(gelu_tanh(v0[2]), gelu_tanh(v0[3]));
                    w.z = cvt_pk_bf16(gelu_tanh(v1[0]), gelu_tanh(v1[1])); w.w = cvt_pk_bf16(gelu_tanh(v1[2]), gelu_tanh(v1[3]));
                    *(u32x4*)rowp = w; } }
    }
};
struct EpiS5Loc {
    static constexpr bool PERM = true, AFTER_DRAIN = false;
    float* O;
    __device__ __forceinline__ void operator()(const f32x4 (&acc)[2][2][4][2], const Unit& u, int wr, int wc, int fr, int fq) const {
        const int g = u.pm >> 1, row0 = u.pm * BM + wr * 64 + fr, col0 = (u.pn - 5 * g) * BM + wc * 32 + 8 * fq;
#pragma unroll
        for (int ai = 0; ai < 2; ++ai)
#pragma unroll
            for (int m = 0; m < 4; ++m) { float* rowp = O + (size_t)(row0 + ai * HALF + m * 16) * 1280 + col0;
#pragma unroll
                for (int bj = 0; bj < 2; ++bj) { *(f32x4*)(rowp + bj * HALF) = acc[ai][bj][m][0]; *(f32x4*)(rowp + bj * HALF + 4) = acc[ai][bj][m][1]; } }
    }
};
struct EpiS5Carry {
    static constexpr bool PERM = true, AFTER_DRAIN = false;
    const float* YLOC; const bf16_t* US5; const float* Dv; bf16_t* YS5; int mtok;
    __device__ __forceinline__ void operator()(const f32x4 (&acc)[2][2][4][2], const Unit& u, int wr, int wc, int fr, int fq) const {
        const int g = u.pm >> 1, row0 = u.pm * BM + wr * 64 + fr, col0 = (u.pn - 4 * g) * BM + wc * 32 + 8 * fq;
        f32x4 dv[2][2];
#pragma unroll
        for (int bj = 0; bj < 2; ++bj) { const int c0 = (col0 + bj * HALF) & 15; dv[bj][0] = *(const f32x4*)(Dv + g * 16 + c0); dv[bj][1] = *(const f32x4*)(Dv + g * 16 + c0 + 4); }
        u32x4 outw[2][4][2];
#pragma unroll
        for (int ai = 0; ai < 2; ++ai)
#pragma unroll
            for (int mp = 0; mp < 4; mp += 2) {
                f32x4 yv[2][2][2]; u32x4 uu[2][2];
#pragma unroll
                for (int mm = 0; mm < 2; ++mm)
#pragma unroll
                    for (int bj = 0; bj < 2; ++bj) { const int rg = row0 + ai * HALF + (mp + mm) * 16, rl = rg - g * 512, col = col0 + bj * HALF, t = col >> 4, c0 = col & 15; const size_t tok = (size_t)rl * 64 + t;
                        yv[mm][bj][0] = *(const f32x4*)(YLOC + (size_t)rg * 1280 + col); yv[mm][bj][1] = *(const f32x4*)(YLOC + (size_t)rg * 1280 + col + 4);
                        uu[mm][bj] = *(const u32x4*)(US5 + ((size_t)g * mtok + tok) * 16 + c0); }
#pragma unroll
                for (int mm = 0; mm < 2; ++mm)
#pragma unroll
                    for (int bj = 0; bj < 2; ++bj) { const int m = mp + mm;
                        const u32x4 w4 = uu[mm][bj];
                        float uv[8]; uv[0] = bf2f(w4.x & 0xffff); uv[1] = bf2f(w4.x >> 16); uv[2] = bf2f(w4.y & 0xffff); uv[3] = bf2f(w4.y >> 16);
                        uv[4] = bf2f(w4.z & 0xffff); uv[5] = bf2f(w4.z >> 16); uv[6] = bf2f(w4.w & 0xffff); uv[7] = bf2f(w4.w >> 16);
                        float r[8];
#pragma unroll
                        for (int e = 0; e < 4; ++e) { r[e] = gelu_tanh(acc[ai][bj][m][0][e] + yv[mm][bj][0][e] + dv[bj][0][e] * uv[e]); r[4 + e] = gelu_tanh(acc[ai][bj][m][1][e] + yv[mm][bj][1][e] + dv[bj][1][e] * uv[4 + e]); }
                        u32x4 w; w.x = cvt_pk_bf16(r[0], r[1]); w.y = cvt_pk_bf16(r[2], r[3]); w.z = cvt_pk_bf16(r[4], r[5]); w.w = cvt_pk_bf16(r[6], r[7]);
                        outw[ai][m][bj] = w; }
            }
#pragma unroll
        for (int ai = 0; ai < 2; ++ai)
#pragma unroll
            for (int m = 0; m < 4; ++m)
#pragma unroll
                for (int bj = 0; bj < 2; ++bj) { const int rg = row0 + ai * HALF + m * 16, rl = rg - g * 512, col = col0 + bj * HALF, t = col >> 4, c0 = col & 15; const size_t tok = (size_t)rl * 64 + t;
                    *(u32x4*)(YS5 + tok * 256 + g * 16 + c0) = outw[ai][m][bj]; }
    }
};
struct EpiGLU {
    static constexpr bool PERM = true, AFTER_DRAIN = false;
    const bf16_t* YS5; const float* bias; bf16_t* O; int ldc, ocol;
    __device__ __forceinline__ void operator()(const f32x4 (&acc)[2][2][4][2], const Unit& u, int wr, int wc, int fr, int fq) const {
        const int row0 = u.pm * BM + wr * 64 + fr, col0 = u.pn * BM + wc * 32 + 8 * fq;
        f32x4 bv[2][2];
#pragma unroll
        for (int bj = 0; bj < 2; ++bj) { const int col = col0 + bj * HALF; bv[bj][0] = *(const f32x4*)(bias + col); bv[bj][1] = *(const f32x4*)(bias + col + 4); }
#pragma unroll
        for (int bj = 0; bj < 2; ++bj) { const int col = col0 + bj * HALF; u32x4 yy[2][4];
#pragma unroll
            for (int ai = 0; ai < 2; ++ai)
#pragma unroll
                for (int m = 0; m < 4; ++m) yy[ai][m] = *(const u32x4*)(YS5 + (size_t)(row0 + ai * HALF + m * 16) * 256 + col);
#pragma unroll
            for (int ai = 0; ai < 2; ++ai)
#pragma unroll
                for (int m = 0; m < 4; ++m) { const size_t row = (size_t)(row0 + ai * HALF + m * 16); const u32x4 uu = yy[ai][m];
                    float yv[8]; yv[0] = bf2f(uu.x & 0xffff); yv[1] = bf2f(uu.x >> 16); yv[2] = bf2f(uu.y & 0xffff); yv[3] = bf2f(uu.y >> 16);
                    yv[4] = bf2f(uu.z & 0xffff); yv[5] = bf2f(uu.z >> 16); yv[6] = bf2f(uu.w & 0xffff); yv[7] = bf2f(uu.w >> 16);
                    float r[8];
#pragma unroll
                    for (int e = 0; e < 4; ++e) { r[e] = yv[e] * fast_sigmoid(acc[ai][bj][m][0][e] + bv[bj][0][e]); r[4 + e] = yv[4 + e] * fast_sigmoid(acc[ai][bj][m][1][e] + bv[bj][1][e]); }
                    u32x4 w; w.x = cvt_pk_bf16(r[0], r[1]); w.y = cvt_pk_bf16(r[2], r[3]); w.z = cvt_pk_bf16(r[4], r[5]); w.w = cvt_pk_bf16(r[6], r[7]);
                    *(u32x4*)(O + row * ldc + ocol + col) = w; } }
    }
};

__device__ __forceinline__ unsigned long long pk4(float a, float b, float c, float d) { return (unsigned long long)cvt_pk_bf16(a, b) | ((unsigned long long)cvt_pk_bf16(c, d) << 32); }
struct EpiWin {
    static constexpr bool PERM = true, AFTER_DRAIN = false;
    static constexpr bool ROWSTAGE = true;
    bf16_t* PROJ; bf16_t* KCMP; bf16_t* VCMP; bf16_t* US5; float* LOGF; float* SSQ; float* SSKV; const float* ropeM; const float* ropeN; const float* fb; int mtok; const float* RS; const PG8_LAS float* XR;
    __device__ __forceinline__ void operator()(const f32x4 (&acc)[2][2][4][2], const Unit& u, int wr, int wc, int fr, int fq) const {
        const int row0 = u.pm * BM + wr * 64 + fr;
        float rsv[2][4];
#pragma unroll
        for (int ai = 0; ai < 2; ++ai)
#pragma unroll
            for (int m = 0; m < 4; ++m) rsv[ai][m] = rs4l(XR + u.par * 1024, ai * HALF + wr * 64 + m * 16 + fr);
        float fbv[4];
#pragma unroll
        for (int e = 0; e < 4; ++e) fbv[e] = fb[e];
#pragma unroll
        for (int bj = 0; bj < 2; ++bj) {
            const int chunk = u.pn * 8 + bj * 4 + wc, col0 = chunk * 32 + 8 * fq;
            int type = 0, hbase = 0;
            if (chunk < 10) type = 1;
            else if (chunk == 10) { type = 2; hbase = 320; }
            else if (chunk < 19) { type = 3; hbase = 352 + 64 * ((chunk - 11) >> 1); }
            else if (chunk < 21) { type = 4; hbase = 608; }
            else if (chunk < 23) type = 5;
            else if (chunk < 25) { type = 3; hbase = 736; }
            else if (chunk < 27) type = 0;
            else if (chunk < 29) { type = 3; hbase = 864; }
            else if (chunk < 55) type = 0;
            else if (chunk < 63) type = 6;
            else type = 7;
            if (type == 2 || type == 3 || type == 4) {
                const int half = (type == 2) ? 16 : 32, d0 = (col0 - hbase) >> 1;
                f32x4 csa[2][4][2];
#pragma unroll
                for (int ai = 0; ai < 2; ++ai)
#pragma unroll
                    for (int m = 0; m < 4; ++m) { const int t = (row0 + ai * HALF + m * 16) & 2047; const PG8_GAS float* tab = (const PG8_GAS float*)((type == 2) ? ropeM : ropeN) + ((size_t)t * half + d0) * 2;
                        csa[ai][m][0] = *(const PG8_GAS f32x4*)tab; csa[ai][m][1] = *(const PG8_GAS f32x4*)(tab + 4); }
#pragma unroll
                for (int ai = 0; ai < 2; ++ai) {
#pragma unroll
                    for (int m = 0; m < 4; ++m) { const int row = row0 + ai * HALF + m * 16; const float rs = rsv[ai][m]; const f32x4 v0 = acc[ai][bj][m][0] * rs, v1 = acc[ai][bj][m][1] * rs, cs0 = csa[ai][m][0], cs1 = csa[ai][m][1];
                        const float a0 = v0[0] * cs0[0] - v0[1] * cs0[1], b0 = v0[0] * cs0[1] + v0[1] * cs0[0];
                        const float a1 = v0[2] * cs0[2] - v0[3] * cs0[3], b1 = v0[2] * cs0[3] + v0[3] * cs0[2];
                        const float a2 = v1[0] * cs1[0] - v1[1] * cs1[1], b2 = v1[0] * cs1[1] + v1[1] * cs1[0];
                        const float a3 = v1[2] * cs1[2] - v1[3] * cs1[3], b3 = v1[2] * cs1[3] + v1[3] * cs1[2];
                        bf16_t* dst = (type == 4) ? KCMP + (size_t)row * 64 + d0 : PROJ + (size_t)row * 2048 + hbase + d0;
                        *(unsigned long long*)dst = pk4(a0, a1, a2, a3); *(unsigned long long*)(dst + half) = pk4(b0, b1, b2, b3); }
                }
            } else {
#pragma unroll
                for (int ai = 0; ai < 2; ++ai)
#pragma unroll
                    for (int m = 0; m < 4; ++m) {
                        const int row = row0 + ai * HALF + m * 16; const float rs = rsv[ai][m]; const f32x4 v0 = acc[ai][bj][m][0] * rs, v1 = acc[ai][bj][m][1] * rs;
                        u32x4 w; w.x = cvt_pk_bf16(v0[0], v0[1]); w.y = cvt_pk_bf16(v0[2], v0[3]); w.z = cvt_pk_bf16(v1[0], v1[1]); w.w = cvt_pk_bf16(v1[2], v1[3]);
                        if (type == 0 || type == 1) {
                            *(u32x4*)(PROJ + (size_t)row * 2048 + col0) = w;
                            if (type == 1) { float ss = (v0[0] * v0[0] + v0[1] * v0[1]) + (v0[2] * v0[2] + v0[3] * v0[3]) + (v1[0] * v1[0] + v1[1] * v1[1]) + (v1[2] * v1[2] + v1[3] * v1[3]);
                                ss += __shfl_xor(ss, 16); ss += __shfl_xor(ss, 32);
                                if (fq == 0) { if (chunk < 6) SSQ[(size_t)row * 6 + chunk] = ss; else SSKV[(size_t)row * 4 + (chunk - 6)] = ss; } }
                        } else if (type == 5) {
                            *(u32x4*)(VCMP + (size_t)row * 64 + (col0 - 672)) = w;
                        } else if (type == 6) {
                            const int cc = col0 - 1760, g = cc >> 4, c0 = cc & 15;
                            *(u32x4*)(US5 + ((size_t)g * mtok + row) * 16 + c0) = w;
                        } else {
                            if (fq < 2) *(u32x4*)(PROJ + (size_t)row * 2048 + col0) = w;
                            if (fq == 1) { const int t = row & 2047, b = row >> 11;
#pragma unroll
                                for (int e = 0; e < 4; ++e) { const float x = v1[e] + fbv[e]; LOGF[((size_t)b * 4 + e) * 2048 + t] = fminf(x, 0.f) - log1pf(__expf(-fabsf(x))); } }
                        }
                    }
            }
        }
    }
};
template <bool ROPE> struct EpiRowScale {
    static constexpr bool PERM = true, AFTER_DRAIN = false;
    bf16_t* O; int ldc; const float* SS; int nslot; float inv_dim; const float* ropeM;
    __device__ __forceinline__ void operator()(const f32x4 (&acc)[2][2][4][2], const Unit& u, int wr, int wc, int fr, int fq) const {
        const int row0 = u.pm * BM + wr * 64 + fr;
        float rsv[2][4];
#pragma unroll
        for (int ai = 0; ai < 2; ++ai)
#pragma unroll
            for (int m = 0; m < 4; ++m) { const int row = row0 + ai * HALF + m * 16; float ss = 0.f;
                for (int i = 0; i < nslot; ++i) ss += SS[(size_t)row * nslot + i];
                rsv[ai][m] = __builtin_amdgcn_rsqf(ss * inv_dim + 1e-6f); }
#pragma unroll
        for (int bj = 0; bj < 2; ++bj) {
            const int cbase = u.pn * BM + bj * HALF + wc * 32, col0 = cbase + 8 * fq, hh = cbase / 96, rel = cbase - 96 * hh;
            if (ROPE && rel == 64 && cbase < 384) {
                const int d0 = (8 * fq) >> 1;
                f32x4 csa[2][4][2];
#pragma unroll
                for (int ai = 0; ai < 2; ++ai)
#pragma unroll
                    for (int m = 0; m < 4; ++m) { const int t = (row0 + ai * HALF + m * 16) & 2047; const PG8_GAS float* tab = (const PG8_GAS float*)ropeM + ((size_t)t * 16 + d0) * 2; csa[ai][m][0] = *(const PG8_GAS f32x4*)tab; csa[ai][m][1] = *(const PG8_GAS f32x4*)(tab + 4); }
#pragma unroll
                for (int ai = 0; ai < 2; ++ai) {
#pragma unroll
                    for (int m = 0; m < 4; ++m) { const int row = row0 + ai * HALF + m * 16; const float rs = rsv[ai][m]; const f32x4 v0 = acc[ai][bj][m][0] * rs, v1 = acc[ai][bj][m][1] * rs, cs0 = csa[ai][m][0], cs1 = csa[ai][m][1];
                        const float a0 = v0[0] * cs0[0] - v0[1] * cs0[1], b0 = v0[0] * cs0[1] + v0[1] * cs0[0];
                        const float a1 = v0[2] * cs0[2] - v0[3] * cs0[3], b1 = v0[2] * cs0[3] + v0[3] * cs0[2];
                        const float a2 = v1[0] * cs1[0] - v1[1] * cs1[1], b2 = v1[0] * cs1[1] + v1[1] * cs1[0];
                        const float a3 = v1[2] * cs1[2] - v1[3] * cs1[3], b3 = v1[2] * cs1[3] + v1[3] * cs1[2];
                        bf16_t* dst = O + (size_t)row * ldc + cbase + d0;
                        *(unsigned long long*)dst = pk4(a0, a1, a2, a3); *(unsigned long long*)(dst + 16) = pk4(b0, b1, b2, b3); }
                }
            } else {
#pragma unroll
                for (int ai = 0; ai < 2; ++ai)
#pragma unroll
                    for (int m = 0; m < 4; ++m) { const int row = row0 + ai * HALF + m * 16; const float rs = rsv[ai][m]; const f32x4 v0 = acc[ai][bj][m][0] * rs, v1 = acc[ai][bj][m][1] * rs;
                        u32x4 w; w.x = cvt_pk_bf16(v0[0], v0[1]); w.y = cvt_pk_bf16(v0[2], v0[3]); w.z = cvt_pk_bf16(v1[0], v1[1]); w.w = cvt_pk_bf16(v1[2], v1[3]);
                        *(u32x4*)(O + (size_t)row * ldc + col0) = w; }
            }
        }
    }
};

struct EpiStoreScaled {
    static constexpr bool PERM = true, AFTER_DRAIN = false;
    static constexpr bool ROWSTAGE = true;
    bf16_t* O; int ldc; const float* RS; float mul; const PG8_LAS float* XR;
    __device__ __forceinline__ void operator()(const f32x4 (&acc)[2][2][4][2], const Unit& u, int wr, int wc, int fr, int fq) const {
        const int row0 = u.pm * BM + wr * 64 + fr, col0 = u.pn * BM + wc * 32 + 8 * fq;
        float rsv[2][4];
#pragma unroll
        for (int ai = 0; ai < 2; ++ai)
#pragma unroll
            for (int m = 0; m < 4; ++m) rsv[ai][m] = rs4l(XR + u.par * 1024, ai * HALF + wr * 64 + m * 16 + fr) * mul;
#pragma unroll
        for (int ai = 0; ai < 2; ++ai)
#pragma unroll
            for (int m = 0; m < 4; ++m) { const int row = row0 + ai * HALF + m * 16; bf16_t* rowp = O + (size_t)row * ldc + col0; const float rs = rsv[ai][m];
#pragma unroll
                for (int bj = 0; bj < 2; ++bj) { const f32x4 v0 = acc[ai][bj][m][0] * rs, v1 = acc[ai][bj][m][1] * rs;
                    u32x4 w; w.x = cvt_pk_bf16(v0[0], v0[1]); w.y = cvt_pk_bf16(v0[2], v0[3]); w.z = cvt_pk_bf16(v1[0], v1[1]); w.w = cvt_pk_bf16(v1[2], v1[3]);
                    *(u32x4*)(rowp + bj * HALF) = w; } }
    }
};
struct EpiKH {
    static constexpr bool PERM = true, AFTER_DRAIN = false;
    bf16_t* KH; int nrows;
    __device__ __forceinline__ void operator()(const f32x4 (&acc)[2][2][4][2], const Unit& u, int wr, int wc, int fr, int fq) const {
        const int row0 = u.pm * BM + wr * 64 + fr, col0 = wc * 32 + 8 * fq; bf16_t* base = KH + (size_t)u.pn * nrows * 256;
#pragma unroll
        for (int ai = 0; ai < 2; ++ai)
#pragma unroll
            for (int m = 0; m < 4; ++m) { bf16_t* rowp = base + (size_t)(row0 + ai * HALF + m * 16) * 256 + col0;
#pragma unroll
                for (int bj = 0; bj < 2; ++bj) { const f32x4 v0 = acc[ai][bj][m][0], v1 = acc[ai][bj][m][1];
                    u32x4 w; w.x = cvt_pk_bf16(v0[0], v0[1]); w.y = cvt_pk_bf16(v0[2], v0[3]); w.z = cvt_pk_bf16(v1[0], v1[1]); w.w = cvt_pk_bf16(v1[2], v1[3]);
                    *(u32x4*)(rowp + bj * HALF) = w; } }
    }
};
struct EpiVT {
    static constexpr bool PERM = true, AFTER_DRAIN = false;
    bf16_t* VT;
    __device__ __forceinline__ void operator()(const f32x4 (&acc)[2][2][4][2], const Unit& u, int wr, int wc, int fr, int fq) const {
        const int row0 = u.pm * BM + wr * 64 + fr, col0 = wc * 32 + 8 * fq; bf16_t* base = VT + (size_t)u.pn * 1024 * 256;
#pragma unroll
        for (int ai = 0; ai < 2; ++ai)
#pragma unroll
            for (int m = 0; m < 4; ++m) { bf16_t* rowp = base + (size_t)(row0 + ai * HALF + m * 16) * 256 + col0;
#pragma unroll
                for (int bj = 0; bj < 2; ++bj) { const f32x4 v0 = acc[ai][bj][m][0], v1 = acc[ai][bj][m][1];
                    u32x4 w; w.x = cvt_pk_bf16(v0[0], v0[1]); w.y = cvt_pk_bf16(v0[2], v0[3]); w.z = cvt_pk_bf16(v1[0], v1[1]); w.w = cvt_pk_bf16(v1[2], v1[3]);
                    *(u32x4*)(rowp + bj * HALF) = w; } }
    }
};
struct EpiSoftmaxP {
    static constexpr bool PERM = true, AFTER_DRAIN = false;
    bf16_t* O; int ldc, ocol; PG8_LAS float* XL;
    __device__ __forceinline__ void operator()(const f32x4 (&acc)[2][2][4][2], const Unit& u, int wr, int wc, int fr, int fq) const {
        const int row0 = u.pm * BM + wr * 64 + fr, col0 = wc * 32 + 8 * fq;
        PG8_LAS float* XM = XL; PG8_LAS float* XS = XL + 1024;
        float mx[2][4];
#pragma unroll
        for (int ai = 0; ai < 2; ++ai)
#pragma unroll
            for (int m = 0; m < 4; ++m) { float v = -3e38f;
#pragma unroll
                for (int bj = 0; bj < 2; ++bj)
#pragma unroll
                    for (int n = 0; n < 2; ++n)
#pragma unroll
                        for (int e = 0; e < 4; ++e) v = fmaxf(v, acc[ai][bj][m][n][e]);
                v = fmaxf(v, __shfl_xor(v, 16)); v = fmaxf(v, __shfl_xor(v, 32)); mx[ai][m] = v;
                if (fq == 0) XM[(ai * HALF + wr * 64 + m * 16 + fr) * 4 + wc] = v; }
        asm volatile("s_waitcnt lgkmcnt(0)" ::: "memory"); __builtin_amdgcn_s_barrier();
        float p[2][4][2][8], sm[2][4];
#pragma unroll
        for (int ai = 0; ai < 2; ++ai)
#pragma unroll
            for (int m = 0; m < 4; ++m) { const f32x4 q = *(const PG8_LAS f32x4*)(XM + (ai * HALF + wr * 64 + m * 16 + fr) * 4); const float mm = fmaxf(fmaxf(q[0], q[1]), fmaxf(q[2], q[3])); float sum = 0.f;
#pragma unroll
                for (int bj = 0; bj < 2; ++bj)
#pragma unroll
                    for (int n = 0; n < 2; ++n)
#pragma unroll
                        for (int e = 0; e < 4; ++e) { const float pv = __builtin_amdgcn_exp2f(acc[ai][bj][m][n][e] - mm); p[ai][m][bj][n * 4 + e] = pv; sum += pv; }
                sum += __shfl_xor(sum, 16); sum += __shfl_xor(sum, 32); sm[ai][m] = sum;
                if (fq == 0) XS[(ai * HALF + wr * 64 + m * 16 + fr) * 4 + wc] = sum; }
        asm volatile("s_waitcnt lgkmcnt(0)" ::: "memory"); __builtin_amdgcn_s_barrier();
#pragma unroll
        for (int ai = 0; ai < 2; ++ai)
#pragma unroll
            for (int m = 0; m < 4; ++m) { const f32x4 q = *(const PG8_LAS f32x4*)(XS + (ai * HALF + wr * 64 + m * 16 + fr) * 4); const float inv = __builtin_amdgcn_rcpf((q[0] + q[1]) + (q[2] + q[3]));
                bf16_t* rowp = O + (size_t)(row0 + ai * HALF + m * 16) * ldc + ocol + col0;
#pragma unroll
                for (int bj = 0; bj < 2; ++bj) { const float* pp = p[ai][m][bj];
                    u32x4 w; w.x = cvt_pk_bf16(pp[0] * inv, pp[1] * inv); w.y = cvt_pk_bf16(pp[2] * inv, pp[3] * inv); w.z = cvt_pk_bf16(pp[4] * inv, pp[5] * inv); w.w = cvt_pk_bf16(pp[6] * inv, pp[7] * inv);
                    *(u32x4*)(rowp + bj * HALF) = w; } }
        asm volatile("s_waitcnt lgkmcnt(0)" ::: "memory"); __builtin_amdgcn_s_barrier();
    }
};

struct EpiStoreCol0 {
    static constexpr bool PERM = true, AFTER_DRAIN = false;
    bf16_t* O; int ldc;
    __device__ __forceinline__ void operator()(const f32x4 (&acc)[2][2][4][2], const Unit& u, int wr, int wc, int fr, int fq) const {
        const int row0 = u.pm * BM + wr * 64 + fr, col0 = wc * 32 + 8 * fq;
#pragma unroll
        for (int ai = 0; ai < 2; ++ai)
#pragma unroll
            for (int m = 0; m < 4; ++m) { bf16_t* rowp = O + (size_t)(row0 + ai * HALF + m * 16) * ldc + col0;
#pragma unroll
                for (int bj = 0; bj < 2; ++bj) { const f32x4 v0 = acc[ai][bj][m][0], v1 = acc[ai][bj][m][1];
                    u32x4 w; w.x = cvt_pk_bf16(v0[0], v0[1]); w.y = cvt_pk_bf16(v0[2], v0[3]); w.z = cvt_pk_bf16(v1[0], v1[1]); w.w = cvt_pk_bf16(v1[2], v1[3]);
                    *(u32x4*)(rowp + bj * HALF) = w; } }
    }
};

struct EpiStoreN64 {
    static constexpr bool PERM = true, AFTER_DRAIN = false;
    bf16_t* O;
    __device__ __forceinline__ void operator()(const f32x4 (&acc)[2][2][4][2], const Unit& u, int wr, int wc, int fr, int fq) const {
        if (wc >= 2) return;
        const int row0 = u.pm * BM + wr * 64 + fr, col0 = wc * 32 + 8 * fq;
#pragma unroll
        for (int ai = 0; ai < 2; ++ai)
#pragma unroll
            for (int m = 0; m < 4; ++m) { const f32x4 v0 = acc[ai][0][m][0], v1 = acc[ai][0][m][1];
                u32x4 w; w.x = cvt_pk_bf16(v0[0], v0[1]); w.y = cvt_pk_bf16(v0[2], v0[3]); w.z = cvt_pk_bf16(v1[0], v1[1]); w.w = cvt_pk_bf16(v1[2], v1[3]);
                *(u32x4*)(O + (size_t)(row0 + ai * HALF + m * 16) * 64 + col0) = w; }
    }
};

struct EpiVWo {
    static constexpr bool PERM = true, AFTER_DRAIN = false;
    bf16_t* O; int h;
    __device__ __forceinline__ void operator()(const f32x4 (&acc)[2][2][4][2], const Unit& u, int wr, int wc, int fr, int fq) const {
        const int row0 = u.pm * BM + wr * 64 + fr, col0 = 256 * h + wc * 32 + 8 * fq; bf16_t* base = O + (size_t)u.pn * 1024 * 1024;
#pragma unroll
        for (int ai = 0; ai < 2; ++ai)
#pragma unroll
            for (int m = 0; m < 4; ++m) { bf16_t* rowp = base + (size_t)(row0 + ai * HALF + m * 16) * 1024 + col0;
#pragma unroll
                for (int bj = 0; bj < 2; ++bj) { const f32x4 v0 = acc[ai][bj][m][0], v1 = acc[ai][bj][m][1];
                    u32x4 w; w.x = cvt_pk_bf16(v0[0], v0[1]); w.y = cvt_pk_bf16(v0[2], v0[3]); w.z = cvt_pk_bf16(v1[0], v1[1]); w.w = cvt_pk_bf16(v1[2], v1[3]);
                    *(u32x4*)(rowp + bj * HALF) = w; } }
    }
};
struct EpiStoreB4 {
    static constexpr bool PERM = true, AFTER_DRAIN = false;
    bf16_t* O;
    __device__ __forceinline__ void operator()(const f32x4 (&acc)[2][2][4][2], const Unit& u, int wr, int wc, int fr, int fq) const {
        const int row0 = u.pm * BM + wr * 64 + fr, col0 = (u.pn - 4 * (u.pm >> 3)) * BM + wc * 32 + 8 * fq;
#pragma unroll
        for (int ai = 0; ai < 2; ++ai)
#pragma unroll
            for (int m = 0; m < 4; ++m) { bf16_t* rowp = O + (size_t)(row0 + ai * HALF + m * 16) * 1024 + col0;
#pragma unroll
                for (int bj = 0; bj < 2; ++bj) { const f32x4 v0 = acc[ai][bj][m][0], v1 = acc[ai][bj][m][1];
                    u32x4 w; w.x = cvt_pk_bf16(v0[0], v0[1]); w.y = cvt_pk_bf16(v0[2], v0[3]); w.z = cvt_pk_bf16(v1[0], v1[1]); w.w = cvt_pk_bf16(v1[2], v1[3]);
                    *(u32x4*)(rowp + bj * HALF) = w; } }
    }
};

struct BatchOrderCM {
    int nb, tm, tn, G, c, pn_mul, pn_add;
    __host__ __device__ void init(int nb_, int tm_, int tn_, int G_, int c_) { nb = nb_; tm = tm_; tn = tn_; G = G_; c = c_; pn_mul = tn_; pn_add = 0; }
    __host__ __device__ __forceinline__ bool next(int i, Unit& u) const {
        const long L = (long)i * G + c; if (L >= (long)nb * tm * tn) return false;
        const int per = tm * tn, bt = (int)(L / per), r = (int)(L % per); u.pm = bt * tm + r % tm; u.pn = bt * pn_mul + pn_add + r / tm; return true;
    }
    __device__ __forceinline__ void a_ready(const Unit&) const {}
    __device__ __forceinline__ void done(const Unit&) const {}
};

struct EpiNormRes {
    static constexpr bool PERM = true, AFTER_DRAIN = false;
    const bf16_t* Hin; bf16_t* Hout; float* O32; const float* gpost; float w; float* SSY; float* SSH; unsigned* cnt; PG8_LAS float* XL;
    static constexpr bool HPREF = true;
    __device__ __forceinline__ void prefetch(const Unit& u, PG8_LAS unsigned char* lds, int wid, int lane) const {
        const int ct = u.pn & 3, l0 = 2 * (wid * 64 + lane);
#pragma unroll
        for (int j = 0; j < 2; ++j) { const int ln = l0 + j; const char* p = (const char*)Hin + ((size_t)(u.pm * BM + (ln >> 2)) * 1024 + ct * BM) * 2 + (ln & 3) * 128;
            __builtin_amdgcn_global_load_lds((const unsigned*)p, (PG8_LAS unsigned*)(lds + PF_OFF + wid * 256), 4, 0, 0); }
    }
    __device__ __forceinline__ void operator()(const f32x4 (&acc)[2][2][4][2], const Unit& u, int wr, int wc, int fr, int fq) const {
        const int ct = u.pn & 3, tid = (wr * 4 + wc) * 64 + fq * 16 + fr, rloc = wr * 64 + fr;
        const int row0 = u.pm * BM + rloc, col0 = ct * BM + wc * 32 + 8 * fq;
        const unsigned eo = (unsigned)row0 * 1024u + (unsigned)col0;
        unsigned yp[2][4][2][4];
#pragma unroll
        for (int ai = 0; ai < 2; ++ai)
#pragma unroll
            for (int m = 0; m < 4; ++m) { float v = 0.f;
#pragma unroll
                for (int bj = 0; bj < 2; ++bj) {
#pragma unroll
                    for (int n = 0; n < 2; ++n)
#pragma unroll
                        for (int e = 0; e < 4; ++e) v += acc[ai][bj][m][n][e] * acc[ai][bj][m][n][e];
                    yp[ai][m][bj][0] = cvt_pk_bf16(acc[ai][bj][m][0][0], acc[ai][bj][m][0][1]); yp[ai][m][bj][1] = cvt_pk_bf16(acc[ai][bj][m][0][2], acc[ai][bj][m][0][3]);
                    yp[ai][m][bj][2] = cvt_pk_bf16(acc[ai][bj][m][1][0], acc[ai][bj][m][1][1]); yp[ai][m][bj][3] = cvt_pk_bf16(acc[ai][bj][m][1][2], acc[ai][bj][m][1][3]); }
                v += __shfl_xor(v, 16); v += __shfl_xor(v, 32);
                if (fq == 0) XL[(ai * HALF + rloc + m * 16) * 4 + wc] = v;
                __builtin_amdgcn_sched_barrier(0); }
        asm volatile("s_waitcnt lgkmcnt(0)" ::: "memory"); __builtin_amdgcn_s_barrier();
        if (tid < BM) { const f32x4 q = *(const PG8_LAS f32x4*)(XL + tid * 4); __hip_atomic_store(SSY + ((size_t)(u.pm * BM + tid) * 4 + ct), (q[0] + q[1]) + (q[2] + q[3]), __ATOMIC_RELAXED, __HIP_MEMORY_SCOPE_AGENT); }
        asm volatile("s_waitcnt vmcnt(0)" ::: "memory"); __builtin_amdgcn_s_barrier();
        if (tid == 0) (void)__hip_atomic_fetch_add(cnt + u.pm, 1u, __ATOMIC_RELAXED, __HIP_MEMORY_SCOPE_AGENT);
        __builtin_amdgcn_sched_barrier(0);
        u32x4 hh[2][4][2];
#pragma unroll
        for (int ai = 0; ai < 2; ++ai)
#pragma unroll
            for (int m = 0; m < 4; ++m)
#pragma unroll
                for (int bj = 0; bj < 2; ++bj) hh[ai][m][bj] = *(const PG8_GAS u32x4*)((const PG8_GAS char*)Hin + (size_t)(2u * (eo + (unsigned)((ai * HALF + m * 16) * 1024 + bj * HALF))));
        __builtin_amdgcn_sched_barrier(0);
        if (tid == 0) {
            unsigned* c = cnt + u.pm;
            unsigned sp = 0u;
            while (__hip_atomic_load(c, __ATOMIC_RELAXED, __HIP_MEMORY_SCOPE_AGENT) < 4u) { __builtin_amdgcn_s_sleep(1); if (++sp > (1u << 17)) break; }
        }
        __builtin_amdgcn_s_barrier();
        if (tid < BM) { const float* sp4 = SSY + (size_t)(u.pm * BM + tid) * 4;
            const float q0 = __hip_atomic_load(sp4, __ATOMIC_RELAXED, __HIP_MEMORY_SCOPE_AGENT), q1 = __hip_atomic_load(sp4 + 1, __ATOMIC_RELAXED, __HIP_MEMORY_SCOPE_AGENT);
            const float q2 = __hip_atomic_load(sp4 + 2, __ATOMIC_RELAXED, __HIP_MEMORY_SCOPE_AGENT), q3 = __hip_atomic_load(sp4 + 3, __ATOMIC_RELAXED, __HIP_MEMORY_SCOPE_AGENT);
            XL[1024 + tid] = w * __builtin_amdgcn_rsqf(((q0 + q1) + (q2 + q3)) * (1.f / 1024.f) + 1e-6f); }
        asm volatile("s_waitcnt lgkmcnt(0)" ::: "memory"); __builtin_amdgcn_s_barrier();
        f32x4 g0[2], g1[2];
#pragma unroll
        for (int bj = 0; bj < 2; ++bj) { g0[bj] = *(const PG8_GAS f32x4*)((const PG8_GAS char*)gpost + (size_t)(4u * (unsigned)(col0 + bj * HALF))); g1[bj] = *(const PG8_GAS f32x4*)((const PG8_GAS char*)gpost + (size_t)(4u * (unsigned)(col0 + bj * HALF + 4))); }
#pragma unroll
        for (int ai = 0; ai < 2; ++ai)
#pragma unroll
            for (int m = 0; m < 4; ++m) { const int rl = ai * HALF + rloc + m * 16; const float rs = XL[1024 + rl]; float sv = 0.f;
#pragma unroll
                for (int bj = 0; bj < 2; ++bj) { const u32x4 hb = hh[ai][m][bj]; const unsigned* y = yp[ai][m][bj]; const unsigned o1 = eo + (unsigned)((ai * HALF + m * 16) * 1024 + bj * HALF); float hv[8];
                    hv[0] = __builtin_bit_cast(float, hb.x << 16) + __builtin_bit_cast(float, y[0] << 16) * rs * g0[bj][0]; hv[1] = __builtin_bit_cast(float, hb.x & 0xffff0000u) + __builtin_bit_cast(float, y[0] & 0xffff0000u) * rs * g0[bj][1];
                    hv[2] = __builtin_bit_cast(float, hb.y << 16) + __builtin_bit_cast(float, y[1] << 16) * rs * g0[bj][2]; hv[3] = __builtin_bit_cast(float, hb.y & 0xffff0000u) + __builtin_bit_cast(float, y[1] & 0xffff0000u) * rs * g0[bj][3];
                    hv[4] = __builtin_bit_cast(float, hb.z << 16) + __builtin_bit_cast(float, y[2] << 16) * rs * g1[bj][0]; hv[5] = __builtin_bit_cast(float, hb.z & 0xffff0000u) + __builtin_bit_cast(float, y[2] & 0xffff0000u) * rs * g1[bj][1];
                    hv[6] = __builtin_bit_cast(float, hb.w << 16) + __builtin_bit_cast(float, y[3] << 16) * rs * g1[bj][2]; hv[7] = __builtin_bit_cast(float, hb.w & 0xffff0000u) + __builtin_bit_cast(float, y[3] & 0xffff0000u) * rs * g1[bj][3];
#pragma unroll
                    for (int e = 0; e < 8; ++e) sv += hv[e] * hv[e];
                    if (Hout) { u32x4 o; o.x = cvt_pk_bf16(hv[0], hv[1]); o.y = cvt_pk_bf16(hv[2], hv[3]); o.z = cvt_pk_bf16(hv[4], hv[5]); o.w = cvt_pk_bf16(hv[6], hv[7]); *(PG8_GAS u32x4*)((PG8_GAS char*)Hout + (size_t)(2u * o1)) = o; }
                    else { *(PG8_GAS f32x4*)((PG8_GAS char*)O32 + (size_t)(4u * o1)) = (f32x4){hv[0], hv[1], hv[2], hv[3]}; *(PG8_GAS f32x4*)((PG8_GAS char*)O32 + (size_t)(4u * o1 + 16u)) = (f32x4){hv[4], hv[5], hv[6], hv[7]}; } }
                if (SSH) { sv += __shfl_xor(sv, 16); sv += __shfl_xor(sv, 32); if (fq == 0) XL[rl * 4 + wc] = sv; } }
        asm volatile("s_waitcnt lgkmcnt(0)" ::: "memory"); __builtin_amdgcn_s_barrier();
        if (SSH && tid < BM) { const f32x4 q = *(const PG8_LAS f32x4*)(XL + tid * 4); *(PG8_GAS float*)((PG8_GAS char*)SSH + (size_t)(4u * (unsigned)((u.pm * BM + tid) * 4 + ct))) = (q[0] + q[1]) + (q[2] + q[3]); }
    }
};

struct EpiGLUNorm {
    static constexpr bool PERM = true, AFTER_DRAIN = false;
    const bf16_t* YS5; const float* bias; const float* gain; bf16_t* O; int ldc, ocol; PG8_LAS float* XL;
    __device__ __forceinline__ void operator()(const f32x4 (&acc)[2][2][4][2], const Unit& u, int wr, int wc, int fr, int fq) const {
        const int row0 = u.pm * BM + wr * 64 + fr, col0 = wc * 32 + 8 * fq;
        unsigned rp[2][4][2][4]; float ss[2][4];
#pragma unroll
        for (int ai = 0; ai < 2; ++ai)
#pragma unroll
            for (int m = 0; m < 4; ++m) ss[ai][m] = 0.f;
#pragma unroll
        for (int bj = 0; bj < 2; ++bj) { const int col = col0 + bj * HALF;
            const f32x4 b0 = *(const f32x4*)(bias + col), b1 = *(const f32x4*)(bias + col + 4);
#pragma unroll
            for (int ai = 0; ai < 2; ++ai) { u32x4 yy[4];
#pragma unroll
                for (int m = 0; m < 4; ++m) yy[m] = *(const u32x4*)(YS5 + (size_t)(row0 + ai * HALF + m * 16) * 256 + col);
#pragma unroll
                for (int m = 0; m < 4; ++m) { const u32x4 uu = yy[m];
                    float yv[8]; yv[0] = bf2f(uu.x & 0xffff); yv[1] = bf2f(uu.x >> 16); yv[2] = bf2f(uu.y & 0xffff); yv[3] = bf2f(uu.y >> 16);
                    yv[4] = bf2f(uu.z & 0xffff); yv[5] = bf2f(uu.z >> 16); yv[6] = bf2f(uu.w & 0xffff); yv[7] = bf2f(uu.w >> 16);
                    float rr[8];
#pragma unroll
                    for (int e = 0; e < 4; ++e) { rr[e] = yv[e] * fast_sigmoid(acc[ai][bj][m][0][e] + b0[e]); rr[4 + e] = yv[4 + e] * fast_sigmoid(acc[ai][bj][m][1][e] + b1[e]); }
#pragma unroll
                    for (int e = 0; e < 8; ++e) ss[ai][m] += rr[e] * rr[e];
#pragma unroll
                    for (int e = 0; e < 4; ++e) rp[ai][m][bj][e] = cvt_pk_bf16(rr[2 * e], rr[2 * e + 1]); }
                __builtin_amdgcn_sched_barrier(0); } }
#pragma unroll
        for (int ai = 0; ai < 2; ++ai)
#pragma unroll
            for (int m = 0; m < 4; ++m) { float v = ss[ai][m]; v += __shfl_xor(v, 16); v += __shfl_xor(v, 32);
                if (fq == 0) XL[(ai * HALF + wr * 64 + m * 16 + fr) * 4 + wc] = v; }
        asm volatile("s_waitcnt lgkmcnt(0)" ::: "memory"); __builtin_amdgcn_s_barrier();
#pragma unroll
        for (int bj = 0; bj < 2; ++bj) { const int col = col0 + bj * HALF; const f32x4 g0 = *(const f32x4*)(gain + col), g1 = *(const f32x4*)(gain + col + 4);
#pragma unroll
            for (int ai = 0; ai < 2; ++ai)
#pragma unroll
                for (int m = 0; m < 4; ++m) { const f32x4 q = *(const PG8_LAS f32x4*)(XL + (ai * HALF + wr * 64 + m * 16 + fr) * 4); const float rs = __builtin_amdgcn_rsqf(((q[0] + q[1]) + (q[2] + q[3])) * (1.f / 256.f) + 1e-6f);
                    const size_t row = (size_t)(row0 + ai * HALF + m * 16); const unsigned* pp = rp[ai][m][bj];
                    u32x4 w; w.x = cvt_pk_bf16(bf2f(pp[0] & 0xffff) * rs * g0[0], bf2f(pp[0] >> 16) * rs * g0[1]); w.y = cvt_pk_bf16(bf2f(pp[1] & 0xffff) * rs * g0[2], bf2f(pp[1] >> 16) * rs * g0[3]);
                    w.z = cvt_pk_bf16(bf2f(pp[2] & 0xffff) * rs * g1[0], bf2f(pp[2] >> 16) * rs * g1[1]); w.w = cvt_pk_bf16(bf2f(pp[3] & 0xffff) * rs * g1[2], bf2f(pp[3] >> 16) * rs * g1[3]);
                    *(u32x4*)(O + row * ldc + ocol + col) = w; } }
        asm volatile("s_waitcnt lgkmcnt(0)" ::: "memory"); __builtin_amdgcn_s_barrier();
    }
};
template <class Epi, class Sched, bool ALIGN_EPI = false, bool SP2 = false>
__device__ __forceinline__ void gemm_phase(PG8_LAS unsigned char* lds, const Gemm g, const Sched& S, const Epi& E) {
    int tid_op = threadIdx.x; asm volatile("" : "+v"(tid_op));
    const int tid = tid_op, wid = __builtin_amdgcn_readfirstlane(tid >> 6), lane = tid & 63, wr = wid >> 2, wc = wid & 3, fr = lane & 15, fq = lane >> 4;
    int Kop = g.K; asm volatile("" : "+s"(Kop));
    const int K = Kop, nt = K / BK;
    unsigned voffA[2], voffB[2];
#pragma unroll
    for (int i = 0; i < 2; ++i) { int R, C; stage_rc(tid * 16 + i * 8192, R, C); const int Rb = Epi::PERM ? ((R & ~31) + perm32(R & 31)) : R;
        voffA[i] = (unsigned)(R * g.lda + C) * 2u; voffB[i] = (unsigned)(Rb * K + C) * 2u; }
    const size_t kstep = (size_t)(BK * 2);
    const size_t hstepB = (size_t)HALF * K * 2, hstepA = (size_t)HALF * g.lda * 2;
    const size_t tstepA = 2 * hstepA, tstepB = 2 * hstepB;
    const unsigned ldsw = (unsigned)wid * 1024u;
    const int aoff = lds_byte(wr * 64 + fr, fq * 8), boff = lds_byte(wc * 32 + fr, fq * 8);
#define PG8_SA(b, h) (((b) * 2 + (h)) * HTB)
#define PG8_SB(b, h) ((4 + (b) * 2 + (h)) * HTB)
#define PG8_STAGE(bufoff, gbase, voff) do { _Pragma("unroll") for (int _i = 0; _i < 2; ++_i) \
        __builtin_amdgcn_global_load_lds((const unsigned*)((const char*)(gbase) + (voff)[_i]), (PG8_LAS unsigned*)(lds + (bufoff) + ldsw + _i * 8192), 16, 0, 0); } while (0)
#define PG8_LDA(dst, b, h) do { _Pragma("unroll") for (int m = 0; m < 4; ++m) _Pragma("unroll") for (int k = 0; k < 2; ++k) dst[m][k] = *(const PG8_LAS bf16x8*)(lds + PG8_SA(b, h) + aoff + m * 2048 + k * 1024); } while (0)
#define PG8_LDB(dst, b, h) do { _Pragma("unroll") for (int n = 0; n < 2; ++n) _Pragma("unroll") for (int k = 0; k < 2; ++k) dst[n][k] = *(const PG8_LAS bf16x8*)(lds + PG8_SB(b, h) + boff + n * 2048 + k * 1024); } while (0)
#define PG8_MMA(ai, bj, At, Bt) do { __builtin_amdgcn_s_setprio(1); _Pragma("unroll") for (int m = 0; m < 4; ++m) _Pragma("unroll") for (int n = 0; n < 2; ++n) _Pragma("unroll") for (int k = 0; k < 2; ++k) \
        acc[ai][bj][m][n] = __builtin_amdgcn_mfma_f32_16x16x32_bf16(Bt[n][k], At[m][k], acc[ai][bj][m][n], 0, 0, 0); __builtin_amdgcn_s_setprio(0); } while (0)
#define PG8_WAIT_V(n) asm volatile("s_waitcnt vmcnt(" #n ")" ::: "memory")
#define PG8_WAIT_L(n) asm volatile("s_waitcnt lgkmcnt(" #n ")" ::: "memory")
#define PG8_BAR __builtin_amdgcn_s_barrier()
#define PG8_SCHED __builtin_amdgcn_sched_barrier(0)
    const char* gA0; const char* gB0;
    { const unsigned long long va = (unsigned long long)g.A, vb = (unsigned long long)g.Bt;
      gA0 = (const char*)(((unsigned long long)(unsigned)__builtin_amdgcn_readfirstlane((int)(va >> 32)) << 32) | (unsigned)__builtin_amdgcn_readfirstlane((int)va));
      gB0 = (const char*)(((unsigned long long)(unsigned)__builtin_amdgcn_readfirstlane((int)(vb >> 32)) << 32) | (unsigned)__builtin_amdgcn_readfirstlane((int)vb)); }
    Unit cur, nxt; int ui = 0;
    if (!S.next(0, cur)) return;
    f32x4 acc[2][2][4][2];
#pragma unroll
    for (int a = 0; a < 2; ++a)
#pragma unroll
        for (int b = 0; b < 2; ++b)
#pragma unroll
            for (int m = 0; m < 4; ++m)
#pragma unroll
                for (int n = 0; n < 2; ++n) acc[a][b][m][n] = (f32x4){0.f, 0.f, 0.f, 0.f};
    bf16x8 At[4][2], B0[2][2], B1[2][2];
    const char* cA = gA0 + (size_t)cur.pm * tstepA; const char* cB = gB0 + (size_t)cur.pn * tstepB;
    S.a_ready(cur);
    if constexpr (SP2) {
        PG8_STAGE(PG8_SB(0, 0), cB, voffB); PG8_STAGE(PG8_SB(0, 1), cB + hstepB, voffB); PG8_STAGE(PG8_SA(0, 0), cA, voffA); PG8_STAGE(PG8_SA(0, 1), cA + hstepA, voffA);
        if (wr == 1) PG8_BAR;
        PG8_WAIT_V(2); PG8_BAR;
        PG8_STAGE(PG8_SB(1, 0), cB + kstep, voffB); PG8_STAGE(PG8_SA(1, 0), cA + kstep, voffA); PG8_STAGE(PG8_SB(1, 1), cB + hstepB + kstep, voffB);
        PG8_WAIT_V(6); PG8_BAR;
    } else {
        PG8_STAGE(PG8_SB(0, 0), cB, voffB); PG8_STAGE(PG8_SA(0, 0), cA, voffA); PG8_STAGE(PG8_SB(0, 1), cB + hstepB, voffB); PG8_STAGE(PG8_SA(0, 1), cA + hstepA, voffA);
        if (wr == 1) PG8_BAR;
        PG8_WAIT_V(4); PG8_BAR;
        PG8_STAGE(PG8_SB(1, 0), cB + kstep, voffB); PG8_STAGE(PG8_SA(1, 0), cA + kstep, voffA); PG8_STAGE(PG8_SB(1, 1), cB + hstepB + kstep, voffB);
        PG8_WAIT_V(6); PG8_BAR;
    }
    for (;;) {
        const bool has_next = S.next(ui + 1, nxt);
        if constexpr (has_rowstage<Epi>::value) { if (wid < 4)
            __builtin_amdgcn_global_load_lds((const unsigned*)((const char*)E.RS + ((size_t)cur.pm * BM + wid * 64 + lane) * 16), (PG8_LAS unsigned*)(lds + XR_OFF + (ui & 1) * 4096 + wid * 1024), 16, 0, 0); }
        const char* gA = gA0; const char* gB = gB0; asm volatile("" : "+s"(gA), "+s"(gB));
        const char* nA = has_next ? gA + (size_t)nxt.pm * tstepA : cA; const char* nB = has_next ? gB + (size_t)nxt.pn * tstepB : cB;
        for (int t = 0; t < nt; t += 2) {
            const bool last = (t == nt - 2);
            if constexpr (has_hpref<Epi>::value) { if (t == (nt > 8 ? nt - 8 : 0)) E.prefetch(cur, lds, wid, lane); }
            const char* a1 = cA + (size_t)(t + 1) * kstep;
            const char* a2 = last ? nA : cA + (size_t)(t + 2) * kstep; const char* b2 = last ? nB : cB + (size_t)(t + 2) * kstep;
            const char* a3 = a2 + kstep; const char* b3 = b2 + kstep;
            if (last && has_next) S.a_ready(nxt);
            if constexpr (SP2) {
            PG8_LDB(B0, 0, 0); PG8_LDB(B1, 0, 1); PG8_SCHED; PG8_LDA(At, 0, 0); PG8_STAGE(PG8_SA(1, 1), a1 + hstepA, voffA);
            PG8_WAIT_V(8); PG8_WAIT_L(0); PG8_BAR; PG8_MMA(0, 0, At, B0); PG8_MMA(0, 1, At, B1); PG8_BAR; PG8_SCHED;
            PG8_LDA(At, 0, 1); PG8_STAGE(PG8_SB(0, 0), b2, voffB); PG8_STAGE(PG8_SB(0, 1), b2 + hstepB, voffB); PG8_STAGE(PG8_SA(0, 0), a2, voffA);
            PG8_WAIT_V(8); PG8_WAIT_L(0); PG8_BAR; PG8_MMA(1, 0, At, B0); PG8_MMA(1, 1, At, B1); PG8_BAR; PG8_SCHED;
            PG8_LDB(B0, 1, 0); PG8_LDB(B1, 1, 1); PG8_SCHED; PG8_LDA(At, 1, 0); PG8_STAGE(PG8_SA(0, 1), a2 + hstepA, voffA);
            PG8_WAIT_V(8); PG8_WAIT_L(0); PG8_BAR; PG8_MMA(0, 0, At, B0); PG8_MMA(0, 1, At, B1); PG8_BAR; PG8_SCHED;
            PG8_LDA(At, 1, 1); PG8_STAGE(PG8_SB(1, 0), b3, voffB); PG8_STAGE(PG8_SB(1, 1), b3 + hstepB, voffB); PG8_STAGE(PG8_SA(1, 0), a3, voffA);
            PG8_WAIT_V(8); PG8_WAIT_L(0); PG8_BAR; PG8_MMA(1, 0, At, B0); PG8_MMA(1, 1, At, B1); PG8_BAR; PG8_SCHED;
            } else {
            PG8_LDB(B0, 0, 0); PG8_SCHED; PG8_LDA(At, 0, 0); PG8_STAGE(PG8_SA(1, 1), a1 + hstepA, voffA);
            PG8_WAIT_L(8); PG8_BAR; PG8_WAIT_L(0); PG8_MMA(0, 0, At, B0); PG8_BAR; PG8_SCHED;
            PG8_LDB(B1, 0, 1); PG8_STAGE(PG8_SB(0, 0), b2, voffB);
            PG8_BAR; PG8_WAIT_L(0); PG8_MMA(0, 1, At, B1); PG8_BAR;
            PG8_LDA(At, 0, 1); PG8_STAGE(PG8_SA(0, 0), a2, voffA);
            PG8_BAR; PG8_WAIT_L(0); PG8_MMA(1, 0, At, B0); PG8_BAR; PG8_SCHED;
            PG8_STAGE(PG8_SB(0, 1), b2 + hstepB, voffB);
            PG8_WAIT_V(6); PG8_BAR; PG8_MMA(1, 1, At, B1); PG8_BAR;
            PG8_LDB(B0, 1, 0); PG8_SCHED; PG8_LDA(At, 1, 0); PG8_STAGE(PG8_SA(0, 1), a2 + hstepA, voffA);
            PG8_WAIT_L(8); PG8_BAR; PG8_WAIT_L(0); PG8_MMA(0, 0, At, B0); PG8_BAR; PG8_SCHED;
            PG8_LDB(B1, 1, 1); PG8_STAGE(PG8_SB(1, 0), b3, voffB);
            PG8_BAR; PG8_WAIT_L(0); PG8_MMA(0, 1, At, B1); PG8_BAR;
            PG8_LDA(At, 1, 1); PG8_STAGE(PG8_SA(1, 0), a3, voffA);
            PG8_BAR; PG8_WAIT_L(0); PG8_MMA(1, 0, At, B0); PG8_BAR; PG8_SCHED;
            PG8_STAGE(PG8_SB(1, 1), b3 + hstepB, voffB);
            PG8_WAIT_V(6); PG8_BAR; PG8_MMA(1, 1, At, B1); PG8_BAR;
            }
        }
        if constexpr (ALIGN_EPI) { if (wr == 0) PG8_BAR; }
        cur.par = ui & 1;
        if constexpr (!Epi::AFTER_DRAIN) { E(acc, cur, wr, wc, fr, fq); S.done(cur); }
        if (!has_next) break;
#pragma unroll
        for (int a = 0; a < 2; ++a)
#pragma unroll
            for (int b = 0; b < 2; ++b)
#pragma unroll
                for (int m = 0; m < 4; ++m)
#pragma unroll
                    for (int n = 0; n < 2; ++n) acc[a][b][m][n] = (f32x4){0.f, 0.f, 0.f, 0.f};
        cur = nxt; cA = nA; cB = nB; ++ui;
        if constexpr (ALIGN_EPI) { if (wr == 1) PG8_BAR; }
    }
    PG8_WAIT_V(0);
    if constexpr (!ALIGN_EPI) { if (wr == 0) PG8_BAR; }
    PG8_BAR;
    if constexpr (Epi::AFTER_DRAIN) { E.fused(acc, cur, wr, wc, fr, fq, lds, wid, lane); S.done(cur); }
#undef PG8_SA
#undef PG8_SB
#undef PG8_STAGE
#undef PG8_LDA
#undef PG8_LDB
#undef PG8_MMA
#undef PG8_WAIT_V
#undef PG8_WAIT_L
#undef PG8_BAR
#undef PG8_SCHED
}
}
constexpr int NWAVES = 8, NTHR = NWAVES * 64;
constexpr int BATCH = 16, SEQ = 2048, DMODEL = 1024, FFD = 2816, MTOK = BATCH * SEQ, DEPTH = 2;
constexpr int MEML = 256, MROWS = BATCH * MEML;
constexpr int NIN_SRC = 2032, NIN = 2048;
constexpr float NORM_EPS = 1e-6f, LOG2E = 1.4426950408889634f, NEGBIG = -1e30f;
constexpr int PC_CQ = 0, PC_CKV = 192, PC_KPE = 320, PC_NQ = 352, PC_KCMP = 608, PC_VCMP = 672, PC_KSLC = 736, PC_VSLC = 800, PC_KSWA = 864, PC_VSWA = 928,
              PC_FQ = 992, PC_FK = 1248, PC_FV = 1504, PC_S5 = 1760, PC_GATE = 2016, PC_FF = 2028;

constexpr size_t MiB = 1u << 20, KiB = 1u << 10;
constexpr size_t WS_CTL = 0, CTL_ZERO_BYTES = 64 * KiB;
constexpr int CW_GRP = 8192;
constexpr int CW_BAR = 1024;
constexpr size_t WS_WGU1 = 1 * MiB;
constexpr size_t WS_WD1  = WS_WGU1 + 11 * MiB;
constexpr size_t WS_WGU2 = WS_WD1 + 6 * MiB;
constexpr size_t WS_WD2  = WS_WGU2 + 11 * MiB;
constexpr size_t WS_WIN  = WS_WD2 + 6 * MiB;
constexpr size_t WS_WOUT = WS_WIN + 4 * MiB;
constexpr size_t WS_WXQ  = WS_WOUT + 2 * MiB;
constexpr size_t WS_WXKV = WS_WXQ + 2 * MiB;
constexpr size_t WS_WXO  = WS_WXKV + 4 * MiB;
constexpr size_t WS_WPHI = WS_WXO + 2 * MiB;
constexpr size_t WS_WUQ  = WS_WPHI + 2 * MiB;
constexpr size_t WS_WUKV = WS_WUQ + 256 * KiB;
constexpr size_t WS_WGLU = WS_WUKV + 128 * KiB;
constexpr size_t WS_FS5  = WS_WGLU + 128 * KiB;
constexpr size_t WS_MISC = WS_FS5 + 4 * MiB;
constexpr size_t WS_BTS5 = WS_MISC + 2 * MiB;
constexpr size_t WS_U    = WS_BTS5 + 40 * MiB;
constexpr size_t WS_H    = WS_U + 64 * MiB;
constexpr size_t WS_BIG  = WS_H + 64 * MiB;
constexpr size_t WS_VWO  = WS_BIG + 240 * MiB;
constexpr size_t WS_END  = WS_VWO + 32 * MiB;
static_assert(WS_END <= 512 * MiB, "workspace map exceeds 512 MiB");
constexpr size_t MS_PHIB = 0;
constexpr size_t MS_A64 = 4 * KiB;
constexpr size_t MS_ROPEM = 16 * KiB;
constexpr size_t MS_ROPEN = MS_ROPEM + 256 * KiB;
constexpr size_t MS_WPHI2 = 1280 * KiB;
constexpr size_t MS_RS = 1 * MiB;
constexpr size_t MS_PHIP = MS_ROPEN + 512 * KiB;
constexpr size_t BG_ACT = 0;
constexpr size_t BG_Y = 176 * MiB;
constexpr size_t BG_WXKV1 = BG_Y + 2 * MiB, BG_MEMN1 = BG_Y + 6 * MiB, BG_KH1 = BG_Y + 14 * MiB, BG_VT1 = BG_Y + 22 * MiB;
static_assert(BG_VT1 + 8 * MiB <= 240 * MiB, "Y region");
constexpr size_t BG_SSY = BG_Y, BG_SSH = BG_Y + 1 * MiB;
constexpr size_t BG_QM = 0, BG_KVM = 32 * MiB;
constexpr size_t BG_CQN = 64 * MiB;
constexpr size_t BG_SSQ = 76 * MiB, BG_SSKV = 77 * MiB;
constexpr size_t BG_YS5 = BG_CQN;
constexpr size_t BG_CKVN = 80 * MiB;
constexpr size_t BG_US5 = 88 * MiB;
constexpr size_t BG_S5OUT = 104 * MiB;
constexpr size_t BG_KCMP = 144 * MiB;
constexpr size_t BG_VCMP = 149 * MiB;
constexpr size_t BG_HIDK = 154 * MiB, BG_HIDV = 155 * MiB;
constexpr size_t BG_KC = 156 * MiB, BG_VC = BG_KC + 256 * KiB;
constexpr size_t BG_XIN = BG_KC + 512 * KiB;
constexpr size_t BG_LOGF = BG_XIN + 2 * MiB;
constexpr size_t BG_CUM = BG_LOGF + 512 * KiB;
static_assert(BG_CUM + 512 * KiB <= 176 * MiB, "mixer overlay");
constexpr size_t BG_XQ = 0, BG_XO = 64 * MiB, BG_KH = 128 * MiB, BG_VT = 136 * MiB, BG_MEMN = 144 * MiB;
constexpr size_t BG_PX = 64 * MiB;

constexpr int RING_OFF = 0, RING_BYTES = 131072;
constexpr int LDSCTL_OFF = RING_BYTES, MISC_OFF = LDSCTL_OFF + 320;
constexpr int XCH_OFF = RING_BYTES + 1024;
constexpr int XR_OFF = XCH_OFF + 8192;
constexpr int LDS_BYTES = 155648;
static_assert(MISC_OFF + 128 <= XCH_OFF && XR_OFF + 8192 <= LDS_BYTES && XR_OFF == pg8::XR_OFF + RING_OFF && pg8::PF_OFF + RING_OFF + 2048 <= LDS_BYTES && pg8::PF_OFF == pg8::XR_OFF + 8192, "LDS map");

#define GAS __attribute__((address_space(1)))
#define LAS __attribute__((address_space(3)))
typedef unsigned short bf16;
typedef unsigned v4u __attribute__((ext_vector_type(4)));
typedef unsigned v2u __attribute__((ext_vector_type(2)));
typedef float f32x4 __attribute__((ext_vector_type(4)));
typedef float f32x16 __attribute__((ext_vector_type(16)));
typedef short bf16x8 __attribute__((ext_vector_type(8)));
typedef short s16x4 __attribute__((ext_vector_type(4)));
typedef GAS unsigned gu32;
#define RLX_AGENT __ATOMIC_RELAXED, __HIP_MEMORY_SCOPE_AGENT
__device__ __forceinline__ unsigned f2bf(float f) { unsigned u = __builtin_bit_cast(unsigned, f); return (u + 0x7fffu + ((u >> 16) & 1u)) >> 16; }
__device__ __forceinline__ unsigned pk2(float lo, float hi) { return f2bf(lo) | (f2bf(hi) << 16); }
__device__ __forceinline__ float bflo(unsigned w) { return __builtin_bit_cast(float, w << 16); }
__device__ __forceinline__ float bfhi(unsigned w) { return __builtin_bit_cast(float, w & 0xffff0000u); }
__device__ __forceinline__ float b2f(bf16 b) { return __builtin_bit_cast(float, (unsigned)b << 16); }
using pg8::fast_sigmoid; using pg8::gelu_tanh;
#define XB_TMO      128
#define XB_XCNT(j)  (256  + 64 * (j))
#define XB_XSUB(j)  (1280 + 64 * (j))
#define XB_XGEN(j)  (2304 + 64 * (j))
#define XB_TOP      3328
#define XB_TOPGEN   3392
#define XCD_BAR_WORDS 3456
#define XB_SPIN_CAP (1u << 18)
#define LAS __attribute__((address_space(3)))

__device__ __forceinline__ unsigned xb_ld(unsigned* p)              { return __hip_atomic_load(p, __ATOMIC_RELAXED, __HIP_MEMORY_SCOPE_AGENT); }
__device__ __forceinline__ unsigned xb_add(unsigned* p, unsigned v) { return __hip_atomic_fetch_add(p, v, __ATOMIC_RELAXED, __HIP_MEMORY_SCOPE_AGENT); }
__device__ __forceinline__ unsigned xb_xcc_id() { return (unsigned)__builtin_amdgcn_s_getreg((3 << 11) | 20) & 0xFu; }
#define XB_SPIN(cond, bar) do { unsigned _sp = 0; while (cond) { __builtin_amdgcn_s_sleep(1); \
    if ((++_sp & 255u) == 0u) { if (xb_ld(&(bar)[XB_TMO])) break; if (_sp > XB_SPIN_CAP) { atomicAdd(&(bar)[XB_TMO], 1u); break; } } } } while (0)

struct XcdBarrier {
    unsigned* bar; unsigned x;
    volatile LAS unsigned* st;
};

__device__ __forceinline__ XcdBarrier xcd_barrier_post(unsigned* bar, volatile LAS unsigned* st) {
    XcdBarrier b; b.bar = bar; b.x = xb_xcc_id(); b.st = st;
    if (threadIdx.x == 0) (void)xb_add(&bar[XB_XCNT(b.x)], 1u);
    return b;
}
__device__ __forceinline__ void xcd_barrier_complete(unsigned* bar, unsigned x, unsigned& nloc, unsigned& nx) {
    const unsigned G = gridDim.x * gridDim.y * gridDim.z;
    unsigned sum, cnt, mine, sp = 0u;
    for (;;) {
        sum = 0u; cnt = 0u; mine = 0u;
#pragma unroll
        for (unsigned j = 0; j < 16; ++j) { const unsigned c = xb_ld(&bar[XB_XCNT(j)]); sum += c; cnt += (c > 0u) ? 1u : 0u; mine = (j == x) ? c : mine; }
        if (sum == G) break;
        __builtin_amdgcn_s_sleep(1);
        if ((++sp & 255u) == 0u) { if (xb_ld(&bar[XB_TMO])) break; if (sp > XB_SPIN_CAP) { atomicAdd(&bar[XB_TMO], 1u); break; } }
    }
    nloc = mine > 0u ? mine : 1u; nx = cnt > 0u ? cnt : 1u;
}

__device__ __forceinline__ void xcd_barrier(const XcdBarrier& b) {
    asm volatile("s_waitcnt vmcnt(0)" ::: "memory");
    __syncthreads();
    if (threadIdx.x == 0) {
        unsigned* bar = b.bar;
        __builtin_amdgcn_s_waitcnt(0);
        unsigned nloc = b.st[0], nx = b.st[1];
        if (nloc == 0u) { xcd_barrier_complete(bar, b.x, nloc, nx); b.st[0] = nloc; b.st[1] = nx; }
        const unsigned old = xb_add(&bar[XB_XSUB(b.x)], 1u);
        const unsigned gen = old / nloc;
        if (old + 1u == (gen + 1u) * nloc) {
            __builtin_amdgcn_fence(__ATOMIC_RELEASE, "agent");
            asm volatile("s_waitcnt vmcnt(0)" ::: "memory");
            const unsigned og = xb_add(&bar[XB_TOP], 1u);
            const unsigned tg = og / nx;
            if (og + 1u == (tg + 1u) * nx) xb_add(&bar[XB_TOPGEN], 1u);
            else XB_SPIN(xb_ld(&bar[XB_TOPGEN]) == tg, bar);
            __builtin_amdgcn_fence(__ATOMIC_ACQUIRE, "agent");
            xb_add(&bar[XB_XGEN(b.x)], 1u);
            asm volatile("s_waitcnt vmcnt(0)" ::: "memory");
        } else {
            XB_SPIN(xb_ld(&bar[XB_XGEN(b.x)]) == gen, bar);
            __builtin_amdgcn_fence(__ATOMIC_ACQUIRE, "agent");
            asm volatile("s_waitcnt vmcnt(0)" ::: "memory");
        }
    }
    __syncthreads();
}
struct Frame {
    LAS unsigned char* lds;
    gu32* ctl;
    int tid, lane, wave, vcu, G;
    unsigned char* ws;
    const float* const* in;
};
__device__ __forceinline__ float wave_sum(float v) {
#pragma unroll
    for (int o = 1; o < 64; o <<= 1) v += __shfl_xor(v, o);
    return v;
}
#define LDS_WAIT() asm volatile("s_waitcnt lgkmcnt(0)" ::: "memory")

enum { MAP_ID = 0, MAP_GATE = 1, MAP_UP = 2, MAP_WIN = 3, MAP_UQ = 4 };
__device__ __forceinline__ int ileave(int d, int half) { return d < half ? 2 * d : 2 * (d - half) + 1; }
__device__ __forceinline__ int map_row(int mode, int n) {
    if (mode == MAP_GATE) return 256 * (n >> 7) + (n & 127);
    if (mode == MAP_UP)   return 256 * (n >> 7) + 128 + (n & 127);
    if (mode == MAP_WIN) {
        if (n < 320) return n;
        if (n < 352) return 320 + ileave(n - 320, 16);
        if (n < 672) { const int h = (n - 352) >> 6; return 352 + 64 * h + ileave((n - 352) & 63, 32); }
        if (n < 736) return n;
        if (n < 800) return 736 + ileave(n - 736, 32);
        if (n < 864) return n;
        if (n < 928) return 864 + ileave(n - 864, 32);
        if (n < 992) return n;
        if (n < 1004) return PC_GATE + (n - 992); if (n < 1772) return n - 12; if (n < 1776) return PC_FF + (n - 1772); if (n < 2032) return n - 16; return n; }
    if (mode == MAP_UQ) { if (n >= 384) return n; const int h = n / 96, j = n - 96 * h; return j < 64 ? n : 96 * h + 64 + ileave(j - 64, 16); }
    return n;
}
__device__ __forceinline__ void tr_item(const float* W, int Ks, int Ns, bf16* WT, int Kd, int Nd, int mode, LAS float* scr, int item, int lane, const float* kscale = nullptr) {
    const int nblk = Nd / 32, kb = item / nblk, nb = item % nblk, k0 = 64 * kb, n0 = 32 * nb;
    if ((Ns & 3) == 0 && n0 + 32 <= Ns) {
        const int n4 = (lane & 7) * 4;
        f32x4 v[8];
#pragma unroll
        for (int i = 0; i < 8; ++i) { const int k = k0 + (lane >> 3) + 8 * i; v[i] = (k < Ks) ? *(const GAS f32x4*)(W + (size_t)k * Ns + n0 + n4) : (f32x4){0.f, 0.f, 0.f, 0.f}; }
#pragma unroll
        for (int i = 0; i < 8; ++i) { const int kk = (lane >> 3) + 8 * i; const float sc = (kscale && k0 + kk < Ks) ? kscale[k0 + kk] : 1.f; *(LAS f32x4*)(scr + kk * 36 + n4) = v[i] * sc; }
    } else {
        const int n_l = n0 + (lane & 31);
#pragma unroll 8
        for (int i = 0; i < 32; ++i) { const int kk = 2 * i + (lane >> 5); const int k = k0 + kk;
            float v = (k < Ks && n_l < Ns) ? W[(size_t)k * Ns + n_l] : 0.f; if (kscale && k < Ks) v *= kscale[k];
            scr[kk * 36 + (lane & 31)] = v; }
    }
    LDS_WAIT(); asm volatile("" ::: "memory");
    const int c = lane & 7;
#pragma unroll
    for (int j = 0; j < 4; ++j) { const int n = (lane >> 3) + 8 * j; const LAS float* s = scr + (8 * c) * 36 + n;
        v4u o; o.x = pk2(s[0 * 36], s[1 * 36]); o.y = pk2(s[2 * 36], s[3 * 36]); o.z = pk2(s[4 * 36], s[5 * 36]); o.w = pk2(s[6 * 36], s[7 * 36]);
        const int nd = map_row(mode, n0 + n);
        *(GAS v4u*)(WT + (size_t)nd * Kd + k0 + 8 * c) = o; }
    LDS_WAIT(); asm volatile("" ::: "memory");
}

__device__ __forceinline__ void norm_row(int lane, const bf16* yrow, const bf16* hrow, const float* x32, bf16* hout, float* out32, const float* gpost, float w, float* rsout) {
    f32x4 hv[4];
    if (yrow) {
        f32x4 yv[4]; float s = 0.f;
#pragma unroll
        for (int j = 0; j < 4; ++j) { const v2u hb = ((const GAS v2u*)hrow)[lane + 64 * j], yb = ((const GAS v2u*)yrow)[lane + 64 * j];
            hv[j] = (f32x4){bflo(hb.x), bfhi(hb.x), bflo(hb.y), bfhi(hb.y)}; yv[j] = (f32x4){bflo(yb.x), bfhi(yb.x), bflo(yb.y), bfhi(yb.y)};
            s += (yv[j].x * yv[j].x + yv[j].y * yv[j].y) + (yv[j].z * yv[j].z + yv[j].w * yv[j].w); }
        const float rs = w * __builtin_amdgcn_rsqf(wave_sum(s) * (1.f / DMODEL) + NORM_EPS);
#pragma unroll
        for (int j = 0; j < 4; ++j) { const f32x4 g = ((const GAS f32x4*)gpost)[lane + 64 * j]; hv[j] = hv[j] + yv[j] * g * rs; }
    } else {
#pragma unroll
        for (int j = 0; j < 4; ++j) hv[j] = ((const GAS f32x4*)x32)[lane + 64 * j];
    }
    if (hout) {
#pragma unroll
        for (int j = 0; j < 4; ++j) { v2u o; o.x = pk2(hv[j].x, hv[j].y); o.y = pk2(hv[j].z, hv[j].w); ((GAS v2u*)hout)[lane + 64 * j] = o; }
    }
    if (out32) {
#pragma unroll
        for (int j = 0; j < 4; ++j) ((GAS f32x4*)out32)[lane + 64 * j] = hv[j];
    }
    if (rsout) {
        float s2 = 0.f;
#pragma unroll
        for (int j = 0; j < 4; ++j) s2 += (hv[j].x * hv[j].x + hv[j].y * hv[j].y) + (hv[j].z * hv[j].z + hv[j].w * hv[j].w);
        const float tot = wave_sum(s2);
        if (lane == 0) *(GAS f32x4*)rsout = (f32x4){tot, 0.f, 0.f, 0.f};
    }
}
__device__ __forceinline__ void xpass_rows2(int lane, const float* xa, const float* xb, bf16* ha, bf16* hb, float* ra, float* rb) {
    f32x4 va[4], vb[4];
#pragma unroll
    for (int j = 0; j < 4; ++j) { va[j] = ((const GAS f32x4*)xa)[lane + 64 * j]; vb[j] = ((const GAS f32x4*)xb)[lane + 64 * j]; }
    float sa = 0.f, sb = 0.f;
#pragma unroll
    for (int j = 0; j < 4; ++j) { sa += (va[j].x * va[j].x + va[j].y * va[j].y) + (va[j].z * va[j].z + va[j].w * va[j].w); sb += (vb[j].x * vb[j].x + vb[j].y * vb[j].y) + (vb[j].z * vb[j].z + vb[j].w * vb[j].w); }
#pragma unroll
    for (int j = 0; j < 4; ++j) { v2u o; o.x = pk2(va[j].x, va[j].y); o.y = pk2(va[j].z, va[j].w); ((GAS v2u*)ha)[lane + 64 * j] = o; v2u q; q.x = pk2(vb[j].x, vb[j].y); q.y = pk2(vb[j].z, vb[j].w); ((GAS v2u*)hb)[lane + 64 * j] = q; }
    const float ta = wave_sum(sa), tb = wave_sum(sb);
    if (lane == 0) { *(GAS f32x4*)ra = (f32x4){ta, 0.f, 0.f, 0.f}; *(GAS f32x4*)rb = (f32x4){tb, 0.f, 0.f, 0.f}; }
}
__device__ __forceinline__ void norm_only_row(int lane, const float* xrow, const float* g, bf16* urow) {
    f32x4 hv[4]; float s2 = 0.f;
#pragma unroll
    for (int j = 0; j < 4; ++j) { hv[j] = ((const GAS f32x4*)xrow)[lane + 64 * j]; s2 += (hv[j].x * hv[j].x + hv[j].y * hv[j].y) + (hv[j].z * hv[j].z + hv[j].w * hv[j].w); }
    const float rs2 = __builtin_amdgcn_rsqf(wave_sum(s2) * (1.f / DMODEL) + NORM_EPS);
#pragma unroll
    for (int j = 0; j < 4; ++j) { const f32x4 gg = ((const GAS f32x4*)g)[lane + 64 * j]; const f32x4 v = hv[j] * gg * rs2;
        v2u o; o.x = pk2(v.x, v.y); o.y = pk2(v.z, v.w); ((GAS v2u*)urow)[lane + 64 * j] = o; }
}
__device__ __forceinline__ void groupnorm_row(int lane, bf16* row, const float* gg) {
    v4u a = ((GAS v4u*)row)[2 * lane], b = ((GAS v4u*)row)[2 * lane + 1];
    float v[16];
    v[0] = bflo(a.x); v[1] = bfhi(a.x); v[2] = bflo(a.y); v[3] = bfhi(a.y); v[4] = bflo(a.z); v[5] = bfhi(a.z); v[6] = bflo(a.w); v[7] = bfhi(a.w);
    v[8] = bflo(b.x); v[9] = bfhi(b.x); v[10] = bflo(b.y); v[11] = bfhi(b.y); v[12] = bflo(b.z); v[13] = bfhi(b.z); v[14] = bflo(b.w); v[15] = bfhi(b.w);
    float s = 0.f;
#pragma unroll
    for (int i = 0; i < 16; ++i) s += v[i] * v[i];
#pragma unroll
    for (int o = 1; o < 16; o <<= 1) s += __shfl_xor(s, o);
    const float rs = __builtin_amdgcn_rsqf(s * (1.f / 256.f) + NORM_EPS);
    const float* g = gg + 16 * lane;
#pragma unroll
    for (int i = 0; i < 16; ++i) v[i] = v[i] * rs * g[i];
    a.x = pk2(v[0], v[1]); a.y = pk2(v[2], v[3]); a.z = pk2(v[4], v[5]); a.w = pk2(v[6], v[7]);
    b.x = pk2(v[8], v[9]); b.y = pk2(v[10], v[11]); b.z = pk2(v[12], v[13]); b.w = pk2(v[14], v[15]);
    ((GAS v4u*)row)[2 * lane] = a; ((GAS v4u*)row)[2 * lane + 1] = b;
}

struct S5W { const float *lre, *lim, *ldt, *bre, *bim, *cre, *cim; bf16* BT; bf16* FS; float* A64; };
__device__ __forceinline__ void s5_item(LAS float* sm, int tid, int g, int tlo, int thi, const S5W& W) {
    LAS float* Ar = sm; LAS float* Ai = sm + 64; LAS float* Kr = sm + 128; LAS float* Ki = sm + 192; LAS float* A1r = sm + 256; LAS float* A1i = sm + 320; LAS float* KT = sm + 384;
    LAS float* Bkr = sm + 1024; LAS float* Bki = sm + 2048; LAS float* Cr = sm + 3072; LAS float* Ci = sm + 4096;
    __syncthreads();
    if (tid < 64) { const int p = tid; const float dt = __expf(W.ldt[g]); const float lr = W.lre[g * 64 + p], li = W.lim[g * 64 + p];
        const float mag1 = __expf(lr * dt), ar1 = mag1 * cosf(li * dt), ai1 = mag1 * sinf(li * dt);
        const float den = lr * lr + li * li; Kr[p] = ((ar1 - 1.f) * lr + ai1 * li) / den; Ki[p] = (ai1 * lr - (ar1 - 1.f) * li) / den; A1r[p] = ar1; A1i[p] = ai1;
        const float mg = __expf(lr * dt * (float)tlo);
        double ang = (double)li * (double)dt * (double)tlo; const double twopi = 6.283185307179586476925; ang -= twopi * rint(ang / twopi);
        const float af = (float)ang; Ar[p] = mg * cosf(af); Ai[p] = mg * sinf(af); }
    for (int i = tid; i < 1024; i += NTHR) { Cr[i] = W.cre[g * 1024 + i]; Ci[i] = W.cim[g * 1024 + i]; }
    __syncthreads();
    for (int i = tid; i < 1024; i += NTHR) { const int p = i >> 4; const float br = W.bre[g * 1024 + i], bi = W.bim[g * 1024 + i]; Bkr[i] = Kr[p] * br - Ki[p] * bi; Bki[i] = Kr[p] * bi + Ki[p] * br; }
    __syncthreads();
    bf16* BTg = W.BT + (size_t)g * 1280 * 1024;
    for (int tau = tlo; tau <= thi; ++tau) {
        if (tau < 64) {
            if (tid < 256) { const int c = tid >> 4, cp = tid & 15; float acc = 0.f;
#pragma unroll 8
                for (int p = 0; p < 64; ++p) { const float kbr = Bkr[p * 16 + cp], kbi = Bki[p * 16 + cp];
                    const float wr_ = kbr * Ar[p] - kbi * Ai[p], wi_ = kbr * Ai[p] + kbi * Ar[p];
                    acc += Cr[c * 64 + p] * wr_ - Ci[c * 64 + p] * wi_; }
                KT[c * 16 + cp] = acc; }
            __syncthreads();
            const int nseg = (64 - tau) * 16;
            for (int idx = tid; idx < nseg; idx += NTHR) { const int t = tau + (idx >> 4), c = idx & 15; const LAS float* k = KT + c * 16;
                v4u a, b; a.x = pk2(k[0], k[1]); a.y = pk2(k[2], k[3]); a.z = pk2(k[4], k[5]); a.w = pk2(k[6], k[7]); b.x = pk2(k[8], k[9]); b.y = pk2(k[10], k[11]); b.z = pk2(k[12], k[13]); b.w = pk2(k[14], k[15]);
                bf16* dst = BTg + (size_t)(t * 16 + c) * 1024 + (t - tau) * 16; *(GAS v4u*)dst = a; *(GAS v4u*)(dst + 8) = b;
                if (tau > 0) { bf16* dz = BTg + (size_t)((t - tau) * 16 + c) * 1024 + t * 16; const v4u z = {0u, 0u, 0u, 0u}; *(GAS v4u*)dz = z; *(GAS v4u*)(dz + 8) = z; } }
            if (tid < 128) { const int p = tid & 63, im = tid >> 6, s = 63 - tau; float v[16];
#pragma unroll
                for (int cp = 0; cp < 16; ++cp) { const float kbr = Bkr[p * 16 + cp], kbi = Bki[p * 16 + cp]; v[cp] = im ? (kbr * Ai[p] + kbi * Ar[p]) : (kbr * Ar[p] - kbi * Ai[p]); }
                v4u a, b; a.x = pk2(v[0], v[1]); a.y = pk2(v[2], v[3]); a.z = pk2(v[4], v[5]); a.w = pk2(v[6], v[7]); b.x = pk2(v[8], v[9]); b.y = pk2(v[10], v[11]); b.z = pk2(v[12], v[13]); b.w = pk2(v[14], v[15]);
                bf16* dst = BTg + (size_t)(1024 + im * 64 + p) * 1024 + s * 16; *(GAS v4u*)dst = a; *(GAS v4u*)(dst + 8) = b; }
        }
        if (tau >= 1 && tid >= 256) { const int i = tid - 256, c = i >> 4, p0 = (i & 15) * 8, t = tau - 1; const int im = p0 >= 64, pb = p0 & 63; float v[8];
#pragma unroll
            for (int j = 0; j < 8; ++j) { const int p = pb + j; const float cr = Cr[c * 64 + p], ci = Ci[c * 64 + p]; v[j] = im ? -(cr * Ai[p] + ci * Ar[p]) : (cr * Ar[p] - ci * Ai[p]); }
            v4u a; a.x = pk2(v[0], v[1]); a.y = pk2(v[2], v[3]); a.z = pk2(v[4], v[5]); a.w = pk2(v[6], v[7]);
            *(GAS v4u*)(W.FS + ((size_t)g * 1024 + t * 16 + c) * 128 + p0) = a; }
        if (tau == 64 && tid < 64) { W.A64[(g * 64 + tid) * 2] = Ar[tid]; W.A64[(g * 64 + tid) * 2 + 1] = Ai[tid]; }
        __syncthreads();
        if (tid < 64) { const float r = Ar[tid] * A1r[tid] - Ai[tid] * A1i[tid], im2 = Ar[tid] * A1i[tid] + Ai[tid] * A1r[tid]; Ar[tid] = r; Ai[tid] = im2; }
        __syncthreads();
    }
}

__device__ __forceinline__ void phib_part(int item, int lane, const float* pos, const float* w1, float* PHIP) {
    const int nb = item & 3, kc = (item >> 2) & 63, j = item >> 8, n = nb * 64 + lane; const float* w = w1 + (size_t)j * 2048 * 256 + (size_t)(kc * 32) * 256 + n; const float* ps = pos + j * 2048 + kc * 32;
    float acc = 0.f;
#pragma unroll
    for (int k = 0; k < 32; ++k) acc += ps[k] * w[(size_t)k * 256];
    PHIP[(j * 64 + kc) * 256 + n] = acc;
}
__device__ __forceinline__ void phib_final(int i, const float* PHIP, const float* b1, float* PHIB) {
    const int j = i >> 8, n = i & 255; float v[64];
#pragma unroll
    for (int kc = 0; kc < 64; ++kc) v[kc] = PHIP[(j * 64 + kc) * 256 + n];
    float acc = b1[i];
#pragma unroll
    for (int kc = 0; kc < 64; ++kc) acc += v[kc];
    PHIB[i] = acc;
}
__device__ __forceinline__ void rope_fill(float* tab, int nh, int idx) {
    const int pos = idx / nh, i = idx % nh; const float inv = 1.0f / powf(10000.0f, (float)(2 * i) / (float)(2 * nh)); const float ang = (float)pos * inv;
    double a = (double)ang; const double twopi = 6.283185307179586476925; a -= twopi * rint(a / twopi); const float af = (float)a;
    tab[2 * idx] = cosf(af); tab[2 * idx + 1] = sinf(af);
}
__device__ __forceinline__ void phi2_row(int lane, const bf16* hid, const float* w2, bf16* out) {
    float acc = 0.f;
#pragma unroll 8
    for (int k = 0; k < 256; ++k) acc += b2f(hid[k]) * w2[k * 64 + lane];
    out[lane] = (bf16)f2bf(acc);
}
__device__ __forceinline__ void cumsum_seq(int lane, const float* lf, float* cum) {
    float v[32]; float s = 0.f;
#pragma unroll
    for (int i = 0; i < 8; ++i) { const f32x4 x = ((const GAS f32x4*)lf)[lane * 8 + i]; v[4 * i] = x.x; v[4 * i + 1] = x.y; v[4 * i + 2] = x.z; v[4 * i + 3] = x.w; }
#pragma unroll
    for (int i = 0; i < 32; ++i) { s += v[i]; v[i] = s; }
    float incl = s;
#pragma unroll
    for (int o = 1; o < 64; o <<= 1) { const float n = __shfl_up(incl, o); if (lane >= o) incl += n; }
    const float excl = incl - s;
#pragma unroll
    for (int i = 0; i < 8; ++i) { f32x4 x; x.x = v[4 * i] + excl; x.y = v[4 * i + 1] + excl; x.z = v[4 * i + 2] + excl; x.w = v[4 * i + 3] + excl; ((GAS f32x4*)cum)[lane * 8 + i] = x; }
}
__device__ __forceinline__ void s5_carry_blk(int tid, int g, int half, const float* S5OUT, const float* A64, bf16* XIN) {
    const int p = tid & 63, b = 8 * half + (tid >> 6);
    const float ar = A64[(g * 64 + p) * 2], ai = A64[(g * 64 + p) * 2 + 1];
    float xr = 0.f, xi = 0.f;
    for (int k0 = 0; k0 < 32; k0 += 8) {
        float er[8], ei[8];
#pragma unroll
        for (int j = 0; j < 8; ++j) { const size_t row = (size_t)g * 512 + b * 32 + k0 + j;
            er[j] = __hip_atomic_load(S5OUT + row * 1280 + 1024 + p, __ATOMIC_RELAXED, __HIP_MEMORY_SCOPE_AGENT); ei[j] = __hip_atomic_load(S5OUT + row * 1280 + 1088 + p, __ATOMIC_RELAXED, __HIP_MEMORY_SCOPE_AGENT); }
#pragma unroll
        for (int j = 0; j < 8; ++j) { const size_t row = (size_t)g * 512 + b * 32 + k0 + j;
            XIN[row * 128 + p] = (bf16)f2bf(xr); XIN[row * 128 + 64 + p] = (bf16)f2bf(xi);
            const float nr = ar * xr - ai * xi + er[j], ni = ar * xi + ai * xr + ei[j]; xr = nr; xi = ni; }
    }
}
#define MFMA32(a, b, c) __builtin_amdgcn_mfma_f32_32x32x16_bf16(a, b, c, 0, 0, 0)
typedef short v4i16_t __attribute__((ext_vector_type(4)));
__device__ __forceinline__ int krow(int r, int hi) { return (r & 3) + 8 * (r >> 2) + 4 * hi; }
__device__ __forceinline__ s16x4 tr16(const LAS unsigned char* p) { return __builtin_bit_cast(s16x4, __builtin_amdgcn_ds_read_tr16_b64_v4i16((LAS v4i16_t*)p)); }
__device__ __forceinline__ unsigned cvtpk(float lo, float hi) { unsigned r; asm("v_cvt_pk_bf16_f32 %0, %1, %2" : "=v"(r) : "v"(lo), "v"(hi)); return r; }
typedef float f32x2_t __attribute__((ext_vector_type(2)));
typedef __bf16 bf16x2_t __attribute__((ext_vector_type(2)));
__device__ __forceinline__ unsigned cvtpk_c(float lo, float hi) { const f32x2_t v = {lo, hi}; const bf16x2_t b = __builtin_convertvector(v, bf16x2_t); return __builtin_bit_cast(unsigned, b); }

template <int DK> __device__ __forceinline__ f32x16 qk_tile(const LAS unsigned char* kt, int kp, const bf16x8 (&qf)[DK / 16], int lane) {
    const int r32 = lane & 31, hi = lane >> 5; f32x16 s;
#pragma unroll
    for (int r = 0; r < 16; ++r) s[r] = 0.f;
#pragma unroll
    for (int d0 = 0; d0 < DK / 16; ++d0) { const bf16x8 kf = *(const LAS bf16x8*)(kt + r32 * kp + d0 * 32 + hi * 16); s = MFMA32(kf, qf[d0], s); }
    return s;
}
template <int DV> __device__ __forceinline__ void pv_tile(f32x16 (&o)[DV / 32], const LAS unsigned char* vt, int vp, const f32x16& p, int lane) {
    const int hi = lane >> 5, q4 = (lane & 15) >> 2, p4 = lane & 3, ch = (lane >> 4) & 1;
    v4u w0, w1;
    w0.x = cvtpk(p[0], p[1]); w0.y = cvtpk(p[2], p[3]); w0.z = cvtpk(p[4], p[5]); w0.w = cvtpk(p[6], p[7]);
    w1.x = cvtpk(p[8], p[9]); w1.y = cvtpk(p[10], p[11]); w1.z = cvtpk(p[12], p[13]); w1.w = cvtpk(p[14], p[15]);
    const bf16x8 pf0 = __builtin_bit_cast(bf16x8, w0), pf1 = __builtin_bit_cast(bf16x8, w1);
    const LAS unsigned char* base = vt + (4 * hi + q4) * vp + (16 * ch + 4 * p4) * 2;
#pragma unroll
    for (int blk = 0; blk < DV / 32; ++blk) {
        const s16x4 a0 = tr16(base + blk * 64), a1 = tr16(base + 8 * vp + blk * 64), b0 = tr16(base + 16 * vp + blk * 64), b1 = tr16(base + 24 * vp + blk * 64);
        const bf16x8 vf0 = (bf16x8){a0[0], a0[1], a0[2], a0[3], a1[0], a1[1], a1[2], a1[3]}, vf1 = (bf16x8){b0[0], b0[1], b0[2], b0[3], b1[0], b1[1], b1[2], b1[3]};
        o[blk] = MFMA32(vf0, pf0, o[blk]); o[blk] = MFMA32(vf1, pf1, o[blk]);
    }
}
__device__ __forceinline__ float xhalf_max(float v) { const auto rr = __builtin_amdgcn_permlane32_swap(__float_as_uint(v), __float_as_uint(v), false, false); return fmaxf(__uint_as_float(rr[0]), __uint_as_float(rr[1])); }
__device__ __forceinline__ float xhalf_sum(float v) { const auto rr = __builtin_amdgcn_permlane32_swap(__float_as_uint(v), __float_as_uint(v), false, false); return __uint_as_float(rr[0]) + __uint_as_float(rr[1]); }
template <int NB> __device__ __forceinline__ void sm_update(f32x16& s, float& m, float& l, f32x16 (&o)[NB]) {
    float mx = s[0];
#pragma unroll
    for (int r = 1; r < 16; ++r) mx = fmaxf(mx, s[r]);
    mx = xhalf_max(mx);
    const float mn = fmaxf(m, mx), alpha = __builtin_amdgcn_exp2f(m - mn);
    float rs = 0.f;
#pragma unroll
    for (int r = 0; r < 16; ++r) { const float pv = __builtin_amdgcn_exp2f(s[r] - mn); s[r] = pv; rs += pv; }
    rs = xhalf_sum(rs);
    l = l * alpha + rs; m = mn;
    if (!__all(alpha == 1.0f)) {
#pragma unroll
        for (int b = 0; b < NB; ++b)
#pragma unroll
            for (int r = 0; r < 16; ++r) o[b][r] *= alpha;
    }
}
__device__ __forceinline__ bf16x8 scale_frag(bf16x8 q, float sc) {
    const v4u w = __builtin_bit_cast(v4u, q); v4u o;
    o.x = cvtpk(bflo(w.x) * sc, bfhi(w.x) * sc); o.y = cvtpk(bflo(w.y) * sc, bfhi(w.y) * sc); o.z = cvtpk(bflo(w.z) * sc, bfhi(w.z) * sc); o.w = cvtpk(bflo(w.w) * sc, bfhi(w.w) * sc);
    return __builtin_bit_cast(bf16x8, o); }
template <int DK, int CH = 4> __device__ __forceinline__ void qk64(const LAS unsigned char* kt, int kp, const bf16x8 (&qf)[DK / 16], f32x16& s0, f32x16& s1, int lane) {
    const int r32 = lane & 31, hi = lane >> 5; constexpr int ND = DK / 16;
#pragma unroll
    for (int r = 0; r < 16; ++r) { s0[r] = 0.f; s1[r] = 0.f; }
    const LAS unsigned char* b0 = kt + r32 * kp + hi * 16; const LAS unsigned char* b1 = b0 + 32 * kp;
#pragma unroll
    for (int c0 = 0; c0 < ND; c0 += CH) {
        bf16x8 k0[CH], k1[CH];
#pragma unroll
        for (int i = 0; i < CH; ++i) if (c0 + i < ND) { k0[i] = *(const LAS bf16x8*)(b0 + (c0 + i) * 32); k1[i] = *(const LAS bf16x8*)(b1 + (c0 + i) * 32); }
#pragma unroll
        for (int i = 0; i < CH; ++i) if (c0 + i < ND) { s0 = MFMA32(k0[i], qf[c0 + i], s0); s1 = MFMA32(k1[i], qf[c0 + i], s1); }
    }
}
__device__ __forceinline__ float tile_max64(const f32x16& s0, const f32x16& s1) {
    float mx = fmaxf(s0[0], s1[0]);
#pragma unroll
    for (int r = 1; r < 16; ++r) mx = fmaxf(mx, fmaxf(s0[r], s1[r]));
    return xhalf_max(mx);
}
template <int NB> __device__ __forceinline__ void softmax64m(f32x16& s0, f32x16& s1, float mx, float& m, float& l, f32x16 (&o)[NB]) {
    const float mn = fmaxf(m, mx), alpha = __builtin_amdgcn_exp2f(m - mn);
    float rs = 0.f;
#pragma unroll
    for (int r = 0; r < 16; ++r) { const float p0 = __builtin_amdgcn_exp2f(s0[r] - mn), p1 = __builtin_amdgcn_exp2f(s1[r] - mn); s0[r] = p0; s1[r] = p1; rs += p0 + p1; }
    rs = xhalf_sum(rs);
    l = l * alpha + rs; m = mn;
    if (!__all(alpha == 1.0f)) {
#pragma unroll
        for (int b = 0; b < NB; ++b)
#pragma unroll
            for (int r = 0; r < 16; ++r) o[b][r] *= alpha;
    }
}
template <int NB> __device__ __forceinline__ void softmax64(f32x16& s0, f32x16& s1, float& m, float& l, f32x16 (&o)[NB]) { softmax64m<NB>(s0, s1, tile_max64(s0, s1), m, l, o); }
template <int DV, int NBB = 2> __device__ __forceinline__ void pv64(f32x16 (&o)[DV / 32], const LAS unsigned char* vt, int vp, const f32x16& p0, const f32x16& p1, int lane) {
    const int hi = lane >> 5, q4 = (lane & 15) >> 2, p4 = lane & 3, ch = (lane >> 4) & 1;
    bf16x8 pf[4];
    { v4u w; w.x = cvtpk(p0[0], p0[1]); w.y = cvtpk(p0[2], p0[3]); w.z = cvtpk(p0[4], p0[5]); w.w = cvtpk(p0[6], p0[7]); pf[0] = __builtin_bit_cast(bf16x8, w);
      w.x = cvtpk(p0[8], p0[9]); w.y = cvtpk(p0[10], p0[11]); w.z = cvtpk(p0[12], p0[13]); w.w = cvtpk(p0[14], p0[15]); pf[1] = __builtin_bit_cast(bf16x8, w);
      w.x = cvtpk(p1[0], p1[1]); w.y = cvtpk(p1[2], p1[3]); w.z = cvtpk(p1[4], p1[5]); w.w = cvtpk(p1[6], p1[7]); pf[2] = __builtin_bit_cast(bf16x8, w);
      w.x = cvtpk(p1[8], p1[9]); w.y = cvtpk(p1[10], p1[11]); w.z = cvtpk(p1[12], p1[13]); w.w = cvtpk(p1[14], p1[15]); pf[3] = __builtin_bit_cast(bf16x8, w); }
    const LAS unsigned char* base = vt + (4 * hi + q4) * vp + (16 * ch + 4 * p4) * 2;
#pragma unroll
    for (int b2 = 0; b2 < DV / 32; b2 += NBB) {
        s16x4 a[NBB][8];
#pragma unroll
        for (int bb = 0; bb < NBB; ++bb)
#pragma unroll
            for (int k = 0; k < 8; ++k) a[bb][k] = tr16(base + (8 * k) * vp + (b2 + bb) * 64);
#pragma unroll
        for (int k = 0; k < 4; ++k)
#pragma unroll
            for (int bb = 0; bb < NBB; ++bb) { const s16x4 lo = a[bb][2 * k], hh = a[bb][2 * k + 1];
                const bf16x8 vf = (bf16x8){lo[0], lo[1], lo[2], lo[3], hh[0], hh[1], hh[2], hh[3]};
                o[b2 + bb] = MFMA32(vf, pf[k], o[b2 + bb]); }
    }
}
template <int NCH> __device__ __forceinline__ void stage_rows(LAS unsigned char* dst, int lp, int nrows, const bf16* src0, int pitch0, const bf16* src1, int pitch1, int tid) {
    for (int c = tid; c < nrows * NCH; c += NTHR) { const int row = c / NCH, ch = c % NCH;
        const bf16* s = (NCH <= 8 || ch < 8 || src1 == nullptr) ? (src0 + (size_t)row * pitch0 + ch * 8) : (src1 + (size_t)row * pitch1 + (ch - 8) * 8);
        const v4u v = *(const GAS v4u*)s; *(LAS v4u*)(dst + row * lp + ch * 16) = v; }
}
template <int NB> __device__ __forceinline__ void store_ot(const f32x16 (&o)[NB], float sc, bf16* orow, int lane) {
    const int hi = lane >> 5;
#pragma unroll
    for (int b = 0; b < NB; ++b)
#pragma unroll
        for (int g = 0; g < 4; g += 2) {
            unsigned ax = cvtpk_c(o[b][4 * g] * sc, o[b][4 * g + 1] * sc), ay = cvtpk_c(o[b][4 * g + 2] * sc, o[b][4 * g + 3] * sc);
            unsigned bx = cvtpk_c(o[b][4 * g + 4] * sc, o[b][4 * g + 5] * sc), by = cvtpk_c(o[b][4 * g + 6] * sc, o[b][4 * g + 7] * sc);
            const auto rx = __builtin_amdgcn_permlane32_swap(ax, bx, false, false); const auto ry = __builtin_amdgcn_permlane32_swap(ay, by, false, false);
            v4u w; w.x = rx[0]; w.y = ry[0]; w.z = rx[1]; w.w = ry[1];
            *(GAS v4u*)(orow + 32 * b + 8 * g + 8 * hi) = w; }
}

template <int NCH, int ROWS = 64> struct TileRegs { static constexpr int N = (ROWS * NCH + NTHR - 1) / NTHR; v4u r[N]; };
template <int NCH, int ROWS = 64> __device__ __forceinline__ void tile_issue(TileRegs<NCH, ROWS>& T, const bf16* src0, int pitch0, const bf16* src1, int pitch1, int tid) {
#pragma unroll
    for (int i = 0; i < TileRegs<NCH, ROWS>::N; ++i) { const int c = tid + i * NTHR;
        if ((ROWS * NCH) % NTHR == 0 || c < ROWS * NCH) { const int row = c / NCH, ch = c % NCH;
            const bf16* s = (NCH <= 8 || ch < 8 || src1 == nullptr) ? (src0 + (size_t)row * pitch0 + ch * 8) : (src1 + (size_t)row * pitch1 + (ch - 8) * 8);
            T.r[i] = *(const GAS v4u*)s; } }
}
template <int NCH, int ROWS = 64> __device__ __forceinline__ void tile_commit(const TileRegs<NCH, ROWS>& T, LAS unsigned char* dst, int lp, int tid) {
#pragma unroll
    for (int i = 0; i < TileRegs<NCH, ROWS>::N; ++i) { const int c = tid + i * NTHR;
        if ((ROWS * NCH) % NTHR == 0 || c < ROWS * NCH) { const int row = c / NCH, ch = c % NCH; *(LAS v4u*)(dst + row * lp + ch * 16) = T.r[i]; } }
}

struct CausalArgs { const bf16* Q; int qp; const bf16* K0; int kp0; const bf16* K1; int kp1; const bf16* V; int vp; const float* cum; bf16* O; int op; float scale2; };
template <int DK, bool FOX, int VAR = 0> __device__ __forceinline__ void causal_unit(LAS unsigned char* lds, int tid, int qt, const CausalArgs& A) {
    constexpr int KP = DK * 2 + 16, VP = 64 * 2 + 64, NCHK = DK / 8, BUF = 128 * KP + 128 * VP + 512;
    asm volatile("" : "+v"(tid));
    const int lane = tid & 63, w = __builtin_amdgcn_readfirstlane(tid >> 6), r32 = lane & 31, hi = lane >> 5;
    const int t0 = 256 * qt + 32 * w, tq = t0 + r32;
    if (w >= 4) __builtin_amdgcn_s_setprio(1);
    bf16x8 qf[DK / 16];
#pragma unroll
    for (int d0 = 0; d0 < DK / 16; ++d0) qf[d0] = scale_frag(*(const GAS bf16x8*)(A.Q + (size_t)tq * A.qp + d0 * 16 + hi * 8), A.scale2);
    f32x16 o[2];
#pragma unroll
    for (int b = 0; b < 2; ++b)
#pragma unroll
        for (int r = 0; r < 16; ++r) o[b][r] = 0.f;
    float m = NEGBIG, l = 0.f;
    const int nkt = 2 * (qt + 1);
    TileRegs<NCHK, 128> kr; TileRegs<8, 128> vr; float cr = 0.f;
    { const size_t r0 = (size_t)(128 * (nkt - 1));
      tile_issue<NCHK, 128>(kr, A.K0 + r0 * A.kp0, A.kp0, A.K1 ? A.K1 + r0 * A.kp1 : nullptr, A.kp1, tid); tile_issue<8, 128>(vr, A.V + r0 * A.vp, A.vp, nullptr, 0, tid); if (FOX && tid < 128) cr = A.cum[r0 + tid]; }
    __syncthreads();
    for (int kt = nkt - 1; kt >= 0; --kt) {
        LAS unsigned char* Kl = lds + (kt & 1) * BUF; LAS unsigned char* Vl = Kl + 128 * KP; LAS float* Cl = (LAS float*)(Vl + 128 * VP);
        tile_commit<NCHK, 128>(kr, Kl, KP, tid); tile_commit<8, 128>(vr, Vl, VP, tid); if (FOX && tid < 128) Cl[tid] = cr * LOG2E;
        __syncthreads();
        if (kt > 0) { const size_t r0 = (size_t)(128 * (kt - 1));
            tile_issue<NCHK, 128>(kr, A.K0 + r0 * A.kp0, A.kp0, A.K1 ? A.K1 + r0 * A.kp1 : nullptr, A.kp1, tid); tile_issue<8, 128>(vr, A.V + r0 * A.vp, A.vp, nullptr, 0, tid);
            if (FOX && tid < 128) cr = A.cum[r0 + tid]; }
        const int kA = 128 * kt + 64, kB = 128 * kt;
        const bool doA = kA <= t0 + 31, doB = kB <= t0 + 31;
        f32x16 a0, a1, b0, b1;
        if (doA) qk64<DK>(Kl + 64 * KP, KP, qf, a0, a1, lane);
        if (doB) qk64<DK>(Kl, KP, qf, b0, b1, lane);
#pragma unroll
        for (int hf = 0; hf < 2; ++hf) {
            const bool doit = hf ? doB : doA; const int key0 = hf ? kB : kA;
            if (doit) {
                f32x16& s0 = hf ? b0 : a0; f32x16& s1 = hf ? b1 : a1;
                const LAS float* Ch = Cl + (hf ? 0 : 64);
                if (FOX) {
#pragma unroll
                    for (int g = 0; g < 4; ++g) { const f32x4 c0 = *(const LAS f32x4*)(Ch + 8 * g + 4 * hi), c1 = *(const LAS f32x4*)(Ch + 32 + 8 * g + 4 * hi);
#pragma unroll
                        for (int e = 0; e < 4; ++e) { s0[4 * g + e] -= c0[e]; s1[4 * g + e] -= c1[e]; } }
                }
                if (key0 + 63 > t0) {
#pragma unroll
                    for (int r = 0; r < 16; ++r) { const int kr_ = krow(r, hi); if (key0 + kr_ > tq) s0[r] = NEGBIG; if (key0 + 32 + kr_ > tq) s1[r] = NEGBIG; }
                }
                const float tmx = tile_max64(s0, s1);
                if (!(FOX && __all(tmx < m - 40.f))) {
                    softmax64m<2>(s0, s1, tmx, m, l, o);
                    pv64<64>(o, Vl + (hf ? 0 : 64) * VP, VP, s0, s1, lane);
                }
            }
        }
    }
    store_ot<2>(o, __builtin_amdgcn_rcpf(fmaxf(l, 1e-30f)), A.O + (size_t)tq * A.op, lane);
    __builtin_amdgcn_s_setprio(0);
}

struct XaArgs { const bf16* Q; const bf16* K; const bf16* V; bf16* O; };
template <int VAR = 0> __device__ __forceinline__ void xattn_unit(LAS unsigned char* lds, int tid, const XaArgs& A) {
    constexpr int KP = 256 * 2 + 16, VP = 128 * 2 + 64, BUF = 64 * KP + 64 * VP;
    asm volatile("" : "+v"(tid));
    const int lane = tid & 63, w = __builtin_amdgcn_readfirstlane(tid >> 6), r32 = lane & 31, hi = lane >> 5;
    const int tq = 32 * w + r32;
    bf16x8 qf[16];
#pragma unroll
    for (int d0 = 0; d0 < 16; ++d0) qf[d0] = scale_frag(*(const GAS bf16x8*)(A.Q + (size_t)tq * 1024 + d0 * 16 + hi * 8), 0.0625f * LOG2E);
    f32x16 o[4];
#pragma unroll
    for (int b = 0; b < 4; ++b)
#pragma unroll
        for (int r = 0; r < 16; ++r) o[b][r] = 0.f;
    float m = NEGBIG, l = 0.f;
    TileRegs<32> kr; TileRegs<16> vr;
    if (VAR != 4) tile_issue<32>(kr, A.K, 2048, nullptr, 0, tid); if (VAR != 5) tile_issue<16>(vr, A.V, 2048, nullptr, 0, tid);
    __syncthreads();
    for (int kt = 0; kt < 4; ++kt) {
        LAS unsigned char* Kl = lds + (kt & 1) * BUF; LAS unsigned char* Vl = Kl + 64 * KP;
        if (VAR != 4) tile_commit<32>(kr, Kl, KP, tid); if (VAR != 5) tile_commit<16>(vr, Vl, VP, tid);
        __syncthreads();
        if (kt + 1 < 4) { if (VAR != 4) tile_issue<32>(kr, A.K + (size_t)(64 * (kt + 1)) * 2048, 2048, nullptr, 0, tid); if (VAR != 5) tile_issue<16>(vr, A.V + (size_t)(64 * (kt + 1)) * 2048, 2048, nullptr, 0, tid); }
        { f32x16 s0, s1;
          if (VAR != 3) qk64<256, 2>(Kl, KP, qf, s0, s1, lane);
          else {
#pragma unroll
              for (int r = 0; r < 16; ++r) { s0[r] = (float)(r + kt); s1[r] = (float)(r - kt); } }
          __builtin_amdgcn_sched_barrier(0);
          if (VAR != 2) softmax64<4>(s0, s1, m, l, o);
          __builtin_amdgcn_sched_barrier(0);
          if (VAR != 1 && VAR != 2) pv64<128, 1>(o, Vl, VP, s0, s1, lane);
          else { o[0][0] += s0[0] + s1[3]; o[1][1] += s0[5]; }
          __builtin_amdgcn_sched_barrier(0); }
    }
    store_ot<4>(o, __builtin_amdgcn_rcpf(fmaxf(l, 1e-30f)), A.O + (size_t)tq * 1024, lane);
}
struct NsaArgs { const bf16* PROJ; const bf16* KC; const bf16* VC; const float* gate_b; bf16* O; const float* gg; bf16* Mb; };
__device__ __forceinline__ void nsa_unit(LAS unsigned char* lds, int tid, int T0, const NsaArgs& A) {
    constexpr int KP = 144, VP = 192;
    asm volatile("" : "+v"(tid));
    LAS unsigned char* KCl = lds; LAS unsigned char* VCl = lds + 18432; LAS unsigned char* Kl = lds + 43008; LAS unsigned char* Vl = lds + 52224;
    LAS float* impA = (LAS float*)(lds + 86016); LAS float* impB = (LAS float*)(lds + 94464); LAS unsigned* selm = (LAS unsigned*)(lds + 102912); LAS unsigned* uni = (LAS unsigned*)(lds + 103168);
    const int lane = tid & 63, w = __builtin_amdgcn_readfirstlane(tid >> 6), r32 = lane & 31, hi = lane >> 5;
    const int tl = 8 * w + (r32 >> 2), head = r32 & 3, t = T0 + tl, cur = T0 >> 6;
    if (w >= 4) __builtin_amdgcn_s_setprio(1);
    __syncthreads();
    stage_rows<8>(KCl, KP, 128, A.KC, 64, nullptr, 0, tid);
    stage_rows<8>(VCl, VP, 128, A.VC, 64, nullptr, 0, tid);
    for (int i = tid; i < 2 * 64 * 33; i += NTHR) impA[i] = 0.f;
    const bf16* prow = A.PROJ + (size_t)t * NIN;
    bf16x8 qf[4];
#pragma unroll
    for (int d0 = 0; d0 < 4; ++d0) qf[d0] = scale_frag(*(const GAS bf16x8*)(prow + PC_NQ + 64 * head + d0 * 16 + hi * 8), 0.125f * LOG2E);
    const float g0 = fast_sigmoid(b2f(prow[PC_GATE + head]) + A.gate_b[head]), g1 = fast_sigmoid(b2f(prow[PC_GATE + 4 + head]) + A.gate_b[4 + head]),
                g2 = fast_sigmoid(b2f(prow[PC_GATE + 8 + head]) + A.gate_b[8 + head]);
    f32x16 out[2], o[2];
#pragma unroll
    for (int b = 0; b < 2; ++b)
#pragma unroll
        for (int r = 0; r < 16; ++r) { out[b][r] = 0.f; o[b][r] = 0.f; }
    __syncthreads();
    {
        float mx = NEGBIG, sum = 0.f;
#pragma unroll 1
        for (int kt = 0; kt < 4; ++kt) { f32x16 s = qk_tile<64>(KCl + 32 * kt * KP, KP, qf, lane); float tm = NEGBIG;
#pragma unroll
            for (int r = 0; r < 16; ++r) { const int c = 32 * kt + krow(r, hi); const float v = (16 * c + 31 <= t) ? s[r] : NEGBIG; s[r] = v; tm = fmaxf(tm, v); }
            tm = xhalf_max(tm);
            const float mn = fmaxf(mx, tm); float ps = 0.f;
#pragma unroll
            for (int r = 0; r < 16; ++r) ps += (s[r] > -1e29f) ? __builtin_amdgcn_exp2f(s[r] - mn) : 0.f;
            ps = xhalf_sum(ps);
            sum = sum * __builtin_amdgcn_exp2f(mx - mn) + ps; mx = mn; }
        const float inv = __builtin_amdgcn_rcpf(fmaxf(sum, 1e-30f));
#pragma unroll 1
        for (int kt = 0; kt < 4; ++kt) { f32x16 s = qk_tile<64>(KCl + 32 * kt * KP, KP, qf, lane);
#pragma unroll
            for (int r = 0; r < 16; ++r) { const int c = 32 * kt + krow(r, hi); s[r] = (16 * c + 31 <= t) ? __builtin_amdgcn_exp2f(s[r] - mx) * inv : 0.f; }
#pragma unroll
            for (int g = 0; g < 4; ++g) { float gs = (s[4 * g] + s[4 * g + 1]) + (s[4 * g + 2] + s[4 * g + 3]), ls = s[4 * g + 3];
                gs += __shfl_xor(gs, 1); gs += __shfl_xor(gs, 2); ls += __shfl_xor(ls, 1); ls += __shfl_xor(ls, 2);
                const int j = 8 * kt + 2 * g + hi;
                if (head == 0) { impA[tl * 33 + j] = gs; impB[tl * 33 + j + 1] = ls; } }
            pv_tile<64>(o, VCl + 32 * kt * VP, VP, s, lane);
        }
#pragma unroll
        for (int b = 0; b < 2; ++b)
#pragma unroll
            for (int r = 0; r < 16; ++r) { out[b][r] = g0 * o[b][r]; o[b][r] = 0.f; }
    }
    __syncthreads();
    {
        const int tk = tid >> 3, sub = tid & 7; float sc[4];
#pragma unroll
        for (int i = 0; i < 4; ++i) { const int j = 4 * sub + i; float v = impA[tk * 33 + j] + impB[tk * 33 + j]; if (j == 0 || j == cur || j == cur - 1) v = 1e4f; if (j > cur) v = NEGBIG; sc[i] = v; }
        unsigned sel = 0u;
#pragma unroll 1
        for (int it = 0; it < 8; ++it) {
            float best = -3e38f; int bj = 64;
#pragma unroll
            for (int i = 0; i < 4; ++i) { const bool taken = (sel >> (4 * sub + i)) & 1u; if (!taken && sc[i] > best) { best = sc[i]; bj = 4 * sub + i; } }
#pragma unroll
            for (int o2 = 1; o2 < 8; o2 <<= 1) { const float ov = __shfl_xor(best, o2); const int oj = __shfl_xor(bj, o2); if (ov > best || (ov == best && oj < bj)) { best = ov; bj = oj; } }
            sel |= 1u << (bj & 31);
        }
        sel &= (cur >= 31) ? 0xffffffffu : ((1u << (cur + 1)) - 1u);
        if (sub == 0) selm[tk] = sel;
    }
    __syncthreads();
    if (tid < 64) { unsigned un2 = selm[tid];
#pragma unroll
        for (int o2 = 1; o2 < 64; o2 <<= 1) un2 |= __shfl_xor(un2, o2);
        if (tid == 0) uni[0] = un2; }
    __syncthreads();
    const unsigned un = __builtin_amdgcn_readfirstlane(uni[0]);
    const unsigned mysel = selm[tl];
    {
        constexpr int BUF = 64 * KP + 64 * VP;
        unsigned rem = un; int swj = (cur >= 4 ? cur - 4 : 0);
        int j0, md0, j1, md1;
#define NSA_NEXT(jj, mm) do { if (rem) { jj = __builtin_ctz(rem); rem &= rem - 1u; mm = 0; } else if (swj <= cur) { jj = swj++; mm = 1; } else { jj = 0; mm = 2; } } while (0)
        NSA_NEXT(j0, md0);
        TileRegs<8> kr, vr;
        tile_issue<8>(kr, A.PROJ + (size_t)(64 * j0) * NIN + (md0 ? PC_KSWA : PC_KSLC), NIN, nullptr, 0, tid);
        tile_issue<8>(vr, A.PROJ + (size_t)(64 * j0) * NIN + (md0 ? PC_VSWA : PC_VSLC), NIN, nullptr, 0, tid);
        float m = NEGBIG, l = 0.f; int bufi = 0; bool in_sel = true;
        while (md0 != 2) {
            LAS unsigned char* Kb = Kl + bufi * BUF; LAS unsigned char* Vb = Kb + 64 * KP;
            tile_commit<8>(kr, Kb, KP, tid); tile_commit<8>(vr, Vb, VP, tid);
            __syncthreads();
            NSA_NEXT(j1, md1);
            if (md1 != 2) { tile_issue<8>(kr, A.PROJ + (size_t)(64 * j1) * NIN + (md1 ? PC_KSWA : PC_KSLC), NIN, nullptr, 0, tid);
                            tile_issue<8>(vr, A.PROJ + (size_t)(64 * j1) * NIN + (md1 ? PC_VSWA : PC_VSLC), NIN, nullptr, 0, tid); }
            if (md0 == 1 && in_sel) {
                const float f = g1 / fmaxf(l, 1e-30f);
#pragma unroll
                for (int b = 0; b < 2; ++b)
#pragma unroll
                    for (int r = 0; r < 16; ++r) { out[b][r] += f * o[b][r]; o[b][r] = 0.f; }
                m = NEGBIG; l = 0.f; in_sel = false; }
            const bool selbit = md0 ? true : (((mysel >> j0) & 1u) != 0u);
            if (__any(selbit)) {
                f32x16 s0, s1; qk64<64>(Kb, KP, qf, s0, s1, lane);
#pragma unroll
                for (int r = 0; r < 16; ++r) { const int key = 64 * j0 + krow(r, hi);
                    const bool ok0 = md0 ? (key <= t && key > t - 256) : (selbit && key <= t), ok1 = md0 ? (key + 32 <= t && key + 32 > t - 256) : (selbit && key + 32 <= t);
                    s0[r] = ok0 ? s0[r] : NEGBIG; s1[r] = ok1 ? s1[r] : NEGBIG; }
                softmax64<2>(s0, s1, m, l, o);
                pv64<64>(o, Vb, VP, s0, s1, lane);
            }
            j0 = j1; md0 = md1; bufi ^= 1;
        }
#undef NSA_NEXT
        const float f = g2 / fmaxf(l, 1e-30f);
#pragma unroll
        for (int b = 0; b < 2; ++b)
#pragma unroll
            for (int r = 0; r < 16; ++r) out[b][r] += f * o[b][r];
    }
    {
        float ss = 0.f;
#pragma unroll
        for (int b = 0; b < 2; ++b)
#pragma unroll
            for (int r = 0; r < 16; ++r) ss += out[b][r] * out[b][r];
        ss = xhalf_sum(ss); ss += __shfl_xor(ss, 1); ss += __shfl_xor(ss, 2);
        const float rs = __builtin_amdgcn_rsqf(ss * (1.f / 256.f) + NORM_EPS);
#pragma unroll
        for (int b = 0; b < 2; ++b)
#pragma unroll
            for (int g = 0; g < 4; ++g) { const f32x4 gv = *(const GAS f32x4*)(A.gg + 256 + 64 * head + 32 * b + 8 * g + 4 * hi);
#pragma unroll
                for (int e = 0; e < 4; ++e) out[b][4 * g + e] *= rs * gv[e]; }
    }
    store_ot<2>(out, 1.f, A.O + (size_t)t * 1024 + 64 * head, lane);
    {
        const int tk = tid >> 3, part = tid & 7;
#pragma unroll
        for (int grp = 0; grp < 3; grp += 2) {
            bf16* ptr = A.Mb + (size_t)(T0 + tk) * 1024 + 256 * grp + 32 * part; const float* gp = A.gg + 256 * grp + 32 * part;
            v4u w[4]; f32x4 gv[8];
#pragma unroll
            for (int i = 0; i < 4; ++i) w[i] = ((const GAS v4u*)ptr)[i];
#pragma unroll
            for (int i = 0; i < 8; ++i) gv[i] = ((const GAS f32x4*)gp)[i];
            float v[32]; float ss = 0.f;
#pragma unroll
            for (int i = 0; i < 4; ++i) { v[8 * i] = bflo(w[i].x); v[8 * i + 1] = bfhi(w[i].x); v[8 * i + 2] = bflo(w[i].y); v[8 * i + 3] = bfhi(w[i].y); v[8 * i + 4] = bflo(w[i].z); v[8 * i + 5] = bfhi(w[i].z); v[8 * i + 6] = bflo(w[i].w); v[8 * i + 7] = bfhi(w[i].w); }
#pragma unroll
            for (int i = 0; i < 32; ++i) ss += v[i] * v[i];
            ss += __shfl_xor(ss, 1); ss += __shfl_xor(ss, 2); ss += __shfl_xor(ss, 4);
            const float rs = __builtin_amdgcn_rsqf(ss * (1.f / 256.f) + NORM_EPS);
#pragma unroll
            for (int i = 0; i < 4; ++i) { v4u o4; o4.x = pk2(v[8 * i] * rs * gv[2 * i][0], v[8 * i + 1] * rs * gv[2 * i][1]); o4.y = pk2(v[8 * i + 2] * rs * gv[2 * i][2], v[8 * i + 3] * rs * gv[2 * i][3]);
                o4.z = pk2(v[8 * i + 4] * rs * gv[2 * i + 1][0], v[8 * i + 5] * rs * gv[2 * i + 1][1]); o4.w = pk2(v[8 * i + 6] * rs * gv[2 * i + 1][2], v[8 * i + 7] * rs * gv[2 * i + 1][3]); ((GAS v4u*)ptr)[i] = o4; }
        }
    }
    __builtin_amdgcn_s_setprio(0);
}
__device__ __forceinline__ const float* karg_in(int i) { const char* ka = (const char*)__builtin_amdgcn_kernarg_segment_ptr(); asm volatile("" : "+s"(ka)); return *(const float* const*)(ka + 8 * i); }
#define KIN(i) karg_in(i)
#define Wgu1 ((bf16*)(ws + WS_WGU1))
#define Wd1 ((bf16*)(ws + WS_WD1))
#define Wgu2 ((bf16*)(ws + WS_WGU2))
#define Wd2 ((bf16*)(ws + WS_WD2))
#define Win ((bf16*)(ws + WS_WIN))
#define Wout ((bf16*)(ws + WS_WOUT))
#define Wxq ((bf16*)(ws + WS_WXQ))
#define Wxkv ((bf16*)(ws + WS_WXKV))
#define Wxo ((bf16*)(ws + WS_WXO))
#define Wphi ((bf16*)(ws + WS_WPHI))
#define Wuq ((bf16*)(ws + WS_WUQ))
#define Wukv ((bf16*)(ws + WS_WUKV))
#define Wglu ((bf16*)(ws + WS_WGLU))
#define FS5 ((bf16*)(ws + WS_FS5))
#define BTS5 ((bf16*)(ws + WS_BTS5))
#define PHIB ((float*)(ws + WS_MISC + MS_PHIB))
#define A64 ((float*)(ws + WS_MISC + MS_A64))
#define PHIP ((float*)(ws + WS_MISC + MS_PHIP))
#define RSV ((float*)(ws + WS_BIG + BG_SSH))
#define SSYV ((float*)(ws + WS_BIG + BG_SSY))
#define GRPCNT(i) ((unsigned*)(ws + WS_CTL) + CW_GRP + (L * 4 + (i)) * 128)
#define XLN ((PG8_LAS float*)(lds + XCH_OFF))
#define XRN ((const PG8_LAS float*)(lds + XR_OFF))
#define Wphi2 ((bf16*)(ws + WS_MISC + MS_WPHI2))
#define ROPEM ((float*)(ws + WS_MISC + MS_ROPEM))
#define ROPEN ((float*)(ws + WS_MISC + MS_ROPEN))
#define U ((bf16*)(ws + WS_U))
#define ACT ((bf16*)(ws + WS_BIG + BG_ACT))
#define Y ((bf16*)(ws + WS_BIG + BG_Y))
#define HB ((bf16*)(ws + WS_H))
#define PROJ ((bf16*)H)
#define QM ((bf16*)(ws + WS_BIG + BG_QM))
#define KVM ((bf16*)(ws + WS_BIG + BG_KVM))
#define SSQ ((float*)(ws + WS_BIG + BG_SSQ))
#define SSKV ((float*)(ws + WS_BIG + BG_SSKV))
#define US5 ((bf16*)(ws + WS_BIG + BG_US5))
#define S5OUT ((float*)(ws + WS_BIG + BG_S5OUT))
#define YS5 ((bf16*)(ws + WS_BIG + BG_YS5))
#define KCMP ((bf16*)(ws + WS_BIG + BG_KCMP))
#define VCMP ((bf16*)(ws + WS_BIG + BG_VCMP))
#define HIDK ((bf16*)(ws + WS_BIG + BG_HIDK))
#define HIDV ((bf16*)(ws + WS_BIG + BG_HIDV))
#define KC ((bf16*)(ws + WS_BIG + BG_KC))
#define VC ((bf16*)(ws + WS_BIG + BG_VC))
#define XIN ((bf16*)(ws + WS_BIG + BG_XIN))
#define LOGF ((float*)(ws + WS_BIG + BG_LOGF))
#define CUM ((float*)(ws + WS_BIG + BG_CUM))
#define XQ ((bf16*)(ws + WS_BIG + BG_XQ))
#define XO ((bf16*)(ws + WS_BIG + BG_XO))
#define KH ((bf16*)(ws + WS_BIG + BG_KH))
#define VT ((bf16*)(ws + WS_BIG + BG_VT))
#define PX ((bf16*)(ws + WS_BIG + BG_PX))
#define VWO ((bf16*)(ws + WS_VWO))
#define MEMN ((bf16*)(ws + WS_BIG + BG_MEMN))
#define Wxkv1 ((bf16*)(ws + WS_BIG + BG_WXKV1))
#define MEMN1 ((bf16*)(ws + WS_BIG + BG_MEMN1))
#define KH1 ((bf16*)(ws + WS_BIG + BG_KH1))
#define VT1 ((bf16*)(ws + WS_BIG + BG_VT1))
#define KHL ((L == 0) ? KH : KH1)
#define VTL ((L == 0) ? VT : VT1)
#define MIX U
#define ffn1_pre_g (KIN(2) + (size_t)L * (DMODEL))
#define ffn1_wg (KIN(3) + (size_t)L * (DMODEL * FFD))
#define ffn1_wu (KIN(4) + (size_t)L * (DMODEL * FFD))
#define ffn1_wd (KIN(5) + (size_t)L * (FFD * DMODEL))
#define ffn1_post_g (KIN(6) + (size_t)L * (DMODEL))
#define mix_pre_g (KIN(7) + (size_t)L * (DMODEL))
#define mix_w_in (KIN(8) + (size_t)L * (DMODEL * NIN_SRC))
#define mla_qg (KIN(9) + (size_t)L * (192))
#define mla_wuq (KIN(10) + (size_t)L * (192 * 384))
#define mla_kvg (KIN(11) + (size_t)L * (128))
#define mla_wukv (KIN(12) + (size_t)L * (128 * 512))
#define nsa_pos (KIN(13) + (size_t)L * (2 * 2048))
#define nsa_w1 (KIN(14) + (size_t)L * (2 * 2048 * 256))
#define nsa_b1 (KIN(15) + (size_t)L * (2 * 256))
#define nsa_w2 (KIN(16) + (size_t)L * (2 * 256 * 64))
#define nsa_gb (KIN(17) + (size_t)L * (12))
#define fox_fb (KIN(18) + (size_t)L * (4))
#define s5_lre (KIN(19) + (size_t)L * (1024))
#define s5_lim (KIN(20) + (size_t)L * (1024))
#define s5_ldt (KIN(21) + (size_t)L * (16))
#define s5_bre (KIN(22) + (size_t)L * (16384))
#define s5_bim (KIN(23) + (size_t)L * (16384))
#define s5_cre (KIN(24) + (size_t)L * (16384))
#define s5_cim (KIN(25) + (size_t)L * (16384))
#define s5_d (KIN(26) + (size_t)L * (256))
#define s5_gluw (KIN(27) + (size_t)L * (65536))
#define s5_glub (KIN(28) + (size_t)L * (256))
#define mix_gg (KIN(29) + (size_t)L * (1024))
#define mix_wout (KIN(30) + (size_t)L * (DMODEL * DMODEL))
#define mix_post_g (KIN(31) + (size_t)L * (DMODEL))
#define xa_pre_g (KIN(32) + (size_t)L * (DMODEL))
#define xa_mem_g (KIN(33) + (size_t)L * (DMODEL))
#define xa_wq (KIN(34) + (size_t)L * (DMODEL * DMODEL))
#define xa_wkv (KIN(35) + (size_t)L * (DMODEL * 2048))
#define xa_wo (KIN(36) + (size_t)L * (DMODEL * DMODEL))
#define xa_post_g (KIN(37) + (size_t)L * (DMODEL))
#define ffn2_pre_g (KIN(38) + (size_t)L * (DMODEL))
#define ffn2_wg (KIN(39) + (size_t)L * (DMODEL * FFD))
#define ffn2_wu (KIN(40) + (size_t)L * (DMODEL * FFD))
#define ffn2_wd (KIN(41) + (size_t)L * (FFD * DMODEL))
#define ffn2_post_g (KIN(42) + (size_t)L * (DMODEL))
constexpr int NPH = 21, NPHASES = NPH * DEPTH;
struct Args { const float* in[43]; float* out; unsigned char* ws; int ph_lo, ph_hi; };
static_assert(sizeof(Args) == 43 * 8 + 8 + 8 + 8, "Args has no padding");

__global__ void __launch_bounds__(NTHR, 2) fwd_kernel(Args args) {
    extern __shared__ __attribute__((aligned(16))) unsigned char lds_raw[];
    LAS unsigned char* lds = (LAS unsigned char*)lds_raw;
    volatile LAS unsigned* MISC = (volatile LAS unsigned*)(lds + MISC_OFF);
    const int tid0 = threadIdx.x;
    const int G0 = gridDim.x; const int bx0 = blockIdx.x; const int vcu0 = (G0 % 8 == 0) ? (bx0 % 8) * (G0 / 8) + bx0 / 8 : bx0;
    unsigned char* ws0 = args.ws;
#define PH_LOCALS unsigned char* ws = ws0; int tid = tid0, G = G0, bx = bx0, vcu = vcu0; asm volatile("" : "+s"(ws), "+v"(tid), "+s"(G), "+s"(bx), "+s"(vcu)); \
                  const int lane = tid & 63, wave = __builtin_amdgcn_readfirstlane(tid >> 6); \
                  const int gw = vcu * NWAVES + wave, NGW = G * NWAVES; float* H = (float*)karg_in(43); (void)lane; (void)gw; (void)NGW; (void)H; (void)ws; (void)bx
    gu32* ctl = (gu32*)(ws0 + WS_CTL);
    for (int u = tid0; u < (LDS_BYTES - LDSCTL_OFF) / 4; u += NTHR) ((LAS unsigned*)(lds + LDSCTL_OFF))[u] = 0u;
    __syncthreads();
    XcdBarrier bar; bar.bar = (unsigned*)ctl + CW_BAR; bar.x = 0; bar.st = nullptr;
    if (MK_ONE_LAUNCH) bar = xcd_barrier_post((unsigned*)ctl + CW_BAR, MISC + 8);
    const int lo = args.ph_lo, hi = args.ph_hi;

#ifdef MK_ONLY_PHASE
#define IN(k) ((((k) % NPH) == MK_ONLY_PHASE) && lo <= (k) && (k) < hi)
#else
#define IN(k) (lo <= (k) && (k) < hi)
#endif
#ifdef MK_ONLY_SUB
#define SUB(i) (MK_ONLY_SUB == (i))
#else
#define SUB(i) 1
#endif
#ifdef MK_REPEAT_PHASE
#define REPS(k) (((k) == MK_REPEAT_PHASE) ? MK_REPEAT_N : 1)
#else
#define REPS(k) 1
#endif
#ifdef MK_REPEAT_P0PART
#define P0REP(i) (((i) == MK_REPEAT_P0PART) ? 2 : 1)
#else
#define P0REP(i) 1
#endif
#define SEAM(k) do { if (MK_ONE_LAUNCH && IN((k) + 1)) xcd_barrier(bar); } while (0)
#define GEMM_CALL(EPI, SCHED, gg, SS, EE) pg8::gemm_phase<EPI, SCHED, true, true>(lds + RING_OFF, gg, SS, EE)

    {
        constexpr int L = 0;
        const int pb = L * NPH;
        if (L == 0) {
        if (IN(pb + 0)) for (int rep = 0; rep < REPS(0); ++rep) { PH_LOCALS;
#define PRO_SKIP_WD2 0
#define PRO_XKV 0
            {
                S5W W{s5_lre, s5_lim, s5_ldt, s5_bre, s5_bim, s5_cre, s5_cim, BTS5, FS5, A64};
                for (int rp = 0; rp < P0REP(1); ++rp) for (int u = vcu; u < 256; u += G) { const int g = u >> 4, q = u & 15; s5_item((LAS float*)(lds + RING_OFF), tid, g, 4 * q, q == 15 ? 64 : 4 * q + 3, W); }
                __syncthreads();
            }
            LAS float* scr = (LAS float*)(lds + RING_OFF + wave * 16384);
            constexpr int I_G = (DMODEL / 64) * (FFD / 32), I_D = (FFD / 64) * (DMODEL / 32), I_IN = (DMODEL / 64) * (NIN / 32), I_SQ = (DMODEL / 64) * (DMODEL / 32), I_XKV = (DMODEL / 64) * (2048 / 32);
            constexpr int I_UQ = (256 / 64) * (512 / 32), I_UKV = (128 / 64) * (512 / 32), I_PHI = (2048 / 64) * (256 / 32), I_GLU = (256 / 64) * (256 / 32);
            constexpr int I_P2 = (256 / 64) * (256 / 32);
            constexpr int NITEMS = 4 * I_G + 2 * I_D + I_IN + 3 * I_SQ + I_XKV + I_UQ + I_UKV + 2 * I_PHI + 2 * I_P2 + I_GLU;
            for (int rp = 0; rp < P0REP(2); ++rp) for (int it = gw; it < NITEMS; it += NGW) {
                int r = it;
                if (r < I_G) { tr_item(ffn1_wg, DMODEL, FFD, Wgu1, DMODEL, FFD, MAP_GATE, scr, r, lane, ffn1_pre_g); continue; } r -= I_G;
                if (r < I_G) { tr_item(ffn1_wu, DMODEL, FFD, Wgu1, DMODEL, FFD, MAP_UP, scr, r, lane, ffn1_pre_g); continue; } r -= I_G;
                if (r < I_G) { tr_item(ffn2_wg, DMODEL, FFD, Wgu2, DMODEL, FFD, MAP_GATE, scr, r, lane, ffn2_pre_g); continue; } r -= I_G;
                if (r < I_G) { tr_item(ffn2_wu, DMODEL, FFD, Wgu2, DMODEL, FFD, MAP_UP, scr, r, lane, ffn2_pre_g); continue; } r -= I_G;
                if (r < I_D) { tr_item(ffn1_wd, FFD, DMODEL, Wd1, FFD, DMODEL, MAP_ID, scr, r, lane); continue; } r -= I_D;
                if (r < I_D) { if (!PRO_SKIP_WD2) tr_item(ffn2_wd, FFD, DMODEL, Wd2, FFD, DMODEL, MAP_ID, scr, r, lane); continue; } r -= I_D;
                if (r < I_IN) { tr_item(mix_w_in, DMODEL, NIN_SRC, Win, DMODEL, NIN, MAP_WIN, scr, r, lane, mix_pre_g); continue; } r -= I_IN;
                if (r < I_SQ) { tr_item(mix_wout, DMODEL, DMODEL, Wout, DMODEL, DMODEL, MAP_ID, scr, r, lane); continue; } r -= I_SQ;
                if (r < I_SQ) { tr_item(xa_wq, DMODEL, DMODEL, Wxq, DMODEL, DMODEL, MAP_ID, scr, r, lane, xa_pre_g); continue; } r -= I_SQ;
                if (r < I_SQ) { tr_item(xa_wo, DMODEL, DMODEL, Wxo, DMODEL, DMODEL, MAP_ID, scr, r, lane); continue; } r -= I_SQ;
                if (r < I_XKV) { if (PRO_XKV == 0) tr_item(xa_wkv, DMODEL, 2048, Wxkv, DMODEL, 2048, MAP_ID, scr, r, lane);
                    continue; } r -= I_XKV;
                if (r < I_UQ) { tr_item(mla_wuq, 192, 384, Wuq, 256, 512, MAP_UQ, scr, r, lane, mla_qg); continue; } r -= I_UQ;
                if (r < I_UKV) { tr_item(mla_wukv, 128, 512, Wukv, 128, 512, MAP_ID, scr, r, lane, mla_kvg); continue; } r -= I_UKV;
                if (r < I_PHI) { tr_item(nsa_w1, 2048, 256, Wphi, 2048, 256, MAP_ID, scr, r, lane); continue; } r -= I_PHI;
                if (r < I_PHI) { tr_item(nsa_w1 + 2048 * 256, 2048, 256, Wphi + 256 * 2048, 2048, 256, MAP_ID, scr, r, lane); continue; } r -= I_PHI;
                if (r < I_P2) { tr_item(nsa_w2, 256, 64, Wphi2, 256, 256, MAP_ID, scr, r, lane); continue; } r -= I_P2;
                if (r < I_P2) { tr_item(nsa_w2 + 256 * 64, 256, 64, Wphi2 + 256 * 256, 256, 256, MAP_ID, scr, r, lane); continue; } r -= I_P2;
                tr_item(s5_gluw, 256, 256, Wglu, 256, 256, MAP_ID, scr, r, lane);
            }
            if (PRO_XKV == 0) for (int it = gw; it < I_XKV; it += NGW) tr_item(KIN(35) + (size_t)(DMODEL * 2048), DMODEL, 2048, Wxkv1, DMODEL, 2048, MAP_ID, scr, it, lane);
            for (int it = gw; it < 512; it += NGW) phib_part(it, lane, nsa_pos, nsa_w1, PHIP);
#undef PRO_XKV
#undef PRO_SKIP_WD2
            for (int i = bx * NTHR + tid; i < 2048 * 16; i += G * NTHR) rope_fill(ROPEM, 16, i);
            for (int i = bx * NTHR + tid; i < 2048 * 32; i += G * NTHR) rope_fill(ROPEN, 32, i);
            for (int rp = 0; rp < P0REP(3); ++rp) for (int m = gw; m < MTOK; m += 2 * NGW) { const int m2 = m + NGW;
                if (m2 < MTOK) xpass_rows2(lane, KIN(0) + (size_t)m * DMODEL, KIN(0) + (size_t)m2 * DMODEL, HB + (size_t)m * DMODEL, HB + (size_t)m2 * DMODEL, RSV + 4 * (size_t)m, RSV + 4 * (size_t)m2);
                else norm_row(lane, nullptr, nullptr, KIN(0) + (size_t)m * DMODEL, HB + (size_t)m * DMODEL, nullptr, nullptr, 0.f, RSV + 4 * (size_t)m); }
        }
        SEAM(pb + 0);
        }
        if (IN(pb + 1)) for (int rep = 0; rep < REPS(1); ++rep) { PH_LOCALS; pg8::Gemm g{HB, Wgu1, MTOK, 2 * FFD, DMODEL, DMODEL}; pg8::StaticOrder S; S.init(MTOK, 2 * FFD, G, bx); pg8::EpiSwiGLU E{ACT, FFD, RSV, XRN};
            GEMM_CALL(pg8::EpiSwiGLU, pg8::StaticOrder, g, S, E); }
        if (L > 0 && IN(pb + 1)) { PH_LOCALS; LAS float* scr = (LAS float*)(lds + RING_OFF + wave * 16384);
            for (int it = gw; it < (FFD / 64) * (DMODEL / 32); it += NGW) tr_item(ffn2_wd, FFD, DMODEL, Wd2, FFD, DMODEL, MAP_ID, scr, it, lane); }
        SEAM(pb + 1);
        if (IN(pb + 2)) { PH_LOCALS; pg8::Gemm g{ACT, Wd1, MTOK, DMODEL, FFD, FFD}; pg8::StaticOrder S; S.init(MTOK, DMODEL, G, bx); pg8::EpiNormRes E{HB, HB, nullptr, ffn1_post_g, 0.5f, SSYV, RSV, GRPCNT(0), XLN};
            GEMM_CALL(pg8::EpiNormRes, pg8::StaticOrder, g, S, E); }
        SEAM(pb + 3);
        if (IN(pb + 4)) for (int rep = 0; rep < REPS(4); ++rep) { PH_LOCALS; pg8::Gemm g{HB, Win, MTOK, NIN, DMODEL, DMODEL}; pg8::StaticOrder S; S.init(MTOK, NIN, G, bx);
            pg8::EpiWin E{PROJ, KCMP, VCMP, US5, LOGF, SSQ, SSKV, ROPEM, ROPEN, fox_fb, MTOK, RSV, XRN};
            GEMM_CALL(pg8::EpiWin, pg8::StaticOrder, g, S, E);
            for (int i = bx * NTHR + tid; i < 32 * 64; i += G * NTHR) { KCMP[(size_t)MTOK * 64 + i] = 0; VCMP[(size_t)MTOK * 64 + i] = 0; }
            for (int i = bx * NTHR + tid; i < 512; i += G * NTHR) phib_final(i, PHIP, nsa_b1, PHIB); }
        SEAM(pb + 4);
        if (IN(pb + 6)) for (int rep = 0; rep < REPS(6); ++rep) { PH_LOCALS;
            const int c0 = (G * 80) / 256, c1 = c0 + (G * 64) / 256, c2 = c1 + (G * 96) / 256, c3 = c2 + (G * 8) / 256;
            const int far = 1 << 28;
            if (SUB(0)) { pg8::Gemm g{PROJ + PC_CQ, Wuq, MTOK, 512, 256, NIN}; pg8::StaticOrder S; S.init(MTOK, 512, c0, bx < c0 ? bx : far); pg8::EpiRowScale<true> E{QM, 512, SSQ, 6, 1.f / 192.f, ROPEM}; GEMM_CALL(pg8::EpiRowScale<true>, pg8::StaticOrder, g, S, E); }
            if (SUB(1)) { pg8::Gemm g{PROJ + PC_CKV, Wukv, MTOK, 512, 128, NIN}; pg8::StaticOrder S; S.init(MTOK, 512, c1 - c0, (bx >= c0 && bx < c1) ? bx - c0 : far); pg8::EpiRowScale<false> E{KVM, 512, SSKV, 4, 1.f / 128.f, nullptr}; GEMM_CALL(pg8::EpiRowScale<false>, pg8::StaticOrder, g, S, E); }
            if (SUB(2)) { pg8::Gemm g{US5, BTS5, 16 * 512, 16 * 1280, 1024, 1024}; pg8::BatchOrder S; S.init(16, 2, 5, c2 - c1, (bx >= c1 && bx < c2) ? bx - c1 : far); pg8::EpiS5Loc E{S5OUT}; GEMM_CALL(pg8::EpiS5Loc, pg8::BatchOrder, g, S, E);
                asm volatile("s_waitcnt vmcnt(0)" ::: "memory"); __syncthreads();
                if (bx >= c1 && bx < c2) for (int L2 = bx - c1; L2 < 160; L2 += c2 - c1) { const int bt = L2 / 10, r = L2 % 10; if (r % 5 == 4) s5_carry_blk(tid, bt, r / 5, S5OUT, A64, XIN); } }
            if (SUB(3)) { pg8::Gemm g{KCMP, Wphi, 2048, 256, 2048, 1024}; pg8::StaticOrder S; S.init(2048, 256, c3 - c2, (bx >= c2 && bx < c3) ? bx - c2 : far); pg8::EpiGeluBias E{HIDK, 256, PHIB}; GEMM_CALL(pg8::EpiGeluBias, pg8::StaticOrder, g, S, E); }
            if (SUB(4)) { pg8::Gemm g{VCMP, Wphi + 256 * 2048, 2048, 256, 2048, 1024}; pg8::StaticOrder S; S.init(2048, 256, G - c3, bx >= c3 ? bx - c3 : far); pg8::EpiGeluBias E{HIDV, 256, PHIB + 256}; GEMM_CALL(pg8::EpiGeluBias, pg8::StaticOrder, g, S, E); }
            if (SUB(5)) for (int s = gw; s < 64; s += NGW) cumsum_seq(lane, LOGF + (size_t)s * SEQ, CUM + (size_t)s * SEQ);
        }
        SEAM(pb + 6);
        if (IN(pb + 8)) for (int rep = 0; rep < REPS(8); ++rep) { PH_LOCALS;
            { pg8::Gemm g{HIDK, Wphi2, 2048, 256, 256, 256}; pg8::StaticOrder S; S.init(2048, 256, G, (bx + 16) % G); pg8::EpiStoreN64 E{KC}; GEMM_CALL(pg8::EpiStoreN64, pg8::StaticOrder, g, S, E); }
            { pg8::Gemm g{HIDV, Wphi2 + 256 * 256, 2048, 256, 256, 256}; pg8::StaticOrder S; S.init(2048, 256, G, (bx + 8) % G); pg8::EpiStoreN64 E{VC}; GEMM_CALL(pg8::EpiStoreN64, pg8::StaticOrder, g, S, E); }
            if (SUB(0)) { pg8::Gemm g{XIN, FS5, 16 * 512, 16 * 1024, 128, 128}; pg8::BatchOrder S; S.init(16, 2, 4, G, bx); pg8::EpiS5Carry E{S5OUT, US5, s5_d, YS5, MTOK}; GEMM_CALL(pg8::EpiS5Carry, pg8::BatchOrder, g, S, E); }
            if (SUB(1)) for (int it = vcu; it < 256; it += G) { const int b = it >> 4, h = (it >> 2) & 3, pp = it & 3; const size_t rb = (size_t)b * SEQ;
                CausalArgs A{QM + rb * 512 + 96 * h, 512, KVM + rb * 512 + 128 * h, 512, PROJ + rb * NIN + PC_KPE, NIN, KVM + rb * 512 + 128 * h + 64, 512, nullptr, MIX + rb * 1024 + 64 * h, 1024, 0.10206207261596575f * LOG2E};
                causal_unit<96, false>(lds + RING_OFF, tid, pp, A); causal_unit<96, false>(lds + RING_OFF, tid, 7 - pp, A); }
            if (SUB(2)) for (int it = vcu; it < 256; it += G) { const int b = it >> 4, h = (it >> 2) & 3, pp = it & 3; const size_t rb = (size_t)b * SEQ;
                CausalArgs A{PROJ + rb * NIN + PC_FQ + 64 * h, NIN, PROJ + rb * NIN + PC_FK + 64 * h, NIN, nullptr, 0, PROJ + rb * NIN + PC_FV + 64 * h, NIN, CUM + ((size_t)b * 4 + h) * SEQ, MIX + rb * 1024 + 512 + 64 * h, 1024, 0.125f * LOG2E};
                causal_unit<64, true>(lds + RING_OFF, tid, pp, A); causal_unit<64, true>(lds + RING_OFF, tid, 7 - pp, A); }
            __syncthreads();
        }
        SEAM(pb + 8);
        if (IN(pb + 9)) for (int rep = 0; rep < REPS(9); ++rep) { PH_LOCALS;
            if (SUB(0)) { pg8::Gemm g{YS5, Wglu, MTOK, 256, 256, 256}; pg8::StaticOrder S; S.init(MTOK, 256, G, bx); pg8::EpiGLUNorm E{YS5, s5_glub, mix_gg + 768, MIX, 1024, 768, (PG8_LAS float*)(lds + XCH_OFF)}; GEMM_CALL(pg8::EpiGLUNorm, pg8::StaticOrder, g, S, E); }
            if (SUB(1)) for (int it = vcu; it < 512; it += G) { const int i2 = it & 255, b = i2 >> 4, T0 = (it < 256 ? (i2 & 15) : 31 - (i2 & 15)) * 64; const size_t rb = (size_t)b * SEQ;
                NsaArgs A{PROJ + rb * NIN, KC + (size_t)b * 128 * 64, VC + (size_t)b * 128 * 64, nsa_gb, MIX + rb * 1024 + 256, mix_gg, MIX + rb * 1024};
                nsa_unit(lds + RING_OFF, tid, T0, A); }
            __syncthreads();
        }
        SEAM(pb + 9);
        if (IN(pb + 11)) { PH_LOCALS; pg8::Gemm g{MIX, Wout, MTOK, DMODEL, DMODEL, DMODEL}; pg8::StaticOrder S; S.init(MTOK, DMODEL, G, bx); pg8::EpiNormRes E{HB, HB, nullptr, mix_post_g, 1.0f, SSYV, RSV, GRPCNT(1), XLN};
            GEMM_CALL(pg8::EpiNormRes, pg8::StaticOrder, g, S, E);
            if (L == 0) for (int m = gw; m < MROWS; m += NGW) { norm_only_row(lane, KIN(1) + (size_t)m * DMODEL, xa_mem_g, MEMN + (size_t)m * DMODEL);
                norm_only_row(lane, KIN(1) + (size_t)m * DMODEL, KIN(33) + (size_t)DMODEL, MEMN1 + (size_t)m * DMODEL); }
        }
        SEAM(pb + 12);
        if (IN(pb + 13)) for (int rep = 0; rep < REPS(13); ++rep) { PH_LOCALS;
            if (SUB(0)) { pg8::Gemm g{HB, Wxq, MTOK, DMODEL, DMODEL, DMODEL}; pg8::StaticOrder S; S.init(MTOK, DMODEL, G, bx); pg8::EpiStoreScaled E{XQ, DMODEL, RSV, 0.0625f * LOG2E, XRN}; GEMM_CALL(pg8::EpiStoreScaled, pg8::StaticOrder, g, S, E); }
            if (L == 0 && SUB(1)) { pg8::Gemm g{MEMN, Wxkv, MROWS, DMODEL, DMODEL, DMODEL}; pg8::StaticOrder S; S.init(MROWS, DMODEL, G, bx); pg8::EpiKH E{KH, MROWS}; GEMM_CALL(pg8::EpiKH, pg8::StaticOrder, g, S, E); }
            if (L == 0 && SUB(2)) { pg8::Gemm g{MEMN, Wxkv + (size_t)DMODEL * DMODEL, MROWS, DMODEL, DMODEL, DMODEL}; pg8::StaticOrder S; S.init(MROWS, DMODEL, G, (bx + 64) % G); pg8::EpiKH E{VT, MROWS}; GEMM_CALL(pg8::EpiKH, pg8::StaticOrder, g, S, E); }
        }
        if (L == 0 && IN(pb + 13)) { PH_LOCALS;
            { pg8::Gemm g{MEMN1, Wxkv1, MROWS, DMODEL, DMODEL, DMODEL}; pg8::StaticOrder S; S.init(MROWS, DMODEL, G, (bx + 192) % G); pg8::EpiKH E{KH1, MROWS}; GEMM_CALL(pg8::EpiKH, pg8::StaticOrder, g, S, E); }
            { pg8::Gemm g{MEMN1, Wxkv1 + (size_t)DMODEL * DMODEL, MROWS, DMODEL, DMODEL, DMODEL}; pg8::StaticOrder S; S.init(MROWS, DMODEL, G, (bx + 128) % G); pg8::EpiKH E{VT1, MROWS}; GEMM_CALL(pg8::EpiKH, pg8::StaticOrder, g, S, E); }
        }
        SEAM(pb + 13);
        if (IN(pb + 14)) for (int rep = 0; rep < REPS(14); ++rep) { PH_LOCALS; const int q4 = G / 4, far = 1 << 28;
#pragma unroll
            for (int h = 0; h < 4; ++h) { const int lo4 = h * q4, hi4 = (h == 3) ? G : lo4 + q4;
                pg8::Gemm g{XQ + 256 * h, KHL + (size_t)h * MROWS * 256, MTOK, MROWS, 256, DMODEL}; pg8::BatchOrder S; S.init(16, 8, 1, hi4 - lo4, (bx >= lo4 && bx < hi4) ? bx - lo4 : far);
                pg8::EpiSoftmaxP E{PX, DMODEL, 256 * h, (PG8_LAS float*)(lds + XCH_OFF)}; GEMM_CALL(pg8::EpiSoftmaxP, pg8::BatchOrder, g, S, E); }
#pragma unroll
            for (int h = 0; h < 4; ++h) { const int lo4 = h * q4, hi4 = (h == 3) ? G : lo4 + q4;
                pg8::Gemm g{Wxo + 256 * h, VTL + (size_t)h * MROWS * 256, DMODEL, MROWS, 256, DMODEL}; pg8::StaticOrder S; S.init(DMODEL, MROWS, hi4 - lo4, (bx >= lo4 && bx < hi4) ? bx - lo4 : far);
                pg8::EpiVWo E{VWO, h}; GEMM_CALL(pg8::EpiVWo, pg8::StaticOrder, g, S, E); }
        }
        SEAM(pb + 14);
        if (IN(pb + 15)) { PH_LOCALS;
            pg8::Gemm g{PX, VWO, MTOK, 16 * DMODEL, DMODEL, DMODEL}; pg8::BatchOrderCM S; S.init(16, 8, 4, G, bx); pg8::EpiNormRes E{HB, HB, nullptr, xa_post_g, 1.0f, SSYV, RSV, GRPCNT(2), XLN}; GEMM_CALL(pg8::EpiNormRes, pg8::BatchOrderCM, g, S, E); }
        SEAM(pb + 17);
        if (IN(pb + 18)) for (int rep = 0; rep < REPS(18); ++rep) { PH_LOCALS; pg8::Gemm g{HB, Wgu2, MTOK, 2 * FFD, DMODEL, DMODEL}; pg8::StaticOrder S; S.init(MTOK, 2 * FFD, G, bx); pg8::EpiSwiGLU E{ACT, FFD, RSV, XRN};
            GEMM_CALL(pg8::EpiSwiGLU, pg8::StaticOrder, g, S, E); }
        SEAM(pb + 18);
        if (IN(pb + 19)) { PH_LOCALS; pg8::Gemm g{ACT, Wd2, MTOK, DMODEL, FFD, FFD}; pg8::StaticOrder S; S.init(MTOK, DMODEL, G, bx);
            pg8::EpiNormRes E{HB, (L + 1 < DEPTH) ? HB : nullptr, (L + 1 < DEPTH) ? nullptr : H, ffn2_post_g, 0.5f, SSYV, (L + 1 < DEPTH) ? RSV : nullptr, GRPCNT(3), XLN};
            GEMM_CALL(pg8::EpiNormRes, pg8::StaticOrder, g, S, E); }
        if (L + 1 < DEPTH) {
        if (IN(pb + 20)) { PH_LOCALS;
            { constexpr int Lnext = L + 1; { constexpr int L = Lnext;
#define PRO_SKIP_WD2 1
#define PRO_XKV 1
            {
                S5W W{s5_lre, s5_lim, s5_ldt, s5_bre, s5_bim, s5_cre, s5_cim, BTS5, FS5, A64};
                for (int rp = 0; rp < P0REP(1); ++rp) for (int u = vcu; u < 256; u += G) { const int g = u >> 4, q = u & 15; s5_item((LAS float*)(lds + RING_OFF), tid, g, 4 * q, q == 15 ? 64 : 4 * q + 3, W); }
                __syncthreads();
            }
            LAS float* scr = (LAS float*)(lds + RING_OFF + wave * 16384);
            constexpr int I_G = (DMODEL / 64) * (FFD / 32), I_D = (FFD / 64) * (DMODEL / 32), I_IN = (DMODEL / 64) * (NIN / 32), I_SQ = (DMODEL / 64) * (DMODEL / 32), I_XKV = (DMODEL / 64) * (2048 / 32);
            constexpr int I_UQ = (256 / 64) * (512 / 32), I_UKV = (128 / 64) * (512 / 32), I_PHI = (2048 / 64) * (256 / 32), I_GLU = (256 / 64) * (256 / 32);
            constexpr int I_P2 = (256 / 64) * (256 / 32);
            constexpr int NITEMS = 4 * I_G + 2 * I_D + I_IN + 3 * I_SQ + I_XKV + I_UQ + I_UKV + 2 * I_PHI + 2 * I_P2 + I_GLU;
            for (int rp = 0; rp < P0REP(2); ++rp) for (int it = gw; it < NITEMS; it += NGW) {
                int r = it;
                if (r < I_G) { tr_item(ffn1_wg, DMODEL, FFD, Wgu1, DMODEL, FFD, MAP_GATE, scr, r, lane, ffn1_pre_g); continue; } r -= I_G;
                if (r < I_G) { tr_item(ffn1_wu, DMODEL, FFD, Wgu1, DMODEL, FFD, MAP_UP, scr, r, lane, ffn1_pre_g); continue; } r -= I_G;
                if (r < I_G) { tr_item(ffn2_wg, DMODEL, FFD, Wgu2, DMODEL, FFD, MAP_GATE, scr, r, lane, ffn2_pre_g); continue; } r -= I_G;
                if (r < I_G) { tr_item(ffn2_wu, DMODEL, FFD, Wgu2, DMODEL, FFD, MAP_UP, scr, r, lane, ffn2_pre_g); continue; } r -= I_G;
                if (r < I_D) { tr_item(ffn1_wd, FFD, DMODEL, Wd1, FFD, DMODEL, MAP_ID, scr, r, lane); continue; } r -= I_D;
                if (r < I_D) { if (!PRO_SKIP_WD2) tr_item(ffn2_wd, FFD, DMODEL, Wd2, FFD, DMODEL, MAP_ID, scr, r, lane); continue; } r -= I_D;
                if (r < I_IN) { tr_item(mix_w_in, DMODEL, NIN_SRC, Win, DMODEL, NIN, MAP_WIN, scr, r, lane, mix_pre_g); continue; } r -= I_IN;
                if (r < I_SQ) { tr_item(mix_wout, DMODEL, DMODEL, Wout, DMODEL, DMODEL, MAP_ID, scr, r, lane); continue; } r -= I_SQ;
                if (r < I_SQ) { tr_item(xa_wq, DMODEL, DMODEL, Wxq, DMODEL, DMODEL, MAP_ID, scr, r, lane, xa_pre_g); continue; } r -= I_SQ;
                if (r < I_SQ) { tr_item(xa_wo, DMODEL, DMODEL, Wxo, DMODEL, DMODEL, MAP_ID, scr, r, lane); continue; } r -= I_SQ;
                if (r < I_XKV) { if (PRO_XKV == 0) tr_item(xa_wkv, DMODEL, 2048, Wxkv, DMODEL, 2048, MAP_ID, scr, r, lane);
                    continue; } r -= I_XKV;
                if (r < I_UQ) { tr_item(mla_wuq, 192, 384, Wuq, 256, 512, MAP_UQ, scr, r, lane, mla_qg); continue; } r -= I_UQ;
                if (r < I_UKV) { tr_item(mla_wukv, 128, 512, Wukv, 128, 512, MAP_ID, scr, r, lane, mla_kvg); continue; } r -= I_UKV;
                if (r < I_PHI) { tr_item(nsa_w1, 2048, 256, Wphi, 2048, 256, MAP_ID, scr, r, lane); continue; } r -= I_PHI;
                if (r < I_PHI) { tr_item(nsa_w1 + 2048 * 256, 2048, 256, Wphi + 256 * 2048, 2048, 256, MAP_ID, scr, r, lane); continue; } r -= I_PHI;
                if (r < I_P2) { tr_item(nsa_w2, 256, 64, Wphi2, 256, 256, MAP_ID, scr, r, lane); continue; } r -= I_P2;
                if (r < I_P2) { tr_item(nsa_w2 + 256 * 64, 256, 64, Wphi2 + 256 * 256, 256, 256, MAP_ID, scr, r, lane); continue; } r -= I_P2;
                tr_item(s5_gluw, 256, 256, Wglu, 256, 256, MAP_ID, scr, r, lane);
            }
            if (PRO_XKV == 0) for (int it = gw; it < I_XKV; it += NGW) tr_item(KIN(35) + (size_t)(DMODEL * 2048), DMODEL, 2048, Wxkv1, DMODEL, 2048, MAP_ID, scr, it, lane);
            for (int it = gw; it < 512; it += NGW) phib_part(it, lane, nsa_pos, nsa_w1, PHIP);
#undef PRO_XKV
#undef PRO_SKIP_WD2
            } }
        }
        SEAM(pb + 20);
        }
    }
    {
        constexpr int L = 1;
        const int pb = L * NPH;
        if (L == 0) {
        if (IN(pb + 0)) for (int rep = 0; rep < REPS(0); ++rep) { PH_LOCALS;
#define PRO_SKIP_WD2 0
#define PRO_XKV 0
            {
                S5W W{s5_lre, s5_lim, s5_ldt, s5_bre, s5_bim, s5_cre, s5_cim, BTS5, FS5, A64};
                for (int rp = 0; rp < P0REP(1); ++rp) for (int u = vcu; u < 256; u += G) { const int g = u >> 4, q = u & 15; s5_item((LAS float*)(lds + RING_OFF), tid, g, 4 * q, q == 15 ? 64 : 4 * q + 3, W); }
                __syncthreads();
            }
            LAS float* scr = (LAS float*)(lds + RING_OFF + wave * 16384);
            constexpr int I_G = (DMODEL / 64) * (FFD / 32), I_D = (FFD / 64) * (DMODEL / 32), I_IN = (DMODEL / 64) * (NIN / 32), I_SQ = (DMODEL / 64) * (DMODEL / 32), I_XKV = (DMODEL / 64) * (2048 / 32);
            constexpr int I_UQ = (256 / 64) * (512 / 32), I_UKV = (128 / 64) * (512 / 32), I_PHI = (2048 / 64) * (256 / 32), I_GLU = (256 / 64) * (256 / 32);
            constexpr int I_P2 = (256 / 64) * (256 / 32);
            constexpr int NITEMS = 4 * I_G + 2 * I_D + I_IN + 3 * I_SQ + I_XKV + I_UQ + I_UKV + 2 * I_PHI + 2 * I_P2 + I_GLU;
            for (int rp = 0; rp < P0REP(2); ++rp) for (int it = gw; it < NITEMS; it += NGW) {
                int r = it;
                if (r < I_G) { tr_item(ffn1_wg, DMODEL, FFD, Wgu1, DMODEL, FFD, MAP_GATE, scr, r, lane, ffn1_pre_g); continue; } r -= I_G;
                if (r < I_G) { tr_item(ffn1_wu, DMODEL, FFD, Wgu1, DMODEL, FFD, MAP_UP, scr, r, lane, ffn1_pre_g); continue; } r -= I_G;
                if (r < I_G) { tr_item(ffn2_wg, DMODEL, FFD, Wgu2, DMODEL, FFD, MAP_GATE, scr, r, lane, ffn2_pre_g); continue; } r -= I_G;
                if (r < I_G) { tr_item(ffn2_wu, DMODEL, FFD, Wgu2, DMODEL, FFD, MAP_UP, scr, r, lane, ffn2_pre_g); continue; } r -= I_G;
                if (r < I_D) { tr_item(ffn1_wd, FFD, DMODEL, Wd1, FFD, DMODEL, MAP_ID, scr, r, lane); continue; } r -= I_D;
                if (r < I_D) { if (!PRO_SKIP_WD2) tr_item(ffn2_wd, FFD, DMODEL, Wd2, FFD, DMODEL, MAP_ID, scr, r, lane); continue; } r -= I_D;
                if (r < I_IN) { tr_item(mix_w_in, DMODEL, NIN_SRC, Win, DMODEL, NIN, MAP_WIN, scr, r, lane, mix_pre_g); continue; } r -= I_IN;
                if (r < I_SQ) { tr_item(mix_wout, DMODEL, DMODEL, Wout, DMODEL, DMODEL, MAP_ID, scr, r, lane); continue; } r -= I_SQ;
                if (r < I_SQ) { tr_item(xa_wq, DMODEL, DMODEL, Wxq, DMODEL, DMODEL, MAP_ID, scr, r, lane, xa_pre_g); continue; } r -= I_SQ;
                if (r < I_SQ) { tr_item(xa_wo, DMODEL, DMODEL, Wxo, DMODEL, DMODEL, MAP_ID, scr, r, lane); continue; } r -= I_SQ;
                if (r < I_XKV) { if (PRO_XKV == 0) tr_item(xa_wkv, DMODEL, 2048, Wxkv, DMODEL, 2048, MAP_ID, scr, r, lane);
                    continue; } r -= I_XKV;
                if (r < I_UQ) { tr_item(mla_wuq, 192, 384, Wuq, 256, 512, MAP_UQ, scr, r, lane, mla_qg); continue; } r -= I_UQ;
                if (r < I_UKV) { tr_item(mla_wukv, 128, 512, Wukv, 128, 512, MAP_ID, scr, r, lane, mla_kvg); continue; } r -= I_UKV;
                if (r < I_PHI) { tr_item(nsa_w1, 2048, 256, Wphi, 2048, 256, MAP_ID, scr, r, lane); continue; } r -= I_PHI;
                if (r < I_PHI) { tr_item(nsa_w1 + 2048 * 256, 2048, 256, Wphi + 256 * 2048, 2048, 256, MAP_ID, scr, r, lane); continue; } r -= I_PHI;
                if (r < I_P2) { tr_item(nsa_w2, 256, 64, Wphi2, 256, 256, MAP_ID, scr, r, lane); continue; } r -= I_P2;
                if (r < I_P2) { tr_item(nsa_w2 + 256 * 64, 256, 64, Wphi2 + 256 * 256, 256, 256, MAP_ID, scr, r, lane); continue; } r -= I_P2;
                tr_item(s5_gluw, 256, 256, Wglu, 256, 256, MAP_ID, scr, r, lane);
            }
            if (PRO_XKV == 0) for (int it = gw; it < I_XKV; it += NGW) tr_item(KIN(35) + (size_t)(DMODEL * 2048), DMODEL, 2048, Wxkv1, DMODEL, 2048, MAP_ID, scr, it, lane);
            for (int it = gw; it < 512; it += NGW) phib_part(it, lane, nsa_pos, nsa_w1, PHIP);
#undef PRO_XKV
#undef PRO_SKIP_WD2
            for (int i = bx * NTHR + tid; i < 2048 * 16; i += G * NTHR) rope_fill(ROPEM, 16, i);
            for (int i = bx * NTHR + tid; i < 2048 * 32; i += G * NTHR) rope_fill(ROPEN, 32, i);
            for (int rp = 0; rp < P0REP(3); ++rp) for (int m = gw; m < MTOK; m += 2 * NGW) { const int m2 = m + NGW;
                if (m2 < MTOK) xpass_rows2(lane, KIN(0) + (size_t)m * DMODEL, KIN(0) + (size_t)m2 * DMODEL, HB + (size_t)m * DMODEL, HB + (size_t)m2 * DMODEL, RSV + 4 * (size_t)m, RSV + 4 * (size_t)m2);
                else norm_row(lane, nullptr, nullptr, KIN(0) + (size_t)m * DMODEL, HB + (size_t)m * DMODEL, nullptr, nullptr, 0.f, RSV + 4 * (size_t)m); }
        }
        SEAM(pb + 0);
        }
        if (IN(pb + 1)) for (int rep = 0; rep < REPS(1); ++rep) { PH_LOCALS; pg8::Gemm g{HB, Wgu1, MTOK, 2 * FFD, DMODEL, DMODEL}; pg8::StaticOrder S; S.init(MTOK, 2 * FFD, G, bx); pg8::EpiSwiGLU E{ACT, FFD, RSV, XRN};
            GEMM_CALL(pg8::EpiSwiGLU, pg8::StaticOrder, g, S, E); }
        if (L > 0 && IN(pb + 1)) { PH_LOCALS; LAS float* scr = (LAS float*)(lds + RING_OFF + wave * 16384);
            for (int it = gw; it < (FFD / 64) * (DMODEL / 32); it += NGW) tr_item(ffn2_wd, FFD, DMODEL, Wd2, FFD, DMODEL, MAP_ID, scr, it, lane); }
        SEAM(pb + 1);
        if (IN(pb + 2)) { PH_LOCALS; pg8::Gemm g{ACT, Wd1, MTOK, DMODEL, FFD, FFD}; pg8::StaticOrder S; S.init(MTOK, DMODEL, G, bx); pg8::EpiNormRes E{HB, HB, nullptr, ffn1_post_g, 0.5f, SSYV, RSV, GRPCNT(0), XLN};
            GEMM_CALL(pg8::EpiNormRes, pg8::StaticOrder, g, S, E); }
        SEAM(pb + 3);
        if (IN(pb + 4)) for (int rep = 0; rep < REPS(4); ++rep) { PH_LOCALS; pg8::Gemm g{HB, Win, MTOK, NIN, DMODEL, DMODEL}; pg8::StaticOrder S; S.init(MTOK, NIN, G, bx);
            pg8::EpiWin E{PROJ, KCMP, VCMP, US5, LOGF, SSQ, SSKV, ROPEM, ROPEN, fox_fb, MTOK, RSV, XRN};
            GEMM_CALL(pg8::EpiWin, pg8::StaticOrder, g, S, E);
            for (int i = bx * NTHR + tid; i < 32 * 64; i += G * NTHR) { KCMP[(size_t)MTOK * 64 + i] = 0; VCMP[(size_t)MTOK * 64 + i] = 0; }
            for (int i = bx * NTHR + tid; i < 512; i += G * NTHR) phib_final(i, PHIP, nsa_b1, PHIB); }
        SEAM(pb + 4);
        if (IN(pb + 6)) for (int rep = 0; rep < REPS(6); ++rep) { PH_LOCALS;
            const int c0 = (G * 80) / 256, c1 = c0 + (G * 64) / 256, c2 = c1 + (G * 96) / 256, c3 = c2 + (G * 8) / 256;
            const int far = 1 << 28;
            if (SUB(0)) { pg8::Gemm g{PROJ + PC_CQ, Wuq, MTOK, 512, 256, NIN}; pg8::StaticOrder S; S.init(MTOK, 512, c0, bx < c0 ? bx : far); pg8::EpiRowScale<true> E{QM, 512, SSQ, 6, 1.f / 192.f, ROPEM}; GEMM_CALL(pg8::EpiRowScale<true>, pg8::StaticOrder, g, S, E); }
            if (SUB(1)) { pg8::Gemm g{PROJ + PC_CKV, Wukv, MTOK, 512, 128, NIN}; pg8::StaticOrder S; S.init(MTOK, 512, c1 - c0, (bx >= c0 && bx < c1) ? bx - c0 : far); pg8::EpiRowScale<false> E{KVM, 512, SSKV, 4, 1.f / 128.f, nullptr}; GEMM_CALL(pg8::EpiRowScale<false>, pg8::StaticOrder, g, S, E); }
            if (SUB(2)) { pg8::Gemm g{US5, BTS5, 16 * 512, 16 * 1280, 1024, 1024}; pg8::BatchOrder S; S.init(16, 2, 5, c2 - c1, (bx >= c1 && bx < c2) ? bx - c1 : far); pg8::EpiS5Loc E{S5OUT}; GEMM_CALL(pg8::EpiS5Loc, pg8::BatchOrder, g, S, E);
                asm volatile("s_waitcnt vmcnt(0)" ::: "memory"); __syncthreads();
                if (bx >= c1 && bx < c2) for (int L2 = bx - c1; L2 < 160; L2 += c2 - c1) { const int bt = L2 / 10, r = L2 % 10; if (r % 5 == 4) s5_carry_blk(tid, bt, r / 5, S5OUT, A64, XIN); } }
            if (SUB(3)) { pg8::Gemm g{KCMP, Wphi, 2048, 256, 2048, 1024}; pg8::StaticOrder S; S.init(2048, 256, c3 - c2, (bx >= c2 && bx < c3) ? bx - c2 : far); pg8::EpiGeluBias E{HIDK, 256, PHIB}; GEMM_CALL(pg8::EpiGeluBias, pg8::StaticOrder, g, S, E); }
            if (SUB(4)) { pg8::Gemm g{VCMP, Wphi + 256 * 2048, 2048, 256, 2048, 1024}; pg8::StaticOrder S; S.init(2048, 256, G - c3, bx >= c3 ? bx - c3 : far); pg8::EpiGeluBias E{HIDV, 256, PHIB + 256}; GEMM_CALL(pg8::EpiGeluBias, pg8::StaticOrder, g, S, E); }
            if (SUB(5)) for (int s = gw; s < 64; s += NGW) cumsum_seq(lane, LOGF + (size_t)s * SEQ, CUM + (size_t)s * SEQ);
        }
        SEAM(pb + 6);
        if (IN(pb + 8)) for (int rep = 0; rep < REPS(8); ++rep) { PH_LOCALS;
            { pg8::Gemm g{HIDK, Wphi2, 2048, 256, 256, 256}; pg8::StaticOrder S; S.init(2048, 256, G, (bx + 16) % G); pg8::EpiStoreN64 E{KC}; GEMM_CALL(pg8::EpiStoreN64, pg8::StaticOrder, g, S, E); }
            { pg8::Gemm g{HIDV, Wphi2 + 256 * 256, 2048, 256, 256, 256}; pg8::StaticOrder S; S.init(2048, 256, G, (bx + 8) % G); pg8::EpiStoreN64 E{VC}; GEMM_CALL(pg8::EpiStoreN64, pg8::StaticOrder, g, S, E); }
            if (SUB(0)) { pg8::Gemm g{XIN, FS5, 16 * 512, 16 * 1024, 128, 128}; pg8::BatchOrder S; S.init(16, 2, 4, G, bx); pg8::EpiS5Carry E{S5OUT, US5, s5_d, YS5, MTOK}; GEMM_CALL(pg8::EpiS5Carry, pg8::BatchOrder, g, S, E); }
            if (SUB(1)) for (int it = vcu; it < 256; it += G) { const int b = it >> 4, h = (it >> 2) & 3, pp = it & 3; const size_t rb = (size_t)b * SEQ;
                CausalArgs A{QM + rb * 512 + 96 * h, 512, KVM + rb * 512 + 128 * h, 512, PROJ + rb * NIN + PC_KPE, NIN, KVM + rb * 512 + 128 * h + 64, 512, nullptr, MIX + rb * 1024 + 64 * h, 1024, 0.10206207261596575f * LOG2E};
                causal_unit<96, false>(lds + RING_OFF, tid, pp, A); causal_unit<96, false>(lds + RING_OFF, tid, 7 - pp, A); }
            if (SUB(2)) for (int it = vcu; it < 256; it += G) { const int b = it >> 4, h = (it >> 2) & 3, pp = it & 3; const size_t rb = (size_t)b * SEQ;
                CausalArgs A{PROJ + rb * NIN + PC_FQ + 64 * h, NIN, PROJ + rb * NIN + PC_FK + 64 * h, NIN, nullptr, 0, PROJ + rb * NIN + PC_FV + 64 * h, NIN, CUM + ((size_t)b * 4 + h) * SEQ, MIX + rb * 1024 + 512 + 64 * h, 1024, 0.125f * LOG2E};
                causal_unit<64, true>(lds + RING_OFF, tid, pp, A); causal_unit<64, true>(lds + RING_OFF, tid, 7 - pp, A); }
            __syncthreads();
        }
        SEAM(pb + 8);
        if (IN(pb + 9)) for (int rep = 0; rep < REPS(9); ++rep) { PH_LOCALS;
            if (SUB(0)) { pg8::Gemm g{YS5, Wglu, MTOK, 256, 256, 256}; pg8::StaticOrder S; S.init(MTOK, 256, G, bx); pg8::EpiGLUNorm E{YS5, s5_glub, mix_gg + 768, MIX, 1024, 768, (PG8_LAS float*)(lds + XCH_OFF)}; GEMM_CALL(pg8::EpiGLUNorm, pg8::StaticOrder, g, S, E); }
            if (SUB(1)) for (int it = vcu; it < 512; it += G) { const int i2 = it & 255, b = i2 >> 4, T0 = (it < 256 ? (i2 & 15) : 31 - (i2 & 15)) * 64; const size_t rb = (size_t)b * SEQ;
                NsaArgs A{PROJ + rb * NIN, KC + (size_t)b * 128 * 64, VC + (size_t)b * 128 * 64, nsa_gb, MIX + rb * 1024 + 256, mix_gg, MIX + rb * 1024};
                nsa_unit(lds + RING_OFF, tid, T0, A); }
            __syncthreads();
        }
        SEAM(pb + 9);
        if (IN(pb + 11)) { PH_LOCALS; pg8::Gemm g{MIX, Wout, MTOK, DMODEL, DMODEL, DMODEL}; pg8::StaticOrder S; S.init(MTOK, DMODEL, G, bx); pg8::EpiNormRes E{HB, HB, nullptr, mix_post_g, 1.0f, SSYV, RSV, GRPCNT(1), XLN};
            GEMM_CALL(pg8::EpiNormRes, pg8::StaticOrder, g, S, E);
            if (L == 0) for (int m = gw; m < MROWS; m += NGW) { norm_only_row(lane, KIN(1) + (size_t)m * DMODEL, xa_mem_g, MEMN + (size_t)m * DMODEL);
                norm_only_row(lane, KIN(1) + (size_t)m * DMODEL, KIN(33) + (size_t)DMODEL, MEMN1 + (size_t)m * DMODEL); }
        }
        SEAM(pb + 12);
        if (IN(pb + 13)) for (int rep = 0; rep < REPS(13); ++rep) { PH_LOCALS;
            if (SUB(0)) { pg8::Gemm g{HB, Wxq, MTOK, DMODEL, DMODEL, DMODEL}; pg8::StaticOrder S; S.init(MTOK, DMODEL, G, bx); pg8::EpiStoreScaled E{XQ, DMODEL, RSV, 0.0625f * LOG2E, XRN}; GEMM_CALL(pg8::EpiStoreScaled, pg8::StaticOrder, g, S, E); }
            if (L == 0 && SUB(1)) { pg8::Gemm g{MEMN, Wxkv, MROWS, DMODEL, DMODEL, DMODEL}; pg8::StaticOrder S; S.init(MROWS, DMODEL, G, bx); pg8::EpiKH E{KH, MROWS}; GEMM_CALL(pg8::EpiKH, pg8::StaticOrder, g, S, E); }
            if (L == 0 && SUB(2)) { pg8::Gemm g{MEMN, Wxkv + (size_t)DMODEL * DMODEL, MROWS, DMODEL, DMODEL, DMODEL}; pg8::StaticOrder S; S.init(MROWS, DMODEL, G, (bx + 64) % G); pg8::EpiKH E{VT, MROWS}; GEMM_CALL(pg8::EpiKH, pg8::StaticOrder, g, S, E); }
        }
        if (L == 0 && IN(pb + 13)) { PH_LOCALS;
            { pg8::Gemm g{MEMN1, Wxkv1, MROWS, DMODEL, DMODEL, DMODEL}; pg8::StaticOrder S; S.init(MROWS, DMODEL, G, (bx + 192) % G); pg8::EpiKH E{KH1, MROWS}; GEMM_CALL(pg8::EpiKH, pg8::StaticOrder, g, S, E); }
            { pg8::Gemm g{MEMN1, Wxkv1 + (size_t)DMODEL * DMODEL, MROWS, DMODEL, DMODEL, DMODEL}; pg8::StaticOrder S; S.init(MROWS, DMODEL, G, (bx + 128) % G); pg8::EpiKH E{VT1, MROWS}; GEMM_CALL(pg8::EpiKH, pg8::StaticOrder, g, S, E); }
        }
        SEAM(pb + 13);
        if (IN(pb + 14)) for (int rep = 0; rep < REPS(14); ++rep) { PH_LOCALS; const int q4 = G / 4, far = 1 << 28;
#pragma unroll
            for (int h = 0; h < 4; ++h) { const int lo4 = h * q4, hi4 = (h == 3) ? G : lo4 + q4;
                pg8::Gemm g{XQ + 256 * h, KHL + (size_t)h * MROWS * 256, MTOK, MROWS, 256, DMODEL}; pg8::BatchOrder S; S.init(16, 8, 1, hi4 - lo4, (bx >= lo4 && bx < hi4) ? bx - lo4 : far);
                pg8::EpiSoftmaxP E{PX, DMODEL, 256 * h, (PG8_LAS float*)(lds + XCH_OFF)}; GEMM_CALL(pg8::EpiSoftmaxP, pg8::BatchOrder, g, S, E); }
#pragma unroll
            for (int h = 0; h < 4; ++h) { const int lo4 = h * q4, hi4 = (h == 3) ? G : lo4 + q4;
                pg8::Gemm g{Wxo + 256 * h, VTL + (size_t)h * MROWS * 256, DMODEL, MROWS, 256, DMODEL}; pg8::StaticOrder S; S.init(DMODEL, MROWS, hi4 - lo4, (bx >= lo4 && bx < hi4) ? bx - lo4 : far);
                pg8::EpiVWo E{VWO, h}; GEMM_CALL(pg8::EpiVWo, pg8::StaticOrder, g, S, E); }
        }
        SEAM(pb + 14);
        if (IN(pb + 15)) { PH_LOCALS;
            pg8::Gemm g{PX, VWO, MTOK, 16 * DMODEL, DMODEL, DMODEL}; pg8::BatchOrderCM S; S.init(16, 8, 4, G, bx); pg8::EpiNormRes E{HB, HB, nullptr, xa_post_g, 1.0f, SSYV, RSV, GRPCNT(2), XLN}; GEMM_CALL(pg8::EpiNormRes, pg8::BatchOrderCM, g, S, E); }
        SEAM(pb + 17);
        if (IN(pb + 18)) for (int rep = 0; rep < REPS(18); ++rep) { PH_LOCALS; pg8::Gemm g{HB, Wgu2, MTOK, 2 * FFD, DMODEL, DMODEL}; pg8::StaticOrder S; S.init(MTOK, 2 * FFD, G, bx); pg8::EpiSwiGLU E{ACT, FFD, RSV, XRN};
            GEMM_CALL(pg8::EpiSwiGLU, pg8::StaticOrder, g, S, E); }
        SEAM(pb + 18);
        if (IN(pb + 19)) { PH_LOCALS; pg8::Gemm g{ACT, Wd2, MTOK, DMODEL, FFD, FFD}; pg8::StaticOrder S; S.init(MTOK, DMODEL, G, bx);
            pg8::EpiNormRes E{HB, (L + 1 < DEPTH) ? HB : nullptr, (L + 1 < DEPTH) ? nullptr : H, ffn2_post_g, 0.5f, SSYV, (L + 1 < DEPTH) ? RSV : nullptr, GRPCNT(3), XLN};
            GEMM_CALL(pg8::EpiNormRes, pg8::StaticOrder, g, S, E); }
        if (L + 1 < DEPTH) {
        if (IN(pb + 20)) { PH_LOCALS;
            { constexpr int Lnext = L + 1; { constexpr int L = Lnext;
#define PRO_SKIP_WD2 1
#define PRO_XKV 1
            {
                S5W W{s5_lre, s5_lim, s5_ldt, s5_bre, s5_bim, s5_cre, s5_cim, BTS5, FS5, A64};
                for (int rp = 0; rp < P0REP(1); ++rp) for (int u = vcu; u < 256; u += G) { const int g = u >> 4, q = u & 15; s5_item((LAS float*)(lds + RING_OFF), tid, g, 4 * q, q == 15 ? 64 : 4 * q + 3, W); }
                __syncthreads();
            }
            LAS float* scr = (LAS float*)(lds + RING_OFF + wave * 16384);
            constexpr int I_G = (DMODEL / 64) * (FFD / 32), I_D = (FFD / 64) * (DMODEL / 32), I_IN = (DMODEL / 64) * (NIN / 32), I_SQ = (DMODEL / 64) * (DMODEL / 32), I_XKV = (DMODEL / 64) * (2048 / 32);
            constexpr int I_UQ = (256 / 64) * (512 / 32), I_UKV = (128 / 64) * (512 / 32), I_PHI = (2048 / 64) * (256 / 32), I_GLU = (256 / 64) * (256 / 32);
            constexpr int I_P2 = (256 / 64) * (256 / 32);
            constexpr int NITEMS = 4 * I_G + 2 * I_D + I_IN + 3 * I_SQ + I_XKV + I_UQ + I_UKV + 2 * I_PHI + 2 * I_P2 + I_GLU;
            for (int rp = 0; rp < P0REP(2); ++rp) for (int it = gw; it < NITEMS; it += NGW) {
                int r = it;
                if (r < I_G) { tr_item(ffn1_wg, DMODEL, FFD, Wgu1, DMODEL, FFD, MAP_GATE, scr, r, lane, ffn1_pre_g); continue; } r -= I_G;
                if (r < I_G) { tr_item(ffn1_wu, DMODEL, FFD, Wgu1, DMODEL, FFD, MAP_UP, scr, r, lane, ffn1_pre_g); continue; } r -= I_G;
                if (r < I_G) { tr_item(ffn2_wg, DMODEL, FFD, Wgu2, DMODEL, FFD, MAP_GATE, scr, r, lane, ffn2_pre_g); continue; } r -= I_G;
                if (r < I_G) { tr_item(ffn2_wu, DMODEL, FFD, Wgu2, DMODEL, FFD, MAP_UP, scr, r, lane, ffn2_pre_g); continue; } r -= I_G;
                if (r < I_D) { tr_item(ffn1_wd, FFD, DMODEL, Wd1, FFD, DMODEL, MAP_ID, scr, r, lane); continue; } r -= I_D;
                if (r < I_D) { if (!PRO_SKIP_WD2) tr_item(ffn2_wd, FFD, DMODEL, Wd2, FFD, DMODEL, MAP_ID, scr, r, lane); continue; } r -= I_D;
                if (r < I_IN) { tr_item(mix_w_in, DMODEL, NIN_SRC, Win, DMODEL, NIN, MAP_WIN, scr, r, lane, mix_pre_g); continue; } r -= I_IN;
                if (r < I_SQ) { tr_item(mix_wout, DMODEL, DMODEL, Wout, DMODEL, DMODEL, MAP_ID, scr, r, lane); continue; } r -= I_SQ;
                if (r < I_SQ) { tr_item(xa_wq, DMODEL, DMODEL, Wxq, DMODEL, DMODEL, MAP_ID, scr, r, lane, xa_pre_g); continue; } r -= I_SQ;
                if (r < I_SQ) { tr_item(xa_wo, DMODEL, DMODEL, Wxo, DMODEL, DMODEL, MAP_ID, scr, r, lane); continue; } r -= I_SQ;
                if (r < I_XKV) { if (PRO_XKV == 0) tr_item(xa_wkv, DMODEL, 2048, Wxkv, DMODEL, 2048, MAP_ID, scr, r, lane);
                    continue; } r -= I_XKV;
                if (r < I_UQ) { tr_item(mla_wuq, 192, 384, Wuq, 256, 512, MAP_UQ, scr, r, lane, mla_qg); continue; } r -= I_UQ;
                if (r < I_UKV) { tr_item(mla_wukv, 128, 512, Wukv, 128, 512, MAP_ID, scr, r, lane, mla_kvg); continue; } r -= I_UKV;
                if (r < I_PHI) { tr_item(nsa_w1, 2048, 256, Wphi, 2048, 256, MAP_ID, scr, r, lane); continue; } r -= I_PHI;
                if (r < I_PHI) { tr_item(nsa_w1 + 2048 * 256, 2048, 256, Wphi + 256 * 2048, 2048, 256, MAP_ID, scr, r, lane); continue; } r -= I_PHI;
                if (r < I_P2) { tr_item(nsa_w2, 256, 64, Wphi2, 256, 256, MAP_ID, scr, r, lane); continue; } r -= I_P2;
                if (r < I_P2) { tr_item(nsa_w2 + 256 * 64, 256, 64, Wphi2 + 256 * 256, 256, 256, MAP_ID, scr, r, lane); continue; } r -= I_P2;
                tr_item(s5_gluw, 256, 256, Wglu, 256, 256, MAP_ID, scr, r, lane);
            }
            if (PRO_XKV == 0) for (int it = gw; it < I_XKV; it += NGW) tr_item(KIN(35) + (size_t)(DMODEL * 2048), DMODEL, 2048, Wxkv1, DMODEL, 2048, MAP_ID, scr, it, lane);
            for (int it = gw; it < 512; it += NGW) phib_part(it, lane, nsa_pos, nsa_w1, PHIP);
#undef PRO_XKV
#undef PRO_SKIP_WD2
            } }
        }
        SEAM(pb + 20);
        }
    }
#undef IN
#undef SEAM
#undef GEMM_CALL
}

extern "C" void kernel_launch(void* const* d_in, const int* in_sizes, int n_in, void* d_out, int out_size, void* d_ws, size_t ws_size, hipStream_t stream) {
    static int grid = 0;
    if (grid == 0) {
        if (n_in != 43 || out_size != MTOK * DMODEL || ws_size < WS_END) { fprintf(stderr, "kernel_launch: unexpected problem (n_in %d, out %d, ws %zu)\n", n_in, out_size, ws_size); grid = -1; return; }
        int dev = 0, cus = 0, per_cu = 0;
        if (hipGetDevice(&dev) != hipSuccess || hipDeviceGetAttribute(&cus, hipDeviceAttributeMultiprocessorCount, dev) != hipSuccess) { grid = -1; return; }
        if (hipFuncSetAttribute((const void*)fwd_kernel, hipFuncAttributeMaxDynamicSharedMemorySize, LDS_BYTES) != hipSuccess) { fprintf(stderr, "kernel_launch: hipFuncSetAttribute failed\n"); grid = -1; return; }
        if (hipOccupancyMaxActiveBlocksPerMultiprocessor(&per_cu, (const void*)fwd_kernel, NTHR, LDS_BYTES) != hipSuccess || per_cu < 1) { fprintf(stderr, "kernel_launch: occupancy query says %d\n", per_cu); }
        (void)hipGetLastError();
        grid = cus;
    }
    if (grid < 0) return;
    (void)hipMemsetAsync((char*)d_ws + WS_CTL, 0, CTL_ZERO_BYTES, stream);
    Args a{};
    for (int i = 0; i < 43; ++i) a.in[i] = (const float*)d_in[i];
    a.out = (float*)d_out; a.ws = (unsigned char*)d_ws;
    const int stop = (MK_STOP_PHASE < NPHASES) ? MK_STOP_PHASE : NPHASES;
#if MK_ONE_LAUNCH
    a.ph_lo = 0; a.ph_hi = stop;
    hipLaunchKernelGGL(fwd_kernel, dim3(grid), dim3(NTHR), LDS_BYTES, stream, a);
#else
    for (int p = 0; p < stop; ++p) { a.ph_lo = p; a.ph_hi = p + 1; hipLaunchKernelGGL(fwd_kernel, dim3(grid), dim3(NTHR), LDS_BYTES, stream, a); }
#endif
}
```

```cpp
#include <hip/hip_runtime.h>
#include <cstdio>
#include <cstdint>

#ifndef MK_ONE_LAUNCH
#define MK_ONE_LAUNCH 1
#endif
#ifndef MK_REPEAT_N
#define MK_REPEAT_N 2
#endif
#ifndef MK_STOP_PHASE
#define MK_STOP_PHASE 9999
#endif

namespace pg8 {
#define PG8_LAS __attribute__((address_space(3)))
#define PG8_GAS __attribute__((address_space(1)))
typedef unsigned short bf16_t;
typedef short bf16x8 __attribute__((ext_vector_type(8)));
typedef float f32x4 __attribute__((ext_vector_type(4)));
typedef unsigned u32x4 __attribute__((ext_vector_type(4)));
constexpr int BM = 256, BK = 64, HALF = 128, HTB = HALF * BK * 2  , STAGE_BYTES = 8 * HTB, NXCD = 8, WGM = 8;

__host__ __device__ __forceinline__ int lds_byte(int r, int c) { const int st = (r >> 4) * 2 + (c >> 5), rr = r & 15, cc = c & 31, ob = rr * 64 + cc * 2; return st * 1024 + (ob ^ (((ob >> 9) & 1) << 5)); }
__host__ __device__ __forceinline__ void stage_rc(int b, int& R, int& C) { const int st = b / 1024, sb = b % 1024, swz = sb ^ (((sb >> 9) & 1) << 5); R = (st >> 1) * 16 + swz / 64; C = (st & 1) * 32 + (swz % 64) / 2; }
__host__ __device__ __forceinline__ int perm32(int rho) { const int n = rho >> 4, i = rho & 15; return 8 * (i >> 2) + 4 * n + (i & 3); }

struct Unit { int pm, pn, par; };
template <class T, class = void> struct has_rowstage { static constexpr bool value = false; };
template <class T> struct has_rowstage<T, decltype((void)T::ROWSTAGE)> { static constexpr bool value = T::ROWSTAGE; };
constexpr int XR_OFF = 131072 + 1024 + 8192;
struct Gemm { const bf16_t* A; const bf16_t* Bt; int M, N, K, lda; };

struct StaticOrder {
    int nM, nN, nwg, G, c;
    __host__ __device__ void init(int M, int N, int G_, int c_) { nM = M / BM; nN = N / BM; nwg = nM * nN; G = G_; c = c_; }
    __host__ __device__ bool next(int i, Unit& u) const {
        const long L = (long)i * G + c; if (L >= nwg) return false;
        int wgid = (int)L; { const int q = nwg / NXCD, r = nwg % NXCD, xcd = wgid % NXCD, off = wgid / NXCD; wgid = (xcd < r ? xcd * (q + 1) : r * (q + 1) + (xcd - r) * q) + off; }
        const int nig = WGM * nN, gid = wgid / nig, fm = gid * WGM, gsz = (nM - fm) < WGM ? (nM - fm) : WGM;
        u.pm = fm + ((wgid % nig) % gsz); u.pn = (wgid % nig) / gsz; return true;
    }
    __device__ __forceinline__ void a_ready(const Unit&) const {}
    __device__ __forceinline__ void done(const Unit&) const {}
};
__device__ __forceinline__ unsigned cvt_pk_bf16(float lo, float hi) { unsigned r; asm volatile("v_cvt_pk_bf16_f32 %0, %1, %2" : "=v"(r) : "v"(lo), "v"(hi)); return r; }
typedef float f32x2 __attribute__((ext_vector_type(2)));
__device__ __forceinline__ float fast_sigmoid(float x) { return __builtin_amdgcn_rcpf(1.f + __expf(-x)); }
__device__ __forceinline__ float gelu_tanh(float x) { const float u = 0.7978845608028654f * (x + 0.044715f * x * x * x); return x * __builtin_amdgcn_rcpf(1.f + __expf(-2.f * u)); }
__device__ __forceinline__ float bf2f(unsigned short b) { return __builtin_bit_cast(float, (unsigned)b << 16); }
__device__ __forceinline__ float rs4l(const PG8_LAS float* XR, int lrow) { const f32x4 q = *(const PG8_LAS f32x4*)(XR + 4 * lrow); return __builtin_amdgcn_rsqf(((q[0] + q[1]) + (q[2] + q[3])) * (1.f / 1024.f) + 1e-6f); }
__device__ __forceinline__ float rs4(const float* RS4, int row) { const f32x4 q = *(const f32x4*)(RS4 + 4 * (size_t)row); return __builtin_amdgcn_rsqf(((q[0] + q[1]) + (q[2] + q[3])) * (1.f / 1024.f) + 1e-6f); }

struct BatchOrder {
    int nb, tm, tn, G, c, pn_mul, pn_add;
    __host__ __device__ void init(int nb_, int tm_, int tn_, int G_, int c_) { nb = nb_; tm = tm_; tn = tn_; G = G_; c = c_; pn_mul = tn_; pn_add = 0; }
    __host__ __device__ void init2(int nb_, int tm_, int tn_, int G_, int c_, int mul_, int add_) { nb = nb_; tm = tm_; tn = tn_; G = G_; c = c_; pn_mul = mul_; pn_add = add_; }
    __host__ __device__ __forceinline__ bool next(int i, Unit& u) const {
        const long L = (long)i * G + c; if (L >= (long)nb * tm * tn) return false;
        const int per = tm * tn, bt = (int)(L / per), r = (int)(L % per); u.pm = bt * tm + r / tn; u.pn = bt * pn_mul + pn_add + r % tn; return true;
    }
    __device__ __forceinline__ void a_ready(const Unit&) const {}
    __device__ __forceinline__ void done(const Unit&) const {}
};

struct EpiStoreBf16 {
    static constexpr bool PERM = true, AFTER_DRAIN = false;
    bf16_t* O; int ldc; const float* RS;
    __device__ __forceinline__ void operator()(const f32x4 (&acc)[2][2][4][2], const Unit& u, int wr, int wc, int fr, int fq) const {
        const int row0 = u.pm * BM + wr * 64 + fr, col0 = u.pn * BM + wc * 32 + 8 * fq;
        float rsv[2][4];
#pragma unroll
        for (int ai = 0; ai < 2; ++ai)
#pragma unroll
            for (int m = 0; m < 4; ++m) rsv[ai][m] = RS ? RS[row0 + ai * HALF + m * 16] : 1.f;
#pragma unroll
        for (int ai = 0; ai < 2; ++ai)
#pragma unroll
            for (int m = 0; m < 4; ++m) { const int row = row0 + ai * HALF + m * 16; bf16_t* rowp = O + (size_t)row * ldc + col0; const float rs = rsv[ai][m];
#pragma unroll
                for (int bj = 0; bj < 2; ++bj) { const f32x4 v0 = acc[ai][bj][m][0] * rs, v1 = acc[ai][bj][m][1] * rs;
                    u32x4 w; w.x = cvt_pk_bf16(v0[0], v0[1]); w.y = cvt_pk_bf16(v0[2], v0[3]); w.z = cvt_pk_bf16(v1[0], v1[1]); w.w = cvt_pk_bf16(v1[2], v1[3]);
                    *(u32x4*)(rowp + bj * HALF) = w; } }
    }
};
struct EpiStoreF32 {
    static constexpr bool PERM = true, AFTER_DRAIN = false;
    float* O; int ldc;
    __device__ __forceinline__ void operator()(const f32x4 (&acc)[2][2][4][2], const Unit& u, int wr, int wc, int fr, int fq) const {
        const int row0 = u.pm * BM + wr * 64 + fr, col0 = u.pn * BM + wc * 32 + 8 * fq;
#pragma unroll
        for (int ai = 0; ai < 2; ++ai)
#pragma unroll
            for (int m = 0; m < 4; ++m) { float* rowp = O + (size_t)(row0 + ai * HALF + m * 16) * ldc + col0;
#pragma unroll
                for (int bj = 0; bj < 2; ++bj) { *(f32x4*)(rowp + bj * HALF) = acc[ai][bj][m][0]; *(f32x4*)(rowp + bj * HALF + 4) = acc[ai][bj][m][1]; } }
    }
};
struct EpiSwiGLU {
    static constexpr bool PERM = true, AFTER_DRAIN = false;
    static constexpr bool ROWSTAGE = true;
    bf16_t* O; int ldc; const float* RS; const PG8_LAS float* XR;
    __device__ __forceinline__ void operator()(const f32x4 (&acc)[2][2][4][2], const Unit& u, int wr, int wc, int fr, int fq) const {
        const int row0 = u.pm * BM + wr * 64 + fr, col0 = u.pn * HALF + wc * 32 + 8 * fq;
        float rsv[2][4];
#pragma unroll
        for (int ai = 0; ai < 2; ++ai)
#pragma unroll
            for (int m = 0; m < 4; ++m) rsv[ai][m] = rs4l(XR + u.par * 1024, ai * HALF + wr * 64 + m * 16 + fr);
#pragma unroll
        for (int ai = 0; ai < 2; ++ai)
#pragma unroll
            for (int m = 0; m < 4; ++m) { const int row = row0 + ai * HALF + m * 16; bf16_t* rowp = O + (size_t)row * ldc + col0; const float rs = rsv[ai][m];
                float r[8];
#pragma unroll
                for (int n = 0; n < 2; ++n)
#pragma unroll
                    for (int e = 0; e < 4; ++e) { const float g = acc[ai][0][m][n][e] * rs, up = acc[ai][1][m][n][e] * rs; r[n * 4 + e] = g * fast_sigmoid(g) * up; }
                u32x4 w; w.x = cvt_pk_bf16(r[0], r[1]); w.y = cvt_pk_bf16(r[2], r[3]); w.z = cvt_pk_bf16(r[4], r[5]); w.w = cvt_pk_bf16(r[6], r[7]);
                *(u32x4*)rowp = w; }
    }
};
struct EpiGeluBias {
    static constexpr bool PERM = true, AFTER_DRAIN = false;
    bf16_t* O; int ldc; const float* bias;
    __device__ __forceinline__ void operator()(const f32x4 (&acc)[2][2][4][2], const Unit& u, int wr, int wc, int fr, int fq) const {
        const int row0 = u.pm * BM + wr * 64 + fr, col0 = u.pn * BM + wc * 32 + 8 * fq;
#pragma unroll
        for (int bj = 0; bj < 2; ++bj) { const f32x4 b0 = *(const f32x4*)(bias + col0 + bj * HALF), b1 = *(const f32x4*)(bias + col0 + bj * HALF + 4);
#pragma unroll
            for (int ai = 0; ai < 2; ++ai)
#pragma unroll
                for (int m = 0; m < 4; ++m) { bf16_t* rowp = O + (size_t)(row0 + ai * HALF + m * 16) * ldc + col0 + bj * HALF;
                    const f32x4 v0 = acc[ai][bj][m][0] + b0, v1 = acc[ai][bj][m][1] + b1;
                    u32x4 w; w.x = cvt_pk_bf16(gelu_tanh(v0[0]), gelu_tanh(v0[1])); w.y = cvt_pk_bf16(gelu_tanh(v0[2]), gelu_tanh(v0[3]));
                    w.z = cvt_pk_bf16(gelu_tanh(v1[0]), gelu_tanh(v1[1])); w.w = cvt_pk_bf16(gelu_tanh(v1[2]), gelu_tanh(v1[3]));
                    *(u32x4*)rowp = w; } }
    }
};
struct EpiS5Loc {
    static constexpr bool PERM = true, AFTER_DRAIN = false;
    float* O;
    __device__ __forceinline__ void operator()(const f32x4 (&acc)[2][2][4][2], const Unit& u, int wr, int wc, int fr, int fq) const {
        const int g = u.pm >> 1, row0 = u.pm * BM + wr * 64 + fr, col0 = (u.pn - 5 * g) * BM + wc * 32 + 8 * fq;
#pragma unroll
        for (int ai = 0; ai < 2; ++ai)
#pragma unroll
            for (int m = 0; m < 4; ++m) { float* rowp = O + (size_t)(row0 + ai * HALF + m * 16) * 1280 + col0;
#pragma unroll
                for (int bj = 0; bj < 2; ++bj) { *(f32x4*)(rowp + bj * HALF) = acc[ai][bj][m][0]; *(f32x4*)(rowp + bj * HALF + 4) = acc[ai][bj][m][1]; } }
    }
};
struct EpiS5Carry {
    static constexpr bool PERM = true, AFTER_DRAIN = false;
    const float* YLOC; const bf16_t* US5; const float* Dv; bf16_t* YS5; int mtok;
    __device__ __forceinline__ void operator()(const f32x4 (&acc)[2][2][4][2], const Unit& u, int wr, int wc, int fr, int fq) const {
        const int g = u.pm >> 1, row0 = u.pm * BM + wr * 64 + fr, col0 = (u.pn - 4 * g) * BM + wc * 32 + 8 * fq;
        f32x4 dv[2][2];
#pragma unroll
        for (int bj = 0; bj < 2; ++bj) { const int c0 = (col0 + bj * HALF) & 15; dv[bj][0] = *(const f32x4*)(Dv + g * 16 + c0); dv[bj][1] = *(const f32x4*)(Dv + g * 16 + c0 + 4); }
        u32x4 outw[2][4][2];
#pragma unroll
        for (int ai = 0; ai < 2; ++ai)
#pragma unroll
            for (int mp = 0; mp < 4; mp += 2) {
                f32x4 yv[2][2][2]; u32x4 uu[2][2];
#pragma unroll
                for (int mm = 0; mm < 2; ++mm)
#pragma unroll
                    for (int bj = 0; bj < 2; ++bj) { const int rg = row0 + ai * HALF + (mp + mm) * 16, rl = rg - g * 512, col = col0 + bj * HALF, t = col >> 4, c0 = col & 15; const size_t tok = (size_t)rl * 64 + t;
                        yv[mm][bj][0] = *(const f32x4*)(YLOC + (size_t)rg * 1280 + col); yv[mm][bj][1] = *(const f32x4*)(YLOC + (size_t)rg * 1280 + col + 4);
                        uu[mm][bj] = *(const u32x4*)(US5 + ((size_t)g * mtok + tok) * 16 + c0); }
#pragma unroll
                for (int mm = 0; mm < 2; ++mm)
#pragma unroll
                    for (int bj = 0; bj < 2; ++bj) { const int m = mp + mm;
                        const u32x4 w4 = uu[mm][bj];
                        float uv[8]; uv[0] = bf2f(w4.x & 0xffff); uv[1] = bf2f(w4.x >> 16); uv[2] = bf2f(w4.y & 0xffff); uv[3] = bf2f(w4.y >> 16);
                        uv[4] = bf2f(w4.z & 0xffff); uv[5] = bf2f(w4.z >> 16); uv[6] = bf2f(w4.w & 0xffff); uv[7] = bf2f(w4.w >> 16);
                        float r[8];
#pragma unroll
                        for (int e = 0; e < 4; ++e) { r[e] = gelu_tanh(acc[ai][bj][m][0][e] + yv[mm][bj][0][e] + dv[bj][0][e] * uv[e]); r[4 + e] = gelu_tanh(acc[ai][bj][m][1][e] + yv[mm][bj][1][e] + dv[bj][1][e] * uv[4 + e]); }
                        u32x4 w; w.x = cvt_pk_bf16(r[0], r[1]); w.y = cvt_pk_bf16(r[2], r[3]); w.z = cvt_pk_bf16(r[4], r[5]); w.w = cvt_pk_bf16(r[6], r[7]);
                        outw[ai][m][bj] = w; }
            }
#pragma unroll
        for (int ai = 0; ai < 2; ++ai)
#pragma unroll
            for (int m = 0; m < 4; ++m)
#pragma unroll
                for (int bj = 0; bj < 2; ++bj) { const int rg = row0 + ai * HALF + m * 16, rl = rg - g * 512, col = col0 + bj * HALF, t = col >> 4, c0 = col & 15; const size_t tok = (size_t)rl * 64 + t;
                    *(u32x4*)(YS5 + tok * 256 + g * 16 + c0) = outw[ai][m][bj]; }
    }
};
struct EpiGLU {
    static constexpr bool PERM = true, AFTER_DRAIN = false;
    const bf16_t* YS5; const float* bias; bf16_t* O; int ldc, ocol;
    __device__ __forceinline__ void operator()(const f32x4 (&acc)[2][2][4][2], const Unit& u, int wr, int wc, int fr, int fq) const {
        const int row0 = u.pm * BM + wr * 64 + fr, col0 = u.pn * BM + wc * 32 + 8 * fq;
        f32x4 bv[2][2];
#pragma unroll
        for (int bj = 0; bj < 2; ++bj) { const int col = col0 + bj * HALF; bv[bj][0] = *(const f32x4*)(bias + col); bv[bj][1] = *(const f32x4*)(bias + col + 4); }
#pragma unroll
        for (int bj = 0; bj < 2; ++bj) { const int col = col0 + bj * HALF; u32x4 yy[2][4];
#pragma unroll
            for (int ai = 0; ai < 2; ++ai)
#pragma unroll
                for (int m = 0; m < 4; ++m) yy[ai][m] = *(const u32x4*)(YS5 + (size_t)(row0 + ai * HALF + m * 16) * 256 + col);
#pragma unroll
            for (int ai = 0; ai < 2; ++ai)
#pragma unroll
                for (int m = 0; m < 4; ++m) { const size_t row = (size_t)(row0 + ai * HALF + m * 16); const u32x4 uu = yy[ai][m];
                    float yv[8]; yv[0] = bf2f(uu.x & 0xffff); yv[1] = bf2f(uu.x >> 16); yv[2] = bf2f(uu.y & 0xffff); yv[3] = bf2f(uu.y >> 16);
                    yv[4] = bf2f(uu.z & 0xffff); yv[5] = bf2f(uu.z >> 16); yv[6] = bf2f(uu.w & 0xffff); yv[7] = bf2f(uu.w >> 16);
                    float r[8];
#pragma unroll
                    for (int e = 0; e < 4; ++e) { r[e] = yv[e] * fast_sigmoid(acc[ai][bj][m][0][e] + bv[bj][0][e]); r[4 + e] = yv[4 + e] * fast_sigmoid(acc[ai][bj][m][1][e] + bv[bj][1][e]); }
                    u32x4 w; w.x = cvt_pk_bf16(r[0], r[1]); w.y = cvt_pk_bf16(r[2], r[3]); w.z = cvt_pk_bf16(r[4], r[5]); w.w = cvt_pk_bf16(r[6], r[7]);
                    *(u32x4*)(O + row * ldc + ocol + col) = w; } }
    }
};

__device__ __forceinline__ unsigned long long pk4(float a, float b, float c, float d) { return (unsigned long long)cvt_pk_bf16(a, b) | ((unsigned long long)cvt_pk_bf16(c, d) << 32); }
struct EpiWin {
    static constexpr bool PERM = true, AFTER_DRAIN = false;
    static constexpr bool ROWSTAGE = true;
    bf16_t* PROJ; bf16_t* KCMP; bf16_t* VCMP; bf16_t* US5; float* LOGF; float* SSQ; float* SSKV; const float* ropeM; const float* ropeN; const float* fb; int mtok; const float* RS; const PG8_LAS float* XR;
    __device__ __forceinline__ void operator()(const f32x4 (&acc)[2][2][4][2], const Unit& u, int wr, int wc, int fr, int fq) const {
        const int row0 = u.pm * BM + wr * 64 + fr;
        float rsv[2][4];
#pragma unroll
        for (int ai = 0; ai < 2; ++ai)
#pragma unroll
            for (int m = 0; m < 4; ++m) rsv[ai][m] = rs4l(XR + u.par * 1024, ai * HALF + wr * 64 + m * 16 + fr);
        float fbv[4];
#pragma unroll
        for (int e = 0; e < 4; ++e) fbv[e] = fb[e];
#pragma unroll
        for (int bj = 0; bj < 2; ++bj) {
            const int chunk = u.pn * 8 + bj * 4 + wc, col0 = chunk * 32 + 8 * fq;
            int type = 0, hbase = 0;
            if (chunk < 10) type = 1;
            else if (chunk == 10) { type = 2; hbase = 320; }
            else if (chunk < 19) { type = 3; hbase = 352 + 64 * ((chunk - 11) >> 1); }
            else if (chunk < 21) { type = 4; hbase = 608; }
            else if (chunk < 23) type = 5;
            else if (chunk < 25) { type = 3; hbase = 736; }
            else if (chunk < 27) type = 0;
            else if (chunk < 29) { type = 3; hbase = 864; }
            else if (chunk < 55) type = 0;
            else if (chunk < 63) type = 6;
            else type = 7;
            if (type == 2 || type == 3 || type == 4) {
                const int half = (type == 2) ? 16 : 32, d0 = (col0 - hbase) >> 1;
                f32x4 csa[2][4][2];
#pragma unroll
                for (int ai = 0; ai < 2; ++ai)
#pragma unroll
                    for (int m = 0; m < 4; ++m) { const int t = (row0 + ai * HALF + m * 16) & 2047; const PG8_GAS float* tab = (const PG8_GAS float*)((type == 2) ? ropeM : ropeN) + ((size_t)t * half + d0) * 2;
                        csa[ai][m][0] = *(const PG8_GAS f32x4*)tab; csa[ai][m][1] = *(const PG8_GAS f32x4*)(tab + 4); }
#pragma unroll
                for (int ai = 0; ai < 2; ++ai) {
#pragma unroll
                    for (int m = 0; m < 4; ++m) { const int row = row0 + ai * HALF + m * 16; const float rs = rsv[ai][m]; const f32x4 v0 = acc[ai][bj][m][0] * rs, v1 = acc[ai][bj][m][1] * rs, cs0 = csa[ai][m][0], cs1 = csa[ai][m][1];
                        const float a0 = v0[0] * cs0[0] - v0[1] * cs0[1], b0 = v0[0] * cs0[1] + v0[1] * cs0[0];
                        const float a1 = v0[2] * cs0[2] - v0[3] * cs0[3], b1 = v0[2] * cs0[3] + v0[3] * cs0[2];
                        const float a2 = v1[0] * cs1[0] - v1[1] * cs1[1], b2 = v1[0] * cs1[1] + v1[1] * cs1[0];
                        const float a3 = v1[2] * cs1[2] - v1[3] * cs1[3], b3 = v1[2] * cs1[3] + v1[3] * cs1[2];
                        bf16_t* dst = (type == 4) ? KCMP + (size_t)row * 64 + d0 : PROJ + (size_t)row * 2048 + hbase + d0;
                        *(unsigned long long*)dst = pk4(a0, a1, a2, a3); *(unsigned long long*)(dst + half) = pk4(b0, b1, b2, b3); }
                }
            } else {
#pragma unroll
                for (int ai = 0; ai < 2; ++ai)
#pragma unroll
                    for (int m = 0; m < 4; ++m) {
                        const int row = row0 + ai * HALF + m * 16; const float rs = rsv[ai][m]; const f32x4 v0 = acc[ai][bj][m][0] * rs, v1 = acc[ai][bj][m][1] * rs;
                        u32x4 w; w.x = cvt_pk_bf16(v0[0], v0[1]); w.y = cvt_pk_bf16(v0[2], v0[3]); w.z = cvt_pk_bf16(v1[0], v1[1]); w.w = cvt_pk_bf16(v1[2], v1[3]);
                        if (type == 0 || type == 1) {
                            *(u32x4*)(PROJ + (size_t)row * 2048 + col0) = w;
                            if (type == 1) { float ss = (v0[0] * v0[0] + v0[1] * v0[1]) + (v0[2] * v0[2] + v0[3] * v0[3]) + (v1[0] * v1[0] + v1[1] * v1[1]) + (v1[2] * v1[2] + v1[3] * v1[3]);
                                ss += __shfl_xor(ss, 16); ss += __shfl_xor(ss, 32);
                                if (fq == 0) { if (chunk < 6) SSQ[(size_t)row * 6 + chunk] = ss; else SSKV[(size_t)row * 4 + (chunk - 6)] = ss; } }
                        } else if (type == 5) {
                            *(u32x4*)(VCMP + (size_t)row * 64 + (col0 - 672)) = w;
                        } else if (type == 6) {
                            const int cc = col0 - 1760, g = cc >> 4, c0 = cc & 15;
                            *(u32x4*)(US5 + ((size_t)g * mtok + row) * 16 + c0) = w;
                        } else {
                            if (fq < 2) *(u32x4*)(PROJ + (size_t)row * 2048 + col0) = w;
                            if (fq == 1) { const int t = row & 2047, b = row >> 11;
#pragma unroll
                                for (int e = 0; e < 4; ++e) { const float x = v1[e] + fbv[e]; LOGF[((size_t)b * 4 + e) * 2048 + t] = fminf(x, 0.f) - log1pf(__expf(-fabsf(x))); } }
                        }
                    }
            }
        }
    }
};
template <bool ROPE> struct EpiRowScale {
    static constexpr bool PERM = true, AFTER_DRAIN = false;
    bf16_t* O; int ldc; const float* SS; int nslot; float inv_dim; const float* ropeM;
    __device__ __forceinline__ void operator()(const f32x4 (&acc)[2][2][4][2], const Unit& u, int wr, int wc, int fr, int fq) const {
        const int row0 = u.pm * BM + wr * 64 + fr;
        float rsv[2][4];
#pragma unroll
        for (int ai = 0; ai < 2; ++ai)
#pragma unroll
            for (int m = 0; m < 4; ++m) { const int row = row0 + ai * HALF + m * 16; float ss = 0.f;
                for (int i = 0; i < nslot; ++i) ss += SS[(size_t)row * nslot + i];
                rsv[ai][m] = __builtin_amdgcn_rsqf(ss * inv_dim + 1e-6f); }
#pragma unroll
        for (int bj = 0; bj < 2; ++bj) {
            const int cbase = u.pn * BM + bj * HALF + wc * 32, col0 = cbase + 8 * fq, hh = cbase / 96, rel = cbase - 96 * hh;
            if (ROPE && rel == 64 && cbase < 384) {
                const int d0 = (8 * fq) >> 1;
                f32x4 csa[2][4][2];
#pragma unroll
                for (int ai = 0; ai < 2; ++ai)
#pragma unroll
                    for (int m = 0; m < 4; ++m) { const int t = (row0 + ai * HALF + m * 16) & 2047; const PG8_GAS float* tab = (const PG8_GAS float*)ropeM + ((size_t)t * 16 + d0) * 2; csa[ai][m][0] = *(const PG8_GAS f32x4*)tab; csa[ai][m][1] = *(const PG8_GAS f32x4*)(tab + 4); }
#pragma unroll
                for (int ai = 0; ai < 2; ++ai) {
#pragma unroll
                    for (int m = 0; m < 4; ++m) { const int row = row0 + ai * HALF + m * 16; const float rs = rsv[ai][m]; const f32x4 v0 = acc[ai][bj][m][0] * rs, v1 = acc[ai][bj][m][1] * rs, cs0 = csa[ai][m][0], cs1 = csa[ai][m][1];
                        const float a0 = v0[0] * cs0[0] - v0[1] * cs0[1], b0 = v0[0] * cs0[1] + v0[1] * cs0[0];
                        const float a1 = v0[2] * cs0[2] - v0[3] * cs0[3], b1 = v0[2] * cs0[3] + v0[3] * cs0[2];
                        const float a2 = v1[0] * cs1[0] - v1[1] * cs1[1], b2 = v1[0] * cs1[1] + v1[1] * cs1[0];
                        const float a3 = v1[2] * cs1[2] - v1[3] * cs1[3], b3 = v1[2] * cs1[3] + v1[3] * cs1[2];
                        bf16_t* dst = O + (size_t)row * ldc + cbase + d0;
                        *(unsigned long long*)dst = pk4(a0, a1, a2, a3); *(unsigned long long*)(dst + 16) = pk4(b0, b1, b2, b3); }
                }
            } else {
#pragma unroll
                for (int ai = 0; ai < 2; ++ai)
#pragma unroll
                    for (int m = 0; m < 4; ++m) { const int row = row0 + ai * HALF + m * 16; const float rs = rsv[ai][m]; const f32x4 v0 = acc[ai][bj][m][0] * rs, v1 = acc[ai][bj][m][1] * rs;
                        u32x4 w; w.x = cvt_pk_bf16(v0[0], v0[1]); w.y = cvt_pk_bf16(v0[2], v0[3]); w.z = cvt_pk_bf16(v1[0], v1[1]); w.w = cvt_pk_bf16(v1[2], v1[3]);
                        *(u32x4*)(O + (size_t)row * ldc + col0) = w; }
            }
        }
    }
};

struct EpiStoreScaled {
    static constexpr bool PERM = true, AFTER_DRAIN = false;
    static constexpr bool ROWSTAGE = true;
    bf16_t* O; int ldc; const float* RS; float mul; const PG8_LAS float* XR;
    __device__ __forceinline__ void operator()(const f32x4 (&acc)[2][2][4][2], const Unit& u, int wr, int wc, int fr, int fq) const {
        const int row0 = u.pm * BM + wr * 64 + fr, col0 = u.pn * BM + wc * 32 + 8 * fq;
        float rsv[2][4];
#pragma unroll
        for (int ai = 0; ai < 2; ++ai)
#pragma unroll
            for (int m = 0; m < 4; ++m) rsv[ai][m] = rs4l(XR + u.par * 1024, ai * HALF + wr * 64 + m * 16 + fr) * mul;
#pragma unroll
        for (int ai = 0; ai < 2; ++ai)
#pragma unroll
            for (int m = 0; m < 4; ++m) { const int row = row0 + ai * HALF + m * 16; bf16_t* rowp = O + (size_t)row * ldc + col0; const float rs = rsv[ai][m];
#pragma unroll
                for (int bj = 0; bj < 2; ++bj) { const f32x4 v0 = acc[ai][bj][m][0] * rs, v1 = acc[ai][bj][m][1] * rs;
                    u32x4 w; w.x = cvt_pk_bf16(v0[0], v0[1]); w.y = cvt_pk_bf16(v0[2], v0[3]); w.z = cvt_pk_bf16(v1[0], v1[1]); w.w = cvt_pk_bf16(v1[2], v1[3]);
                    *(u32x4*)(rowp + bj * HALF) = w; } }
    }
};
struct EpiKH {
    static constexpr bool PERM = true, AFTER_DRAIN = false;
    bf16_t* KH; int nrows;
    __device__ __forceinline__ void operator()(const f32x4 (&acc)[2][2][4][2], const Unit& u, int wr, int wc, int fr, int fq) const {
        const int row0 = u.pm * BM + wr * 64 + fr, col0 = wc * 32 + 8 * fq; bf16_t* base = KH + (size_t)u.pn * nrows * 256;
#pragma unroll
        for (int ai = 0; ai < 2; ++ai)
#pragma unroll
            for (int m = 0; m < 4; ++m) { bf16_t* rowp = base + (size_t)(row0 + ai * HALF + m * 16) * 256 + col0;
#pragma unroll
                for (int bj = 0; bj < 2; ++bj) { const f32x4 v0 = acc[ai][bj][m][0], v1 = acc[ai][bj][m][1];
                    u32x4 w; w.x = cvt_pk_bf16(v0[0], v0[1]); w.y = cvt_pk_bf16(v0[2], v0[3]); w.z = cvt_pk_bf16(v1[0], v1[1]); w.w = cvt_pk_bf16(v1[2], v1[3]);
                    *(u32x4*)(rowp + bj * HALF) = w; } }
    }
};
struct EpiVT {
    static constexpr bool PERM = true, AFTER_DRAIN = false;
    bf16_t* VT;
    __device__ __forceinline__ void operator()(const f32x4 (&acc)[2][2][4][2], const Unit& u, int wr, int wc, int fr, int fq) const {
        const int row0 = u.pm * BM + wr * 64 + fr, col0 = wc * 32 + 8 * fq; bf16_t* base = VT + (size_t)u.pn * 1024 * 256;
#pragma unroll
        for (int ai = 0; ai < 2; ++ai)
#pragma unroll
            for (int m = 0; m < 4; ++m) { bf16_t* rowp = base + (size_t)(row0 + ai * HALF + m * 16) * 256 + col0;
#pragma unroll
                for (int bj = 0; bj < 2; ++bj) { const f32x4 v0 = acc[ai][bj][m][0], v1 = acc[ai][bj][m][1];
                    u32x4 w; w.x = cvt_pk_bf16(v0[0], v0[1]); w.y = cvt_pk_bf16(v0[2], v0[3]); w.z = cvt_pk_bf16(v1[0], v1[1]); w.w = cvt_pk_bf16(v1[2], v1[3]);
                    *(u32x4*)(rowp + bj * HALF) = w; } }
    }
};
struct EpiSoftmaxP {
    static constexpr bool PERM = true, AFTER_DRAIN = false;
    bf16_t* O; int ldc, ocol; PG8_LAS float* XL;
    __device__ __forceinline__ void operator()(const f32x4 (&acc)[2][2][4][2], const Unit& u, int wr, int wc, int fr, int fq) const {
        const int row0 = u.pm * BM + wr * 64 + fr, col0 = wc * 32 + 8 * fq;
        PG8_LAS float* XM = XL; PG8_LAS float* XS = XL + 1024;
        float mx[2][4];
#pragma unroll
        for (int ai = 0; ai < 2; ++ai)
#pragma unroll
            for (int m = 0; m < 4; ++m) { float v = -3e38f;
#pragma unroll
                for (int bj = 0; bj < 2; ++bj)
#pragma unroll
                    for (int n = 0; n < 2; ++n)
#pragma unroll
                        for (int e = 0; e < 4; ++e) v = fmaxf(v, acc[ai][bj][m][n][e]);
                v = fmaxf(v, __shfl_xor(v, 16)); v = fmaxf(v, __shfl_xor(v, 32)); mx[ai][m] = v;
                if (fq == 0) XM[(ai * HALF + wr * 64 + m * 16 + fr) * 4 + wc] = v; }
        asm volatile("s_waitcnt lgkmcnt(0)" ::: "memory"); __builtin_amdgcn_s_barrier();
        float p[2][4][2][8], sm[2][4];
#pragma unroll
        for (int ai = 0; ai < 2; ++ai)
#pragma unroll
            for (int m = 0; m < 4; ++m) { const f32x4 q = *(const PG8_LAS f32x4*)(XM + (ai * HALF + wr * 64 + m * 16 + fr) * 4); const float mm = fmaxf(fmaxf(q[0], q[1]), fmaxf(q[2], q[3])); float sum = 0.f;
#pragma unroll
                for (int bj = 0; bj < 2; ++bj)
#pragma unroll
                    for (int n = 0; n < 2; ++n)
#pragma unroll
                        for (int e = 0; e < 4; ++e) { const float pv = __builtin_amdgcn_exp2f(acc[ai][bj][m][n][e] - mm); p[ai][m][bj][n * 4 + e] = pv; sum += pv; }
                sum += __shfl_xor(sum, 16); sum += __shfl_xor(sum, 32); sm[ai][m] = sum;
                if (fq == 0) XS[(ai * HALF + wr * 64 + m * 16 + fr) * 4 + wc] = sum; }
        asm volatile("s_waitcnt lgkmcnt(0)" ::: "memory"); __builtin_amdgcn_s_barrier();
#pragma unroll
        for (int ai = 0; ai < 2; ++ai)
#pragma unroll
            for (int m = 0; m < 4; ++m) { const f32x4 q = *(const PG8_LAS f32x4*)(XS + (ai * HALF + wr * 64 + m * 16 + fr) * 4); const float inv = __builtin_amdgcn_rcpf((q[0] + q[1]) + (q[2] + q[3]));
                bf16_t* rowp = O + (size_t)(row0 + ai * HALF + m * 16) * ldc + ocol + col0;
#pragma unroll
                for (int bj = 0; bj < 2; ++bj) { const float* pp = p[ai][m][bj];
                    u32x4 w; w.x = cvt_pk_bf16(pp[0] * inv, pp[1] * inv); w.y = cvt_pk_bf16(pp[2] * inv, pp[3] * inv); w.z = cvt_pk_bf16(pp[4] * inv, pp[5] * inv); w.w = cvt_pk_bf16(pp[6] * inv, pp[7] * inv);
                    *(u32x4*)(rowp + bj * HALF) = w; } }
        asm volatile("s_waitcnt lgkmcnt(0)" ::: "memory"); __builtin_amdgcn_s_barrier();
    }
};

struct EpiStoreCol0 {
    static constexpr bool PERM = true, AFTER_DRAIN = false;
    bf16_t* O; int ldc;
    __device__ __forceinline__ void operator()(const f32x4 (&acc)[2][2][4][2], const Unit& u, int wr, int wc, int fr, int fq) const {
        const int row0 = u.pm * BM + wr * 64 + fr, col0 = wc * 32 + 8 * fq;
#pragma unroll
        for (int ai = 0; ai < 2; ++ai)
#pragma unroll
            for (int m = 0; m < 4; ++m) { bf16_t* rowp = O + (size_t)(row0 + ai * HALF + m * 16) * ldc + col0;
#pragma unroll
                for (int bj = 0; bj < 2; ++bj) { const f32x4 v0 = acc[ai][bj][m][0], v1 = acc[ai][bj][m][1];
                    u32x4 w; w.x = cvt_pk_bf16(v0[0], v0[1]); w.y = cvt_pk_bf16(v0[2], v0[3]); w.z = cvt_pk_bf16(v1[0], v1[1]); w.w = cvt_pk_bf16(v1[2], v1[3]);
                    *(u32x4*)(rowp + bj * HALF) = w; } }
    }
};

struct EpiStoreN64 {
    static constexpr bool PERM = true, AFTER_DRAIN = false;
    bf16_t* O;
    __device__ __forceinline__ void operator()(const f32x4 (&acc)[2][2][4][2], const Unit& u, int wr, int wc, int fr, int fq) const {
        if (wc >= 2) return;
        const int row0 = u.pm * BM + wr * 64 + fr, col0 = wc * 32 + 8 * fq;
#pragma unroll
        for (int ai = 0; ai < 2; ++ai)
#pragma unroll
            for (int m = 0; m < 4; ++m) { const f32x4 v0 = acc[ai][0][m][0], v1 = acc[ai][0][m][1];
                u32x4 w; w.x = cvt_pk_bf16(v0[0], v0[1]); w.y = cvt_pk_bf16(v0[2], v0[3]); w.z = cvt_pk_bf16(v1[0], v1[1]); w.w = cvt_pk_bf16(v1[2], v1[3]);
                *(u32x4*)(O + (size_t)(row0 + ai * HALF + m * 16) * 64 + col0) = w; }
    }
};

struct EpiVWo {
    static constexpr bool PERM = true, AFTER_DRAIN = false;
    bf16_t* O; int h;
    __device__ __forceinline__ void operator()(const f32x4 (&acc)[2][2][4][2], const Unit& u, int wr, int wc, int fr, int fq) const {
        const int row0 = u.pm * BM + wr * 64 + fr, col0 = 256 * h + wc * 32 + 8 * fq; bf16_t* base = O + (size_t)u.pn * 1024 * 1024;
#pragma unroll
        for (int ai = 0; ai < 2; ++ai)
#pragma unroll
            for (int m = 0; m < 4; ++m) { bf16_t* rowp = base + (size_t)(row0 + ai * HALF + m * 16) * 1024 + col0;
#pragma unroll
                for (int bj = 0; bj < 2; ++bj) { const f32x4 v0 = acc[ai][bj][m][0], v1 = acc[ai][bj][m][1];
                    u32x4 w; w.x = cvt_pk_bf16(v0[0], v0[1]); w.y = cvt_pk_bf16(v0[2], v0[3]); w.z = cvt_pk_bf16(v1[0], v1[1]); w.w = cvt_pk_bf16(v1[2], v1[3]);
                    *(u32x4*)(rowp + bj * HALF) = w; } }
    }
};
struct EpiStoreB4 {
    static constexpr bool PERM = true, AFTER_DRAIN = false;
    bf16_t* O;
    __device__ __forceinline__ void operator()(const f32x4 (&acc)[2][2][4][2], const Unit& u, int wr, int wc, int fr, int fq) const {
        const int row0 = u.pm * BM + wr * 64 + fr, col0 = (u.pn - 4 * (u.pm >> 3)) * BM + wc * 32 + 8 * fq;
#pragma unroll
        for (int ai = 0; ai < 2; ++ai)
#pragma unroll
            for (int m = 0; m < 4; ++m) { bf16_t* rowp = O + (size_t)(row0 + ai * HALF + m * 16) * 1024 + col0;
#pragma unroll
                for (int bj = 0; bj < 2; ++bj) { const f32x4 v0 = acc[ai][bj][m][0], v1 = acc[ai][bj][m][1];
                    u32x4 w; w.x = cvt_pk_bf16(v0[0], v0[1]); w.y = cvt_pk_bf16(v0[2], v0[3]); w.z = cvt_pk_bf16(v1[0], v1[1]); w.w = cvt_pk_bf16(v1[2], v1[3]);
                    *(u32x4*)(rowp + bj * HALF) = w; } }
    }
};

struct BatchOrderCM {
    int nb, tm, tn, G, c, pn_mul, pn_add;
    __host__ __device__ void init(int nb_, int tm_, int tn_, int G_, int c_) { nb = nb_; tm = tm_; tn = tn_; G = G_; c = c_; pn_mul = tn_; pn_add = 0; }
    __host__ __device__ __forceinline__ bool next(int i, Unit& u) const {
        const long L = (long)i * G + c; if (L >= (long)nb * tm * tn) return false;
        const int per = tm * tn, bt = (int)(L / per), r = (int)(L % per); u.pm = bt * tm + r % tm; u.pn = bt * pn_mul + pn_add + r / tm; return true;
    }
    __device__ __forceinline__ void a_ready(const Unit&) const {}
    __device__ __forceinline__ void done(const Unit&) const {}
};

struct EpiNormRes {
    static constexpr bool PERM = true, AFTER_DRAIN = false;
    const bf16_t* Hin; bf16_t* Hout; float* O32; const float* gpost; float w; float* SSY; float* SSH; unsigned* cnt; PG8_LAS float* XL;
    __device__ __forceinline__ void operator()(const f32x4 (&acc)[2][2][4][2], const Unit& u, int wr, int wc, int fr, int fq) const {
        const int ct = u.pn & 3, tid = (wr * 4 + wc) * 64 + fq * 16 + fr, rloc = wr * 64 + fr;
        const int row0 = u.pm * BM + rloc, col0 = ct * BM + wc * 32 + 8 * fq;
        const unsigned eo = (unsigned)row0 * 1024u + (unsigned)col0;
        unsigned yp[2][4][2][4];
#pragma unroll
        for (int ai = 0; ai < 2; ++ai)
#pragma unroll
            for (int m = 0; m < 4; ++m) { float v = 0.f;
#pragma unroll
                for (int bj = 0; bj < 2; ++bj) {
#pragma unroll
                    for (int n = 0; n < 2; ++n)
#pragma unroll
                        for (int e = 0; e < 4; ++e) v += acc[ai][bj][m][n][e] * acc[ai][bj][m][n][e];
                    yp[ai][m][bj][0] = cvt_pk_bf16(acc[ai][bj][m][0][0], acc[ai][bj][m][0][1]); yp[ai][m][bj][1] = cvt_pk_bf16(acc[ai][bj][m][0][2], acc[ai][bj][m][0][3]);
                    yp[ai][m][bj][2] = cvt_pk_bf16(acc[ai][bj][m][1][0], acc[ai][bj][m][1][1]); yp[ai][m][bj][3] = cvt_pk_bf16(acc[ai][bj][m][1][2], acc[ai][bj][m][1][3]); }
                v += __shfl_xor(v, 16); v += __shfl_xor(v, 32);
                if (fq == 0) XL[(ai * HALF + rloc + m * 16) * 4 + wc] = v;
                __builtin_amdgcn_sched_barrier(0); }
        asm volatile("s_waitcnt lgkmcnt(0)" ::: "memory"); __builtin_amdgcn_s_barrier();
        if (tid < BM) { const f32x4 q = *(const PG8_LAS f32x4*)(XL + tid * 4); __hip_atomic_store(SSY + ((size_t)(u.pm * BM + tid) * 4 + ct), (q[0] + q[1]) + (q[2] + q[3]), __ATOMIC_RELAXED, __HIP_MEMORY_SCOPE_AGENT); }
        asm volatile("s_waitcnt vmcnt(0)" ::: "memory"); __builtin_amdgcn_s_barrier();
        if (tid == 0) (void)__hip_atomic_fetch_add(cnt + u.pm, 1u, __ATOMIC_RELAXED, __HIP_MEMORY_SCOPE_AGENT);
        __builtin_amdgcn_sched_barrier(0);
        u32x4 hh[2][4][2];
#pragma unroll
        for (int ai = 0; ai < 2; ++ai)
#pragma unroll
            for (int m = 0; m < 4; ++m)
#pragma unroll
                for (int bj = 0; bj < 2; ++bj) hh[ai][m][bj] = *(const PG8_GAS u32x4*)((const PG8_GAS char*)Hin + (size_t)(2u * (eo + (unsigned)((ai * HALF + m * 16) * 1024 + bj * HALF))));
        __builtin_amdgcn_sched_barrier(0);
        if (tid == 0) {
            unsigned* c = cnt + u.pm;
            unsigned sp = 0u;
            while (__hip_atomic_load(c, __ATOMIC_RELAXED, __HIP_MEMORY_SCOPE_AGENT) < 4u) { __builtin_amdgcn_s_sleep(1); if (++sp > (1u << 17)) break; }
        }
        __builtin_amdgcn_s_barrier();
        if (tid < BM) { const float* sp4 = SSY + (size_t)(u.pm * BM + tid) * 4;
            const float q0 = __hip_atomic_load(sp4, __ATOMIC_RELAXED, __HIP_MEMORY_SCOPE_AGENT), q1 = __hip_atomic_load(sp4 + 1, __ATOMIC_RELAXED, __HIP_MEMORY_SCOPE_AGENT);
            const float q2 = __hip_atomic_load(sp4 + 2, __ATOMIC_RELAXED, __HIP_MEMORY_SCOPE_AGENT), q3 = __hip_atomic_load(sp4 + 3, __ATOMIC_RELAXED, __HIP_MEMORY_SCOPE_AGENT);
            XL[1024 + tid] = w * __builtin_amdgcn_rsqf(((q0 + q1) + (q2 + q3)) * (1.f / 1024.f) + 1e-6f); }
        asm volatile("s_waitcnt lgkmcnt(0)" ::: "memory"); __builtin_amdgcn_s_barrier();
        f32x4 g0[2], g1[2];
#pragma unroll
        for (int bj = 0; bj < 2; ++bj) { g0[bj] = *(const PG8_GAS f32x4*)((const PG8_GAS char*)gpost + (size_t)(4u * (unsigned)(col0 + bj * HALF))); g1[bj] = *(const PG8_GAS f32x4*)((const PG8_GAS char*)gpost + (size_t)(4u * (unsigned)(col0 + bj * HALF + 4))); }
#pragma unroll
        for (int ai = 0; ai < 2; ++ai)
#pragma unroll
            for (int m = 0; m < 4; ++m) { const int rl = ai * HALF + rloc + m * 16; const float rs = XL[1024 + rl]; float sv = 0.f;
#pragma unroll
                for (int bj = 0; bj < 2; ++bj) { const u32x4 hb = hh[ai][m][bj]; const unsigned* y = yp[ai][m][bj]; const unsigned o1 = eo + (unsigned)((ai * HALF + m * 16) * 1024 + bj * HALF); float hv[8];
                    hv[0] = __builtin_bit_cast(float, hb.x << 16) + __builtin_bit_cast(float, y[0] << 16) * rs * g0[bj][0]; hv[1] = __builtin_bit_cast(float, hb.x & 0xffff0000u) + __builtin_bit_cast(float, y[0] & 0xffff0000u) * rs * g0[bj][1];
                    hv[2] = __builtin_bit_cast(float, hb.y << 16) + __builtin_bit_cast(float, y[1] << 16) * rs * g0[bj][2]; hv[3] = __builtin_bit_cast(float, hb.y & 0xffff0000u) + __builtin_bit_cast(float, y[1] & 0xffff0000u) * rs * g0[bj][3];
                    hv[4] = __builtin_bit_cast(float, hb.z << 16) + __builtin_bit_cast(float, y[2] << 16) * rs * g1[bj][0]; hv[5] = __builtin_bit_cast(float, hb.z & 0xffff0000u) + __builtin_bit_cast(float, y[2] & 0xffff0000u) * rs * g1[bj][1];
                    hv[6] = __builtin_bit_cast(float, hb.w << 16) + __builtin_bit_cast(float, y[3] << 16) * rs * g1[bj][2]; hv[7] = __builtin_bit_cast(float, hb.w & 0xffff0000u) + __builtin_bit_cast(float, y[3] & 0xffff0000u) * rs * g1[bj][3];
#pragma unroll
                    for (int e = 0; e < 8; ++e) sv += hv[e] * hv[e];
                    if (Hout) { u32x4 o; o.x = cvt_pk_bf16(hv[0], hv[1]); o.y = cvt_pk_bf16(hv[2], hv[3]); o.z = cvt_pk_bf16(hv[4], hv[5]); o.w = cvt_pk_bf16(hv[6], hv[7]); *(PG8_GAS u32x4*)((PG8_GAS char*)Hout + (size_t)(2u * o1)) = o; }
                    else { *(PG8_GAS f32x4*)((PG8_GAS char*)O32 + (size_t)(4u * o1)) = (f32x4){hv[0], hv[1], hv[2], hv[3]}; *(PG8_GAS f32x4*)((PG8_GAS char*)O32 + (size_t)(4u * o1 + 16u)) = (f32x4){hv[4], hv[5], hv[6], hv[7]}; } }
                if (SSH) { sv += __shfl_xor(sv, 16); sv += __shfl_xor(sv, 32); if (fq == 0) XL[rl * 4 + wc] = sv; } }
        asm volatile("s_waitcnt lgkmcnt(0)" ::: "memory"); __builtin_amdgcn_s_barrier();
        if (SSH && tid < BM) { const f32x4 q = *(const PG8_LAS f32x4*)(XL + tid * 4); *(PG8_GAS float*)((PG8_GAS char*)SSH + (size_t)(4u * (unsigned)((u.pm * BM + tid) * 4 + ct))) = (q[0] + q[1]) + (q[2] + q[3]); }
    }
};

struct EpiGLUNorm {
    static constexpr bool PERM = true, AFTER_DRAIN = false;
    const bf16_t* YS5; const float* bias; const float* gain; bf16_t* O; int ldc, ocol; PG8_LAS float* XL;
    __device__ __forceinline__ void operator()(const f32x4 (&acc)[2][2][4][2], const Unit& u, int wr, int wc, int fr, int fq) const {
        const int row0 = u.pm * BM + wr * 64 + fr, col0 = wc * 32 + 8 * fq;
        unsigned rp[2][4][2][4]; float ss[2][4];
#pragma unroll
        for (int ai = 0; ai < 2; ++ai)
#pragma unroll
            for (int m = 0; m < 4; ++m) ss[ai][m] = 0.f;
#pragma unroll
        for (int bj = 0; bj < 2; ++bj) { const int col = col0 + bj * HALF;
            const f32x4 b0 = *(const f32x4*)(bias + col), b1 = *(const f32x4*)(bias + col + 4);
#pragma unroll
            for (int ai = 0; ai < 2; ++ai) { u32x4 yy[4];
#pragma unroll
                for (int m = 0; m < 4; ++m) yy[m] = *(const u32x4*)(YS5 + (size_t)(row0 + ai * HALF + m * 16) * 256 + col);
#pragma unroll
                for (int m = 0; m < 4; ++m) { const u32x4 uu = yy[m];
                    float yv[8]; yv[0] = bf2f(uu.x & 0xffff); yv[1] = bf2f(uu.x >> 16); yv[2] = bf2f(uu.y & 0xffff); yv[3] = bf2f(uu.y >> 16);
                    yv[4] = bf2f(uu.z & 0xffff); yv[5] = bf2f(uu.z >> 16); yv[6] = bf2f(uu.w & 0xffff); yv[7] = bf2f(uu.w >> 16);
                    float rr[8];
#pragma unroll
                    for (int e = 0; e < 4; ++e) { rr[e] = yv[e] * fast_sigmoid(acc[ai][bj][m][0][e] + b0[e]); rr[4 + e] = yv[4 + e] * fast_sigmoid(acc[ai][bj][m][1][e] + b1[e]); }
#pragma unroll
                    for (int e = 0; e < 8; ++e) ss[ai][m] += rr[e] * rr[e];
#pragma unroll
                    for (int e = 0; e < 4; ++e) rp[ai][m][bj][e] = cvt_pk_bf16(rr[2 * e], rr[2 * e + 1]); }
                __builtin_amdgcn_sched_barrier(0); } }
#pragma unroll
        for (int ai = 0; ai < 2; ++ai)
#pragma unroll
            for (int m = 0; m < 4; ++m) { float v = ss[ai][m]; v += __shfl_xor(v, 16); v += __shfl_xor(v, 32);
                if (fq == 0) XL[(ai * HALF + wr * 64 + m * 16 + fr) * 4 + wc] = v; }
        asm volatile("s_waitcnt lgkmcnt(0)" ::: "memory"); __builtin_amdgcn_s_barrier();
#pragma unroll
        for (int bj = 0; bj < 2; ++bj) { const int col = col0 + bj * HALF; const f32x4 g0 = *(const f32x4*)(gain + col), g1 = *(const f32x4*)(gain + col + 4);
#pragma unroll
            for (int ai = 0; ai < 2; ++ai)
#pragma unroll
                for (int m = 0; m < 4; ++m) { const f32x4 q = *(const PG8_LAS f32x4*)(XL + (ai * HALF + wr * 64 + m * 16 + fr) * 4); const float rs = __builtin_amdgcn_rsqf(((q[0] + q[1]) + (q[2] + q[3])) * (1.f / 256.f) + 1e-6f);
                    const size_t row = (size_t)(row0 + ai * HALF + m * 16); const unsigned* pp = rp[ai][m][bj];
                    u32x4 w; w.x = cvt_pk_bf16(bf2f(pp[0] & 0xffff) * rs * g0[0], bf2f(pp[0] >> 16) * rs * g0[1]); w.y = cvt_pk_bf16(bf2f(pp[1] & 0xffff) * rs * g0[2], bf2f(pp[1] >> 16) * rs * g0[3]);
                    w.z = cvt_pk_bf16(bf2f(pp[2] & 0xffff) * rs * g1[0], bf2f(pp[2] >> 16) * rs * g1[1]); w.w = cvt_pk_bf16(bf2f(pp[3] & 0xffff) * rs * g1[2], bf2f(pp[3] >> 16) * rs * g1[3]);
                    *(u32x4*)(O + row * ldc + ocol + col) = w; } }
        asm volatile("s_waitcnt lgkmcnt(0)" ::: "memory"); __builtin_amdgcn_s_barrier();
    }
};
template <class Epi, class Sched, bool ALIGN_EPI = false, bool SP2 = false>
__device__ __forceinline__ void gemm_phase(PG8_LAS unsigned char* lds, const Gemm g, const Sched& S, const Epi& E) {
    int tid_op = threadIdx.x; asm volatile("" : "+v"(tid_op));
    const int tid = tid_op, wid = __builtin_amdgcn_readfirstlane(tid >> 6), lane = tid & 63, wr = wid >> 2, wc = wid & 3, fr = lane & 15, fq = lane >> 4;
    int Kop = g.K; asm volatile("" : "+s"(Kop));
    const int K = Kop, nt = K / BK;
    unsigned voffA[2], voffB[2];
#pragma unroll
    for (int i = 0; i < 2; ++i) { int R, C; stage_rc(tid * 16 + i * 8192, R, C); const int Rb = Epi::PERM ? ((R & ~31) + perm32(R & 31)) : R;
        voffA[i] = (unsigned)(R * g.lda + C) * 2u; voffB[i] = (unsigned)(Rb * K + C) * 2u; }
    const size_t kstep = (size_t)(BK * 2);
    const size_t hstepB = (size_t)HALF * K * 2, hstepA = (size_t)HALF * g.lda * 2;
    const size_t tstepA = 2 * hstepA, tstepB = 2 * hstepB;
    const unsigned ldsw = (unsigned)wid * 1024u;
    const int aoff = lds_byte(wr * 64 + fr, fq * 8), boff = lds_byte(wc * 32 + fr, fq * 8);
#define PG8_SA(b, h) (((b) * 2 + (h)) * HTB)
#define PG8_SB(b, h) ((4 + (b) * 2 + (h)) * HTB)
#define PG8_STAGE(bufoff, gbase, voff) do { _Pragma("unroll") for (int _i = 0; _i < 2; ++_i) \
        __builtin_amdgcn_global_load_lds((const unsigned*)((const char*)(gbase) + (voff)[_i]), (PG8_LAS unsigned*)(lds + (bufoff) + ldsw + _i * 8192), 16, 0, 0); } while (0)
#define PG8_LDA(dst, b, h) do { _Pragma("unroll") for (int m = 0; m < 4; ++m) _Pragma("unroll") for (int k = 0; k < 2; ++k) dst[m][k] = *(const PG8_LAS bf16x8*)(lds + PG8_SA(b, h) + aoff + m * 2048 + k * 1024); } while (0)
#define PG8_LDB(dst, b, h) do { _Pragma("unroll") for (int n = 0; n < 2; ++n) _Pragma("unroll") for (int k = 0; k < 2; ++k) dst[n][k] = *(const PG8_LAS bf16x8*)(lds + PG8_SB(b, h) + boff + n * 2048 + k * 1024); } while (0)
#define PG8_MMA(ai, bj, At, Bt) do { __builtin_amdgcn_s_setprio(1); _Pragma("unroll") for (int m = 0; m < 4; ++m) _Pragma("unroll") for (int n = 0; n < 2; ++n) _Pragma("unroll") for (int k = 0; k < 2; ++k) \
        acc[ai][bj][m][n] = __builtin_amdgcn_mfma_f32_16x16x32_bf16(Bt[n][k], At[m][k], acc[ai][bj][m][n], 0, 0, 0); __builtin_amdgcn_s_setprio(0); } while (0)
#define PG8_WAIT_V(n) asm volatile("s_waitcnt vmcnt(" #n ")" ::: "memory")
#define PG8_WAIT_L(n) asm volatile("s_waitcnt lgkmcnt(" #n ")" ::: "memory")
#define PG8_BAR __builtin_amdgcn_s_barrier()
#define PG8_SCHED __builtin_amdgcn_sched_barrier(0)
    const char* gA0; const char* gB0;
    { const unsigned long long va = (unsigned long long)g.A, vb = (unsigned long long)g.Bt;
      gA0 = (const char*)(((unsigned long long)(unsigned)__builtin_amdgcn_readfirstlane((int)(va >> 32)) << 32) | (unsigned)__builtin_amdgcn_readfirstlane((int)va));
      gB0 = (const char*)(((unsigned long long)(unsigned)__builtin_amdgcn_readfirstlane((int)(vb >> 32)) << 32) | (unsigned)__builtin_amdgcn_readfirstlane((int)vb)); }
    Unit cur, nxt; int ui = 0;
    if (!S.next(0, cur)) return;
    f32x4 acc[2][2][4][2];
#pragma unroll
    for (int a = 0; a < 2; ++a)
#pragma unroll
        for (int b = 0; b < 2; ++b)
#pragma unroll
            for (int m = 0; m < 4; ++m)
#pragma unroll
                for (int n = 0; n < 2; ++n) acc[a][b][m][n] = (f32x4){0.f, 0.f, 0.f, 0.f};
    bf16x8 At[4][2], B0[2][2], B1[2][2];
    const char* cA = gA0 + (size_t)cur.pm * tstepA; const char* cB = gB0 + (size_t)cur.pn * tstepB;
    S.a_ready(cur);
    if constexpr (SP2) {
        PG8_STAGE(PG8_SB(0, 0), cB, voffB); PG8_STAGE(PG8_SB(0, 1), cB + hstepB, voffB); PG8_STAGE(PG8_SA(0, 0), cA, voffA); PG8_STAGE(PG8_SA(0, 1), cA + hstepA, voffA);
        if (wr == 1) PG8_BAR;
        PG8_WAIT_V(2); PG8_BAR;
        PG8_STAGE(PG8_SB(1, 0), cB + kstep, voffB); PG8_STAGE(PG8_SA(1, 0), cA + kstep, voffA); PG8_STAGE(PG8_SB(1, 1), cB + hstepB + kstep, voffB);
        PG8_WAIT_V(6); PG8_BAR;
    } else {
        PG8_STAGE(PG8_SB(0, 0), cB, voffB); PG8_STAGE(PG8_SA(0, 0), cA, voffA); PG8_STAGE(PG8_SB(0, 1), cB + hstepB, voffB); PG8_STAGE(PG8_SA(0, 1), cA + hstepA, voffA);
        if (wr == 1) PG8_BAR;
        PG8_WAIT_V(4); PG8_BAR;
        PG8_STAGE(PG8_SB(1, 0), cB + kstep, voffB); PG8_STAGE(PG8_SA(1, 0), cA + kstep, voffA); PG8_STAGE(PG8_SB(1, 1), cB + hstepB + kstep, voffB);
        PG8_WAIT_V(6); PG8_BAR;
    }
    for (;;) {
        const bool has_next = S.next(ui + 1, nxt);
        if constexpr (has_rowstage<Epi>::value) { if (wid < 4)
            __builtin_amdgcn_global_load_lds((const unsigned*)((const char*)E.RS + ((size_t)cur.pm * BM + wid * 64 + lane) * 16), (PG8_LAS unsigned*)(lds + XR_OFF + (ui & 1) * 4096 + wid * 1024), 16, 0, 0); }
        const char* gA = gA0; const char* gB = gB0; asm volatile("" : "+s"(gA), "+s"(gB));
        const char* nA = has_next ? gA + (size_t)nxt.pm * tstepA : cA; const char* nB = has_next ? gB + (size_t)nxt.pn * tstepB : cB;
        for (int t = 0; t < nt; t += 2) {
            const bool last = (t == nt - 2);
            const char* a1 = cA + (size_t)(t + 1) * kstep;
            const char* a2 = last ? nA : cA + (size_t)(t + 2) * kstep; const char* b2 = last ? nB : cB + (size_t)(t + 2) * kstep;
            const char* a3 = a2 + kstep; const char* b3 = b2 + kstep;
            if (last && has_next) S.a_ready(nxt);
            if constexpr (SP2) {
            PG8_LDB(B0, 0, 0); PG8_LDB(B1, 0, 1); PG8_SCHED; PG8_LDA(At, 0, 0); PG8_STAGE(PG8_SA(1, 1), a1 + hstepA, voffA);
            PG8_WAIT_V(8); PG8_WAIT_L(0); PG8_BAR; PG8_MMA(0, 0, At, B0); PG8_MMA(0, 1, At, B1); PG8_BAR; PG8_SCHED;
            PG8_LDA(At, 0, 1); PG8_STAGE(PG8_SB(0, 0), b2, voffB); PG8_STAGE(PG8_SB(0, 1), b2 + hstepB, voffB); PG8_STAGE(PG8_SA(0, 0), a2, voffA);
            PG8_WAIT_V(8); PG8_WAIT_L(0); PG8_BAR; PG8_MMA(1, 0, At, B0); PG8_MMA(1, 1, At, B1); PG8_BAR; PG8_SCHED;
            PG8_LDB(B0, 1, 0); PG8_LDB(B1, 1, 1); PG8_SCHED; PG8_LDA(At, 1, 0); PG8_STAGE(PG8_SA(0, 1), a2 + hstepA, voffA);
            PG8_WAIT_V(8); PG8_WAIT_L(0); PG8_BAR; PG8_MMA(0, 0, At, B0); PG8_MMA(0, 1, At, B1); PG8_BAR; PG8_SCHED;
            PG8_LDA(At, 1, 1); PG8_STAGE(PG8_SB(1, 0), b3, voffB); PG8_STAGE(PG8_SB(1, 1), b3 + hstepB, voffB); PG8_STAGE(PG8_SA(1, 0), a3, voffA);
            PG8_WAIT_V(8); PG8_WAIT_L(0); PG8_BAR; PG8_MMA(1, 0, At, B0); PG8_MMA(1, 1, At, B1); PG8_BAR; PG8_SCHED;
            } else {
            PG8_LDB(B0, 0, 0); PG8_SCHED; PG8_LDA(At, 0, 0); PG8_STAGE(PG8_SA(1, 1), a1 + hstepA, voffA);
            PG8_WAIT_L(8); PG8_BAR; PG8_WAIT_L(0); PG8_MMA(0, 0, At, B0); PG8_BAR; PG8_SCHED;
            PG8_LDB(B1, 0, 1); PG8_STAGE(PG8_SB(0, 0), b2, voffB);
            PG8_BAR; PG8_WAIT_L(0); PG8_MMA(0, 1, At, B1); PG8_BAR;
            PG8_LDA(At, 0, 1); PG8_STAGE(PG8_SA(0, 0), a2, voffA);
            PG8_BAR; PG8_WAIT_L(0); PG8_MMA(1, 0, At, B0); PG8_BAR; PG8_SCHED;
            PG8_STAGE(PG8_SB(0, 1), b2 + hstepB, voffB);
            PG8_WAIT_V(6); PG8_BAR; PG8_MMA(1, 1, At, B1); PG8_BAR;
            PG8_LDB(B0, 1, 0); PG8_SCHED; PG8_LDA(At, 1, 0); PG8_STAGE(PG8_SA(0, 1), a2 + hstepA, voffA);
            PG8_WAIT_L(8); PG8_BAR; PG8_WAIT_L(0); PG8_MMA(0, 0, At, B0); PG8_BAR; PG8_SCHED;
            PG8_LDB(B1, 1, 1); PG8_STAGE(PG8_SB(1, 0), b3, voffB);
            PG8_BAR; PG8_WAIT_L(0); PG8_MMA(0, 1, At, B1); PG8_BAR;
            PG8_LDA(At, 1, 1); PG8_STAGE(PG8_SA(1, 0), a3, voffA);
            PG8_BAR; PG8_WAIT_L(0); PG8_MMA(1, 0, At, B0); PG8_BAR; PG8_SCHED;
            PG8_STAGE(PG8_SB(1, 1), b3 + hstepB, voffB);
            PG8_WAIT_V(6); PG8_BAR; PG8_MMA(1, 1, At, B1); PG8_BAR;
            }
        }
        if constexpr (ALIGN_EPI) { if (wr == 0) PG8_BAR; }
        cur.par = ui & 1;
        if constexpr (!Epi::AFTER_DRAIN) { E(acc, cur, wr, wc, fr, fq); S.done(cur); }
        if (!has_next) break;
#pragma unroll
        for (int a = 0; a < 2; ++a)
#pragma unroll
            for (int b = 0; b < 2; ++b)
#pragma unroll
                for (int m = 0; m < 4; ++m)
#pragma unroll
                    for (int n = 0; n < 2; ++n) acc[a][b][m][n] = (f32x4){0.f, 0.f, 0.f, 0.f};
        cur = nxt; cA = nA; cB = nB; ++ui;
        if constexpr (ALIGN_EPI) { if (wr == 1) PG8_BAR; }
    }
    PG8_WAIT_V(0);
    if constexpr (!ALIGN_EPI) { if (wr == 0) PG8_BAR; }
    PG8_BAR;
    if constexpr (Epi::AFTER_DRAIN) { E.fused(acc, cur, wr, wc, fr, fq, lds, wid, lane); S.done(cur); }
#undef PG8_SA
#undef PG8_SB
#undef PG8_STAGE
#undef PG8_LDA
#undef PG8_LDB
#undef PG8_MMA
#undef PG8_WAIT_V
#undef PG8_WAIT_L
#undef PG8_BAR
#undef PG8_SCHED
}
}
constexpr int NWAVES = 8, NTHR = NWAVES * 64;
constexpr int BATCH = 16, SEQ = 2048, DMODEL = 1024, FFD = 2816, MTOK = BATCH * SEQ, DEPTH = 2;
constexpr int MEML = 256, MROWS = BATCH * MEML;
constexpr int NIN_SRC = 2032, NIN = 2048;
constexpr float NORM_EPS = 1e-6f, LOG2E = 1.4426950408889634f, NEGBIG = -1e30f;
constexpr int PC_CQ = 0, PC_CKV = 192, PC_KPE = 320, PC_NQ = 352, PC_KCMP = 608, PC_VCMP = 672, PC_KSLC = 736, PC_VSLC = 800, PC_KSWA = 864, PC_VSWA = 928,
              PC_FQ = 992, PC_FK = 1248, PC_FV = 1504, PC_S5 = 1760, PC_GATE = 2016, PC_FF = 2028;

constexpr size_t MiB = 1u << 20, KiB = 1u << 10;
constexpr size_t WS_CTL = 0, CTL_ZERO_BYTES = 64 * KiB;
constexpr int CW_GRP = 8192;
constexpr int CW_BAR = 1024;
constexpr size_t WS_WGU1 = 1 * MiB;
constexpr size_t WS_WD1  = WS_WGU1 + 11 * MiB;
constexpr size_t WS_WGU2 = WS_WD1 + 6 * MiB;
constexpr size_t WS_WD2  = WS_WGU2 + 11 * MiB;
constexpr size_t WS_WIN  = WS_WD2 + 6 * MiB;
constexpr size_t WS_WOUT = WS_WIN + 4 * MiB;
constexpr size_t WS_WXQ  = WS_WOUT + 2 * MiB;
constexpr size_t WS_WXKV = WS_WXQ + 2 * MiB;
constexpr size_t WS_WXO  = WS_WXKV + 4 * MiB;
constexpr size_t WS_WPHI = WS_WXO + 2 * MiB;
constexpr size_t WS_WUQ  = WS_WPHI + 2 * MiB;
constexpr size_t WS_WUKV = WS_WUQ + 256 * KiB;
constexpr size_t WS_WGLU = WS_WUKV + 128 * KiB;
constexpr size_t WS_FS5  = WS_WGLU + 128 * KiB;
constexpr size_t WS_MISC = WS_FS5 + 4 * MiB;
constexpr size_t WS_BTS5 = WS_MISC + 2 * MiB;
constexpr size_t WS_U    = WS_BTS5 + 40 * MiB;
constexpr size_t WS_H    = WS_U + 64 * MiB;
constexpr size_t WS_BIG  = WS_H + 64 * MiB;
constexpr size_t WS_VWO  = WS_BIG + 240 * MiB;
constexpr size_t WS_END  = WS_VWO + 32 * MiB;
static_assert(WS_END <= 512 * MiB, "workspace map exceeds 512 MiB");
constexpr size_t MS_PHIB = 0;
constexpr size_t MS_A64 = 4 * KiB;
constexpr size_t MS_ROPEM = 16 * KiB;
constexpr size_t MS_ROPEN = MS_ROPEM + 256 * KiB;
constexpr size_t MS_WPHI2 = 1280 * KiB;
constexpr size_t MS_RS = 1 * MiB;
constexpr size_t MS_PHIP = MS_ROPEN + 512 * KiB;
constexpr size_t BG_ACT = 0;
constexpr size_t BG_Y = 176 * MiB;
constexpr size_t BG_WXKV1 = BG_Y + 2 * MiB, BG_MEMN1 = BG_Y + 6 * MiB, BG_KH1 = BG_Y + 14 * MiB, BG_VT1 = BG_Y + 22 * MiB;
static_assert(BG_VT1 + 8 * MiB <= 240 * MiB, "Y region");
constexpr size_t BG_SSY = BG_Y, BG_SSH = BG_Y + 1 * MiB;
constexpr size_t BG_QM = 0, BG_KVM = 32 * MiB;
constexpr size_t BG_CQN = 64 * MiB;
constexpr size_t BG_SSQ = 76 * MiB, BG_SSKV = 77 * MiB;
constexpr size_t BG_YS5 = BG_CQN;
constexpr size_t BG_CKVN = 80 * MiB;
constexpr size_t BG_US5 = 88 * MiB;
constexpr size_t BG_S5OUT = 104 * MiB;
constexpr size_t BG_KCMP = 144 * MiB;
constexpr size_t BG_VCMP = 149 * MiB;
constexpr size_t BG_HIDK = 154 * MiB, BG_HIDV = 155 * MiB;
constexpr size_t BG_KC = 156 * MiB, BG_VC = BG_KC + 256 * KiB;
constexpr size_t BG_XIN = BG_KC + 512 * KiB;
constexpr size_t BG_LOGF = BG_XIN + 2 * MiB;
constexpr size_t BG_CUM = BG_LOGF + 512 * KiB;
static_assert(BG_CUM + 512 * KiB <= 176 * MiB, "mixer overlay");
constexpr size_t BG_XQ = 0, BG_XO = 64 * MiB, BG_KH = 128 * MiB, BG_VT = 136 * MiB, BG_MEMN = 144 * MiB;
constexpr size_t BG_PX = 64 * MiB;

constexpr int RING_OFF = 0, RING_BYTES = 131072;
constexpr int LDSCTL_OFF = RING_BYTES, MISC_OFF = LDSCTL_OFF + 320;
constexpr int XCH_OFF = RING_BYTES + 1024;
constexpr int XR_OFF = XCH_OFF + 8192;
constexpr int LDS_BYTES = 155648;
static_assert(MISC_OFF + 128 <= XCH_OFF && XR_OFF + 8192 <= LDS_BYTES && XR_OFF == pg8::XR_OFF + RING_OFF, "LDS map");

#define GAS __attribute__((address_space(1)))
#define LAS __attribute__((address_space(3)))
typedef unsigned short bf16;
typedef unsigned v4u __attribute__((ext_vector_type(4)));
typedef unsigned v2u __attribute__((ext_vector_type(2)));
typedef float f32x4 __attribute__((ext_vector_type(4)));
typedef float f32x16 __attribute__((ext_vector_type(16)));
typedef short bf16x8 __attribute__((ext_vector_type(8)));
typedef short s16x4 __attribute__((ext_vector_type(4)));
typedef GAS unsigned gu32;
#define RLX_AGENT __ATOMIC_RELAXED, __HIP_MEMORY_SCOPE_AGENT
__device__ __forceinline__ unsigned f2bf(float f) { unsigned u = __builtin_bit_cast(unsigned, f); return (u + 0x7fffu + ((u >> 16) & 1u)) >> 16; }
__device__ __forceinline__ unsigned pk2(float lo, float hi) { return f2bf(lo) | (f2bf(hi) << 16); }
__device__ __forceinline__ float bflo(unsigned w) { return __builtin_bit_cast(float, w << 16); }
__device__ __forceinline__ float bfhi(unsigned w) { return __builtin_bit_cast(float, w & 0xffff0000u); }
__device__ __forceinline__ float b2f(bf16 b) { return __builtin_bit_cast(float, (unsigned)b << 16); }
using pg8::fast_sigmoid; using pg8::gelu_tanh;
#define XB_TMO      128
#define XB_XCNT(j)  (256  + 64 * (j))
#define XB_XSUB(j)  (1280 + 64 * (j))
#define XB_XGEN(j)  (2304 + 64 * (j))
#define XB_TOP      3328
#define XB_TOPGEN   3392
#define XCD_BAR_WORDS 3456
#define XB_SPIN_CAP (1u << 18)
#define LAS __attribute__((address_space(3)))

__device__ __forceinline__ unsigned xb_ld(unsigned* p)              { return __hip_atomic_load(p, __ATOMIC_RELAXED, __HIP_MEMORY_SCOPE_AGENT); }
__device__ __forceinline__ unsigned xb_add(unsigned* p, unsigned v) { return __hip_atomic_fetch_add(p, v, __ATOMIC_RELAXED, __HIP_MEMORY_SCOPE_AGENT); }
__device__ __forceinline__ unsigned xb_xcc_id() { return (unsigned)__builtin_amdgcn_s_getreg((3 << 11) | 20) & 0xFu; }
#define XB_SPIN(cond, bar) do { unsigned _sp = 0; while (cond) { __builtin_amdgcn_s_sleep(1); \
    if ((++_sp & 255u) == 0u) { if (xb_ld(&(bar)[XB_TMO])) break; if (_sp > XB_SPIN_CAP) { atomicAdd(&(bar)[XB_TMO], 1u); break; } } } } while (0)

struct XcdBarrier {
    unsigned* bar; unsigned x;
    volatile LAS unsigned* st;
};

__device__ __forceinline__ XcdBarrier xcd_barrier_post(unsigned* bar, volatile LAS unsigned* st) {
    XcdBarrier b; b.bar = bar; b.x = xb_xcc_id(); b.st = st;
    if (threadIdx.x == 0) (void)xb_add(&bar[XB_XCNT(b.x)], 1u);
    return b;
}
__device__ __forceinline__ void xcd_barrier_complete(unsigned* bar, unsigned x, unsigned& nloc, unsigned& nx) {
    const unsigned G = gridDim.x * gridDim.y * gridDim.z;
    unsigned sum, cnt, mine, sp = 0u;
    for (;;) {
        sum = 0u; cnt = 0u; mine = 0u;
#pragma unroll
        for (unsigned j = 0; j < 16; ++j) { const unsigned c = xb_ld(&bar[XB_XCNT(j)]); sum += c; cnt += (c > 0u) ? 1u : 0u; mine = (j == x) ? c : mine; }
        if (sum == G) break;
        __builtin_amdgcn_s_sleep(1);
        if ((++sp & 255u) == 0u) { if (xb_ld(&bar[XB_TMO])) break; if (sp > XB_SPIN_CAP) { atomicAdd(&bar[XB_TMO], 1u); break; } }
    }
    nloc = mine > 0u ? mine : 1u; nx = cnt > 0u ? cnt : 1u;
}

__device__ __forceinline__ void xcd_barrier(const XcdBarrier& b) {
    asm volatile("s_waitcnt vmcnt(0)" ::: "memory");
    __syncthreads();
    if (threadIdx.x == 0) {
        unsigned* bar = b.bar;
        __builtin_amdgcn_s_waitcnt(0);
        unsigned nloc = b.st[0], nx = b.st[1];
        if (nloc == 0u) { xcd_barrier_complete(bar, b.x, nloc, nx); b.st[0] = nloc; b.st[1] = nx; }
        const unsigned old = xb_add(&bar[XB_XSUB(b.x)], 1u);
        const unsigned gen = old / nloc;
        if (old + 1u == (gen + 1u) * nloc) {
            __builtin_amdgcn_fence(__ATOMIC_RELEASE, "agent");
            asm volatile("s_waitcnt vmcnt(0)" ::: "memory");
            const unsigned og = xb_add(&bar[XB_TOP], 1u);
            const unsigned tg = og / nx;
            if (og + 1u == (tg + 1u) * nx) xb_add(&bar[XB_TOPGEN], 1u);
            else XB_SPIN(xb_ld(&bar[XB_TOPGEN]) == tg, bar);
            __builtin_amdgcn_fence(__ATOMIC_ACQUIRE, "agent");
            xb_add(&bar[XB_XGEN(b.x)], 1u);
            asm volatile("s_waitcnt vmcnt(0)" ::: "memory");
        } else {
            XB_SPIN(xb_ld(&bar[XB_XGEN(b.x)]) == gen, bar);
            __builtin_amdgcn_fence(__ATOMIC_ACQUIRE, "agent");
            asm volatile("s_waitcnt vmcnt(0)" ::: "memory");
        }
    }
    __syncthreads();
}
struct Frame {
    LAS unsigned char* lds;
    gu32* ctl;
    int tid, lane, wave, vcu, G;
    unsigned char* ws;
    const float* const* in;
};
__device__ __forceinline__ float wave_sum(float v) {
#pragma unroll
    for (int o = 1; o < 64; o <<= 1) v += __shfl_xor(v, o);
    return v;
}
#define LDS_WAIT() asm volatile("s_waitcnt lgkmcnt(0)" ::: "memory")

enum { MAP_ID = 0, MAP_GATE = 1, MAP_UP = 2, MAP_WIN = 3, MAP_UQ = 4 };
__device__ __forceinline__ int ileave(int d, int half) { return d < half ? 2 * d : 2 * (d - half) + 1; }
__device__ __forceinline__ int map_row(int mode, int n) {
    if (mode == MAP_GATE) return 256 * (n >> 7) + (n & 127);
    if (mode == MAP_UP)   return 256 * (n >> 7) + 128 + (n & 127);
    if (mode == MAP_WIN) {
        if (n < 320) return n;
        if (n < 352) return 320 + ileave(n - 320, 16);
        if (n < 672) { const int h = (n - 352) >> 6; return 352 + 64 * h + ileave((n - 352) & 63, 32); }
        if (n < 736) return n;
        if (n < 800) return 736 + ileave(n - 736, 32);
        if (n < 864) return n;
        if (n < 928) return 864 + ileave(n - 864, 32);
        if (n < 992) return n;
        if (n < 1004) return PC_GATE + (n - 992); if (n < 1772) return n - 12; if (n < 1776) return PC_FF + (n - 1772); if (n < 2032) return n - 16; return n; }
    if (mode == MAP_UQ) { if (n >= 384) return n; const int h = n / 96, j = n - 96 * h; return j < 64 ? n : 96 * h + 64 + ileave(j - 64, 16); }
    return n;
}
__device__ __forceinline__ void tr_item(const float* W, int Ks, int Ns, bf16* WT, int Kd, int Nd, int mode, LAS float* scr, int item, int lane, const float* kscale = nullptr) {
    const int nblk = Nd / 32, kb = item / nblk, nb = item % nblk, k0 = 64 * kb, n0 = 32 * nb;
    if ((Ns & 3) == 0 && n0 + 32 <= Ns) {
        const int n4 = (lane & 7) * 4;
        f32x4 v[8];
#pragma unroll
        for (int i = 0; i < 8; ++i) { const int k = k0 + (lane >> 3) + 8 * i; v[i] = (k < Ks) ? *(const GAS f32x4*)(W + (size_t)k * Ns + n0 + n4) : (f32x4){0.f, 0.f, 0.f, 0.f}; }
#pragma unroll
        for (int i = 0; i < 8; ++i) { const int kk = (lane >> 3) + 8 * i; const float sc = (kscale && k0 + kk < Ks) ? kscale[k0 + kk] : 1.f; *(LAS f32x4*)(scr + kk * 36 + n4) = v[i] * sc; }
    } else {
        const int n_l = n0 + (lane & 31);
#pragma unroll 8
        for (int i = 0; i < 32; ++i) { const int kk = 2 * i + (lane >> 5); const int k = k0 + kk;
            float v = (k < Ks && n_l < Ns) ? W[(size_t)k * Ns + n_l] : 0.f; if (kscale && k < Ks) v *= kscale[k];
            scr[kk * 36 + (lane & 31)] = v; }
    }
    LDS_WAIT(); asm volatile("" ::: "memory");
    const int c = lane & 7;
#pragma unroll
    for (int j = 0; j < 4; ++j) { const int n = (lane >> 3) + 8 * j; const LAS float* s = scr + (8 * c) * 36 + n;
        v4u o; o.x = pk2(s[0 * 36], s[1 * 36]); o.y = pk2(s[2 * 36], s[3 * 36]); o.z = pk2(s[4 * 36], s[5 * 36]); o.w = pk2(s[6 * 36], s[7 * 36]);
        const int nd = map_row(mode, n0 + n);
        *(GAS v4u*)(WT + (size_t)nd * Kd + k0 + 8 * c) = o; }
    LDS_WAIT(); asm volatile("" ::: "memory");
}

__device__ __forceinline__ void norm_row(int lane, const bf16* yrow, const bf16* hrow, const float* x32, bf16* hout, float* out32, const float* gpost, float w, float* rsout) {
    f32x4 hv[4];
    if (yrow) {
        f32x4 yv[4]; float s = 0.f;
#pragma unroll
        for (int j = 0; j < 4; ++j) { const v2u hb = ((const GAS v2u*)hrow)[lane + 64 * j], yb = ((const GAS v2u*)yrow)[lane + 64 * j];
            hv[j] = (f32x4){bflo(hb.x), bfhi(hb.x), bflo(hb.y), bfhi(hb.y)}; yv[j] = (f32x4){bflo(yb.x), bfhi(yb.x), bflo(yb.y), bfhi(yb.y)};
            s += (yv[j].x * yv[j].x + yv[j].y * yv[j].y) + (yv[j].z * yv[j].z + yv[j].w * yv[j].w); }
        const float rs = w * __builtin_amdgcn_rsqf(wave_sum(s) * (1.f / DMODEL) + NORM_EPS);
#pragma unroll
        for (int j = 0; j < 4; ++j) { const f32x4 g = ((const GAS f32x4*)gpost)[lane + 64 * j]; hv[j] = hv[j] + yv[j] * g * rs; }
    } else {
#pragma unroll
        for (int j = 0; j < 4; ++j) hv[j] = ((const GAS f32x4*)x32)[lane + 64 * j];
    }
    if (hout) {
#pragma unroll
        for (int j = 0; j < 4; ++j) { v2u o; o.x = pk2(hv[j].x, hv[j].y); o.y = pk2(hv[j].z, hv[j].w); ((GAS v2u*)hout)[lane + 64 * j] = o; }
    }
    if (out32) {
#pragma unroll
        for (int j = 0; j < 4; ++j) ((GAS f32x4*)out32)[lane + 64 * j] = hv[j];
    }
    if (rsout) {
        float s2 = 0.f;
#pragma unroll
        for (int j = 0; j < 4; ++j) s2 += (hv[j].x * hv[j].x + hv[j].y * hv[j].y) + (hv[j].z * hv[j].z + hv[j].w * hv[j].w);
        const float tot = wave_sum(s2);
        if (lane == 0) *(GAS f32x4*)rsout = (f32x4){tot, 0.f, 0.f, 0.f};
    }
}
__device__ __forceinline__ void xpass_rows2(int lane, const float* xa, const float* xb, bf16* ha, bf16* hb, float* ra, float* rb) {
    f32x4 va[4], vb[4];
#pragma unroll
    for (int j = 0; j < 4; ++j) { va[j] = ((const GAS f32x4*)xa)[lane + 64 * j]; vb[j] = ((const GAS f32x4*)xb)[lane + 64 * j]; }
    float sa = 0.f, sb = 0.f;
#pragma unroll
    for (int j = 0; j < 4; ++j) { sa += (va[j].x * va[j].x + va[j].y * va[j].y) + (va[j].z * va[j].z + va[j].w * va[j].w); sb += (vb[j].x * vb[j].x + vb[j].y * vb[j].y) + (vb[j].z * vb[j].z + vb[j].w * vb[j].w); }
#pragma unroll
    for (int j = 0; j < 4; ++j) { v2u o; o.x = pk2(va[j].x, va[j].y); o.y = pk2(va[j].z, va[j].w); ((GAS v2u*)ha)[lane + 64 * j] = o; v2u q; q.x = pk2(vb[j].x, vb[j].y); q.y = pk2(vb[j].z, vb[j].w); ((GAS v2u*)hb)[lane + 64 * j] = q; }
    const float ta = wave_sum(sa), tb = wave_sum(sb);
    if (lane == 0) { *(GAS f32x4*)ra = (f32x4){ta, 0.f, 0.f, 0.f}; *(GAS f32x4*)rb = (f32x4){tb, 0.f, 0.f, 0.f}; }
}
__device__ __forceinline__ void norm_only_row(int lane, const float* xrow, const float* g, bf16* urow) {
    f32x4 hv[4]; float s2 = 0.f;
#pragma unroll
    for (int j = 0; j < 4; ++j) { hv[j] = ((const GAS f32x4*)xrow)[lane + 64 * j]; s2 += (hv[j].x * hv[j].x + hv[j].y * hv[j].y) + (hv[j].z * hv[j].z + hv[j].w * hv[j].w); }
    const float rs2 = __builtin_amdgcn_rsqf(wave_sum(s2) * (1.f / DMODEL) + NORM_EPS);
#pragma unroll
    for (int j = 0; j < 4; ++j) { const f32x4 gg = ((const GAS f32x4*)g)[lane + 64 * j]; const f32x4 v = hv[j] * gg * rs2;
        v2u o; o.x = pk2(v.x, v.y); o.y = pk2(v.z, v.w); ((GAS v2u*)urow)[lane + 64 * j] = o; }
}
__device__ __forceinline__ void groupnorm_row(int lane, bf16* row, const float* gg) {
    v4u a = ((GAS v4u*)row)[2 * lane], b = ((GAS v4u*)row)[2 * lane + 1];
    float v[16];
    v[0] = bflo(a.x); v[1] = bfhi(a.x); v[2] = bflo(a.y); v[3] = bfhi(a.y); v[4] = bflo(a.z); v[5] = bfhi(a.z); v[6] = bflo(a.w); v[7] = bfhi(a.w);
    v[8] = bflo(b.x); v[9] = bfhi(b.x); v[10] = bflo(b.y); v[11] = bfhi(b.y); v[12] = bflo(b.z); v[13] = bfhi(b.z); v[14] = bflo(b.w); v[15] = bfhi(b.w);
    float s = 0.f;
#pragma unroll
    for (int i = 0; i < 16; ++i) s += v[i] * v[i];
#pragma unroll
    for (int o = 1; o < 16; o <<= 1) s += __shfl_xor(s, o);
    const float rs = __builtin_amdgcn_rsqf(s * (1.f / 256.f) + NORM_EPS);
    const float* g = gg + 16 * lane;
#pragma unroll
    for (int i = 0; i < 16; ++i) v[i] = v[i] * rs * g[i];
    a.x = pk2(v[0], v[1]); a.y = pk2(v[2], v[3]); a.z = pk2(v[4], v[5]); a.w = pk2(v[6], v[7]);
    b.x = pk2(v[8], v[9]); b.y = pk2(v[10], v[11]); b.z = pk2(v[12], v[13]); b.w = pk2(v[14], v[15]);
    ((GAS v4u*)row)[2 * lane] = a; ((GAS v4u*)row)[2 * lane + 1] = b;
}

struct S5W { const float *lre, *lim, *ldt, *bre, *bim, *cre, *cim; bf16* BT; bf16* FS; float* A64; };
__device__ __forceinline__ void s5_item(LAS float* sm, int tid, int g, int tlo, int thi, const S5W& W) {
    LAS float* Ar = sm; LAS float* Ai = sm + 64; LAS float* Kr = sm + 128; LAS float* Ki = sm + 192; LAS float* A1r = sm + 256; LAS float* A1i = sm + 320; LAS float* KT = sm + 384;
    LAS float* Bkr = sm + 1024; LAS float* Bki = sm + 2048; LAS float* Cr = sm + 3072; LAS float* Ci = sm + 4096;
    __syncthreads();
    if (tid < 64) { const int p = tid; const float dt = __expf(W.ldt[g]); const float lr = W.lre[g * 64 + p], li = W.lim[g * 64 + p];
        const float mag1 = __expf(lr * dt), ar1 = mag1 * cosf(li * dt), ai1 = mag1 * sinf(li * dt);
        const float den = lr * lr + li * li; Kr[p] = ((ar1 - 1.f) * lr + ai1 * li) / den; Ki[p] = (ai1 * lr - (ar1 - 1.f) * li) / den; A1r[p] = ar1; A1i[p] = ai1;
        const float mg = __expf(lr * dt * (float)tlo);
        double ang = (double)li * (double)dt * (double)tlo; const double twopi = 6.283185307179586476925; ang -= twopi * rint(ang / twopi);
        const float af = (float)ang; Ar[p] = mg * cosf(af); Ai[p] = mg * sinf(af); }
    for (int i = tid; i < 1024; i += NTHR) { Cr[i] = W.cre[g * 1024 + i]; Ci[i] = W.cim[g * 1024 + i]; }
    __syncthreads();
    for (int i = tid; i < 1024; i += NTHR) { const int p = i >> 4; const float br = W.bre[g * 1024 + i], bi = W.bim[g * 1024 + i]; Bkr[i] = Kr[p] * br - Ki[p] * bi; Bki[i] = Kr[p] * bi + Ki[p] * br; }
    __syncthreads();
    bf16* BTg = W.BT + (size_t)g * 1280 * 1024;
    for (int tau = tlo; tau <= thi; ++tau) {
        if (tau < 64) {
            if (tid < 256) { const int c = tid >> 4, cp = tid & 15; float acc = 0.f;
#pragma unroll 8
                for (int p = 0; p < 64; ++p) { const float kbr = Bkr[p * 16 + cp], kbi = Bki[p * 16 + cp];
                    const float wr_ = kbr * Ar[p] - kbi * Ai[p], wi_ = kbr * Ai[p] + kbi * Ar[p];
                    acc += Cr[c * 64 + p] * wr_ - Ci[c * 64 + p] * wi_; }
                KT[c * 16 + cp] = acc; }
            __syncthreads();
            const int nseg = (64 - tau) * 16;
            for (int idx = tid; idx < nseg; idx += NTHR) { const int t = tau + (idx >> 4), c = idx & 15; const LAS float* k = KT + c * 16;
                v4u a, b; a.x = pk2(k[0], k[1]); a.y = pk2(k[2], k[3]); a.z = pk2(k[4], k[5]); a.w = pk2(k[6], k[7]); b.x = pk2(k[8], k[9]); b.y = pk2(k[10], k[11]); b.z = pk2(k[12], k[13]); b.w = pk2(k[14], k[15]);
                bf16* dst = BTg + (size_t)(t * 16 + c) * 1024 + (t - tau) * 16; *(GAS v4u*)dst = a; *(GAS v4u*)(dst + 8) = b;
                if (tau > 0) { bf16* dz = BTg + (size_t)((t - tau) * 16 + c) * 1024 + t * 16; const v4u z = {0u, 0u, 0u, 0u}; *(GAS v4u*)dz = z; *(GAS v4u*)(dz + 8) = z; } }
            if (tid < 128) { const int p = tid & 63, im = tid >> 6, s = 63 - tau; float v[16];
#pragma unroll
                for (int cp = 0; cp < 16; ++cp) { const float kbr = Bkr[p * 16 + cp], kbi = Bki[p * 16 + cp]; v[cp] = im ? (kbr * Ai[p] + kbi * Ar[p]) : (kbr * Ar[p] - kbi * Ai[p]); }
                v4u a, b; a.x = pk2(v[0], v[1]); a.y = pk2(v[2], v[3]); a.z = pk2(v[4], v[5]); a.w = pk2(v[6], v[7]); b.x = pk2(v[8], v[9]); b.y = pk2(v[10], v[11]); b.z = pk2(v[12], v[13]); b.w = pk2(v[14], v[15]);
                bf16* dst = BTg + (size_t)(1024 + im * 64 + p) * 1024 + s * 16; *(GAS v4u*)dst = a; *(GAS v4u*)(dst + 8) = b; }
        }
        if (tau >= 1 && tid >= 256) { const int i = tid - 256, c = i >> 4, p0 = (i & 15) * 8, t = tau - 1; const int im = p0 >= 64, pb = p0 & 63; float v[8];
#pragma unroll
            for (int j = 0; j < 8; ++j) { const int p = pb + j; const float cr = Cr[c * 64 + p], ci = Ci[c * 64 + p]; v[j] = im ? -(cr * Ai[p] + ci * Ar[p]) : (cr * Ar[p] - ci * Ai[p]); }
            v4u a; a.x = pk2(v[0], v[1]); a.y = pk2(v[2], v[3]); a.z = pk2(v[4], v[5]); a.w = pk2(v[6], v[7]);
            *(GAS v4u*)(W.FS + ((size_t)g * 1024 + t * 16 + c) * 128 + p0) = a; }
        if (tau == 64 && tid < 64) { W.A64[(g * 64 + tid) * 2] = Ar[tid]; W.A64[(g * 64 + tid) * 2 + 1] = Ai[tid]; }
        __syncthreads();
        if (tid < 64) { const float r = Ar[tid] * A1r[tid] - Ai[tid] * A1i[tid], im2 = Ar[tid] * A1i[tid] + Ai[tid] * A1r[tid]; Ar[tid] = r; Ai[tid] = im2; }
        __syncthreads();
    }
}

__device__ __forceinline__ void phib_part(int item, int lane, const float* pos, const float* w1, float* PHIP) {
    const int nb = item & 3, kc = (item >> 2) & 63, j = item >> 8, n = nb * 64 + lane; const float* w = w1 + (size_t)j * 2048 * 256 + (size_t)(kc * 32) * 256 + n; const float* ps = pos + j * 2048 + kc * 32;
    float acc = 0.f;
#pragma unroll
    for (int k = 0; k < 32; ++k) acc += ps[k] * w[(size_t)k * 256];
    PHIP[(j * 64 + kc) * 256 + n] = acc;
}
__device__ __forceinline__ void phib_final(int i, const float* PHIP, const float* b1, float* PHIB) {
    const int j = i >> 8, n = i & 255; float v[64];
#pragma unroll
    for (int kc = 0; kc < 64; ++kc) v[kc] = PHIP[(j * 64 + kc) * 256 + n];
    float acc = b1[i];
#pragma unroll
    for (int kc = 0; kc < 64; ++kc) acc += v[kc];
    PHIB[i] = acc;
}
__device__ __forceinline__ void rope_fill(float* tab, int nh, int idx) {
    const int pos = idx / nh, i = idx % nh; const float inv = 1.0f / powf(10000.0f, (float)(2 * i) / (float)(2 * nh)); const float ang = (float)pos * inv;
    double a = (double)ang; const double twopi = 6.283185307179586476925; a -= twopi * rint(a / twopi); const float af = (float)a;
    tab[2 * idx] = cosf(af); tab[2 * idx + 1] = sinf(af);
}
__device__ __forceinline__ void phi2_row(int lane, const bf16* hid, const float* w2, bf16* out) {
    float acc = 0.f;
#pragma unroll 8
    for (int k = 0; k < 256; ++k) acc += b2f(hid[k]) * w2[k * 64 + lane];
    out[lane] = (bf16)f2bf(acc);
}
__device__ __forceinline__ void cumsum_seq(int lane, const float* lf, float* cum) {
    float v[32]; float s = 0.f;
#pragma unroll
    for (int i = 0; i < 8; ++i) { const f32x4 x = ((const GAS f32x4*)lf)[lane * 8 + i]; v[4 * i] = x.x; v[4 * i + 1] = x.y; v[4 * i + 2] = x.z; v[4 * i + 3] = x.w; }
#pragma unroll
    for (int i = 0; i < 32; ++i) { s += v[i]; v[i] = s; }
    float incl = s;
#pragma unroll
    for (int o = 1; o < 64; o <<= 1) { const float n = __shfl_up(incl, o); if (lane >= o) incl += n; }
    const float excl = incl - s;
#pragma unroll
    for (int i = 0; i < 8; ++i) { f32x4 x; x.x = v[4 * i] + excl; x.y = v[4 * i + 1] + excl; x.z = v[4 * i + 2] + excl; x.w = v[4 * i + 3] + excl; ((GAS f32x4*)cum)[lane * 8 + i] = x; }
}
__device__ __forceinline__ void s5_carry_blk(int tid, int g, int half, const float* S5OUT, const float* A64, bf16* XIN) {
    const int p = tid & 63, b = 8 * half + (tid >> 6);
    const float ar = A64[(g * 64 + p) * 2], ai = A64[(g * 64 + p) * 2 + 1];
    float xr = 0.f, xi = 0.f;
    for (int k0 = 0; k0 < 32; k0 += 8) {
        float er[8], ei[8];
#pragma unroll
        for (int j = 0; j < 8; ++j) { const size_t row = (size_t)g * 512 + b * 32 + k0 + j;
            er[j] = __hip_atomic_load(S5OUT + row * 1280 + 1024 + p, __ATOMIC_RELAXED, __HIP_MEMORY_SCOPE_AGENT); ei[j] = __hip_atomic_load(S5OUT + row * 1280 + 1088 + p, __ATOMIC_RELAXED, __HIP_MEMORY_SCOPE_AGENT); }
#pragma unroll
        for (int j = 0; j < 8; ++j) { const size_t row = (size_t)g * 512 + b * 32 + k0 + j;
            XIN[row * 128 + p] = (bf16)f2bf(xr); XIN[row * 128 + 64 + p] = (bf16)f2bf(xi);
            const float nr = ar * xr - ai * xi + er[j], ni = ar * xi + ai * xr + ei[j]; xr = nr; xi = ni; }
    }
}
#define MFMA32(a, b, c) __builtin_amdgcn_mfma_f32_32x32x16_bf16(a, b, c, 0, 0, 0)
typedef short v4i16_t __attribute__((ext_vector_type(4)));
__device__ __forceinline__ int krow(int r, int hi) { return (r & 3) + 8 * (r >> 2) + 4 * hi; }
__device__ __forceinline__ s16x4 tr16(const LAS unsigned char* p) { return __builtin_bit_cast(s16x4, __builtin_amdgcn_ds_read_tr16_b64_v4i16((LAS v4i16_t*)p)); }
__device__ __forceinline__ unsigned cvtpk(float lo, float hi) { unsigned r; asm("v_cvt_pk_bf16_f32 %0, %1, %2" : "=v"(r) : "v"(lo), "v"(hi)); return r; }
typedef float f32x2_t __attribute__((ext_vector_type(2)));
typedef __bf16 bf16x2_t __attribute__((ext_vector_type(2)));
__device__ __forceinline__ unsigned cvtpk_c(float lo, float hi) { const f32x2_t v = {lo, hi}; const bf16x2_t b = __builtin_convertvector(v, bf16x2_t); return __builtin_bit_cast(unsigned, b); }

template <int DK> __device__ __forceinline__ f32x16 qk_tile(const LAS unsigned char* kt, int kp, const bf16x8 (&qf)[DK / 16], int lane) {
    const int r32 = lane & 31, hi = lane >> 5; f32x16 s;
#pragma unroll
    for (int r = 0; r < 16; ++r) s[r] = 0.f;
#pragma unroll
    for (int d0 = 0; d0 < DK / 16; ++d0) { const bf16x8 kf = *(const LAS bf16x8*)(kt + r32 * kp + d0 * 32 + hi * 16); s = MFMA32(kf, qf[d0], s); }
    return s;
}
template <int DV> __device__ __forceinline__ void pv_tile(f32x16 (&o)[DV / 32], const LAS unsigned char* vt, int vp, const f32x16& p, int lane) {
    const int hi = lane >> 5, q4 = (lane & 15) >> 2, p4 = lane & 3, ch = (lane >> 4) & 1;
    v4u w0, w1;
    w0.x = cvtpk(p[0], p[1]); w0.y = cvtpk(p[2], p[3]); w0.z = cvtpk(p[4], p[5]); w0.w = cvtpk(p[6], p[7]);
    w1.x = cvtpk(p[8], p[9]); w1.y = cvtpk(p[10], p[11]); w1.z = cvtpk(p[12], p[13]); w1.w = cvtpk(p[14], p[15]);
    const bf16x8 pf0 = __builtin_bit_cast(bf16x8, w0), pf1 = __builtin_bit_cast(bf16x8, w1);
    const LAS unsigned char* base = vt + (4 * hi + q4) * vp + (16 * ch + 4 * p4) * 2;
#pragma unroll
    for (int blk = 0; blk < DV / 32; ++blk) {
        const s16x4 a0 = tr16(base + blk * 64), a1 = tr16(base + 8 * vp + blk * 64), b0 = tr16(base + 16 * vp + blk * 64), b1 = tr16(base + 24 * vp + blk * 64);
        const bf16x8 vf0 = (bf16x8){a0[0], a0[1], a0[2], a0[3], a1[0], a1[1], a1[2], a1[3]}, vf1 = (bf16x8){b0[0], b0[1], b0[2], b0[3], b1[0], b1[1], b1[2], b1[3]};
        o[blk] = MFMA32(vf0, pf0, o[blk]); o[blk] = MFMA32(vf1, pf1, o[blk]);
    }
}
__device__ __forceinline__ float xhalf_max(float v) { const auto rr = __builtin_amdgcn_permlane32_swap(__float_as_uint(v), __float_as_uint(v), false, false); return fmaxf(__uint_as_float(rr[0]), __uint_as_float(rr[1])); }
__device__ __forceinline__ float xhalf_sum(float v) { const auto rr = __builtin_amdgcn_permlane32_swap(__float_as_uint(v), __float_as_uint(v), false, false); return __uint_as_float(rr[0]) + __uint_as_float(rr[1]); }
template <int NB> __device__ __forceinline__ void sm_update(f32x16& s, float& m, float& l, f32x16 (&o)[NB]) {
    float mx = s[0];
#pragma unroll
    for (int r = 1; r < 16; ++r) mx = fmaxf(mx, s[r]);
    mx = xhalf_max(mx);
    const float mn = fmaxf(m, mx), alpha = __builtin_amdgcn_exp2f(m - mn);
    float rs = 0.f;
#pragma unroll
    for (int r = 0; r < 16; ++r) { const float pv = __builtin_amdgcn_exp2f(s[r] - mn); s[r] = pv; rs += pv; }
    rs = xhalf_sum(rs);
    l = l * alpha + rs; m = mn;
    if (!__all(alpha == 1.0f)) {
#pragma unroll
        for (int b = 0; b < NB; ++b)
#pragma unroll
            for (int r = 0; r < 16; ++r) o[b][r] *= alpha;
    }
}
__device__ __forceinline__ bf16x8 scale_frag(bf16x8 q, float sc) {
    const v4u w = __builtin_bit_cast(v4u, q); v4u o;
    o.x = cvtpk(bflo(w.x) * sc, bfhi(w.x) * sc); o.y = cvtpk(bflo(w.y) * sc, bfhi(w.y) * sc); o.z = cvtpk(bflo(w.z) * sc, bfhi(w.z) * sc); o.w = cvtpk(bflo(w.w) * sc, bfhi(w.w) * sc);
    return __builtin_bit_cast(bf16x8, o); }
#define PRIO_BASE 0
template <int DK, int CH = 4> __device__ __forceinline__ void qk64(const LAS unsigned char* kt, int kp, const bf16x8 (&qf)[DK / 16], f32x16& s0, f32x16& s1, int lane) {
    const int r32 = lane & 31, hi = lane >> 5; constexpr int ND = DK / 16;
#pragma unroll
    for (int r = 0; r < 16; ++r) { s0[r] = 0.f; s1[r] = 0.f; }
    const LAS unsigned char* b0 = kt + r32 * kp + hi * 16; const LAS unsigned char* b1 = b0 + 32 * kp;
#pragma unroll
    for (int c0 = 0; c0 < ND; c0 += CH) {
        bf16x8 k0[CH], k1[CH];
#pragma unroll
        for (int i = 0; i < CH; ++i) if (c0 + i < ND) { k0[i] = *(const LAS bf16x8*)(b0 + (c0 + i) * 32); k1[i] = *(const LAS bf16x8*)(b1 + (c0 + i) * 32); }
        __builtin_amdgcn_s_setprio(2);
#pragma unroll
        for (int i = 0; i < CH; ++i) if (c0 + i < ND) { s0 = MFMA32(k0[i], qf[c0 + i], s0); s1 = MFMA32(k1[i], qf[c0 + i], s1); }
        __builtin_amdgcn_s_setprio(PRIO_BASE);
    }
}
__device__ __forceinline__ float tile_max64(const f32x16& s0, const f32x16& s1) {
    float mx = fmaxf(s0[0], s1[0]);
#pragma unroll
    for (int r = 1; r < 16; ++r) mx = fmaxf(mx, fmaxf(s0[r], s1[r]));
    return xhalf_max(mx);
}
template <int NB> __device__ __forceinline__ void softmax64m(f32x16& s0, f32x16& s1, float mx, float& m, float& l, f32x16 (&o)[NB]) {
    const float mn = fmaxf(m, mx), alpha = __builtin_amdgcn_exp2f(m - mn);
    float rs = 0.f;
#pragma unroll
    for (int r = 0; r < 16; ++r) { const float p0 = __builtin_amdgcn_exp2f(s0[r] - mn), p1 = __builtin_amdgcn_exp2f(s1[r] - mn); s0[r] = p0; s1[r] = p1; rs += p0 + p1; }
    rs = xhalf_sum(rs);
    l = l * alpha + rs; m = mn;
    if (!__all(alpha == 1.0f)) {
#pragma unroll
        for (int b = 0; b < NB; ++b)
#pragma unroll
            for (int r = 0; r < 16; ++r) o[b][r] *= alpha;
    }
}
template <int NB> __device__ __forceinline__ void softmax64(f32x16& s0, f32x16& s1, float& m, float& l, f32x16 (&o)[NB]) { softmax64m<NB>(s0, s1, tile_max64(s0, s1), m, l, o); }
template <int DV, int NBB = 2> __device__ __forceinline__ void pv64(f32x16 (&o)[DV / 32], const LAS unsigned char* vt, int vp, const f32x16& p0, const f32x16& p1, int lane) {
    const int hi = lane >> 5, q4 = (lane & 15) >> 2, p4 = lane & 3, ch = (lane >> 4) & 1;
    bf16x8 pf[4];
    { v4u w; w.x = cvtpk(p0[0], p0[1]); w.y = cvtpk(p0[2], p0[3]); w.z = cvtpk(p0[4], p0[5]); w.w = cvtpk(p0[6], p0[7]); pf[0] = __builtin_bit_cast(bf16x8, w);
      w.x = cvtpk(p0[8], p0[9]); w.y = cvtpk(p0[10], p0[11]); w.z = cvtpk(p0[12], p0[13]); w.w = cvtpk(p0[14], p0[15]); pf[1] = __builtin_bit_cast(bf16x8, w);
      w.x = cvtpk(p1[0], p1[1]); w.y = cvtpk(p1[2], p1[3]); w.z = cvtpk(p1[4], p1[5]); w.w = cvtpk(p1[6], p1[7]); pf[2] = __builtin_bit_cast(bf16x8, w);
      w.x = cvtpk(p1[8], p1[9]); w.y = cvtpk(p1[10], p1[11]); w.z = cvtpk(p1[12], p1[13]); w.w = cvtpk(p1[14], p1[15]); pf[3] = __builtin_bit_cast(bf16x8, w); }
    const LAS unsigned char* base = vt + (4 * hi + q4) * vp + (16 * ch + 4 * p4) * 2;
#pragma unroll
    for (int b2 = 0; b2 < DV / 32; b2 += NBB) {
        s16x4 a[NBB][8];
#pragma unroll
        for (int bb = 0; bb < NBB; ++bb)
#pragma unroll
            for (int k = 0; k < 8; ++k) a[bb][k] = tr16(base + (8 * k) * vp + (b2 + bb) * 64);
        __builtin_amdgcn_s_setprio(2);
#pragma unroll
        for (int k = 0; k < 4; ++k)
#pragma unroll
            for (int bb = 0; bb < NBB; ++bb) { const s16x4 lo = a[bb][2 * k], hh = a[bb][2 * k + 1];
                const bf16x8 vf = (bf16x8){lo[0], lo[1], lo[2], lo[3], hh[0], hh[1], hh[2], hh[3]};
                o[b2 + bb] = MFMA32(vf, pf[k], o[b2 + bb]); }
        __builtin_amdgcn_s_setprio(PRIO_BASE);
    }
}
template <int NCH> __device__ __forceinline__ void stage_rows(LAS unsigned char* dst, int lp, int nrows, const bf16* src0, int pitch0, const bf16* src1, int pitch1, int tid) {
    for (int c = tid; c < nrows * NCH; c += NTHR) { const int row = c / NCH, ch = c % NCH;
        const bf16* s = (NCH <= 8 || ch < 8 || src1 == nullptr) ? (src0 + (size_t)row * pitch0 + ch * 8) : (src1 + (size_t)row * pitch1 + (ch - 8) * 8);
        const v4u v = *(const GAS v4u*)s; *(LAS v4u*)(dst + row * lp + ch * 16) = v; }
}
template <int NB> __device__ __forceinline__ void store_ot(const f32x16 (&o)[NB], float sc, bf16* orow, int lane) {
    const int hi = lane >> 5;
#pragma unroll
    for (int b = 0; b < NB; ++b)
#pragma unroll
        for (int g = 0; g < 4; g += 2) {
            unsigned ax = cvtpk_c(o[b][4 * g] * sc, o[b][4 * g + 1] * sc), ay = cvtpk_c(o[b][4 * g + 2] * sc, o[b][4 * g + 3] * sc);
            unsigned bx = cvtpk_c(o[b][4 * g + 4] * sc, o[b][4 * g + 5] * sc), by = cvtpk_c(o[b][4 * g + 6] * sc, o[b][4 * g + 7] * sc);
            const auto rx = __builtin_amdgcn_permlane32_swap(ax, bx, false, false); const auto ry = __builtin_amdgcn_permlane32_swap(ay, by, false, false);
            v4u w; w.x = rx[0]; w.y = ry[0]; w.z = rx[1]; w.w = ry[1];
            *(GAS v4u*)(orow + 32 * b + 8 * g + 8 * hi) = w; }
}

template <int NCH, int ROWS = 64> struct TileRegs { static constexpr int N = (ROWS * NCH + NTHR - 1) / NTHR; v4u r[N]; };
template <int NCH, int ROWS = 64> __device__ __forceinline__ void tile_issue(TileRegs<NCH, ROWS>& T, const bf16* src0, int pitch0, const bf16* src1, int pitch1, int tid) {
#pragma unroll
    for (int i = 0; i < TileRegs<NCH, ROWS>::N; ++i) { const int c = tid + i * NTHR;
        if ((ROWS * NCH) % NTHR == 0 || c < ROWS * NCH) { const int row = c / NCH, ch = c % NCH;
            const bf16* s = (NCH <= 8 || ch < 8 || src1 == nullptr) ? (src0 + (size_t)row * pitch0 + ch * 8) : (src1 + (size_t)row * pitch1 + (ch - 8) * 8);
            T.r[i] = *(const GAS v4u*)s; } }
}
template <int NCH, int ROWS = 64> __device__ __forceinline__ void tile_commit(const TileRegs<NCH, ROWS>& T, LAS unsigned char* dst, int lp, int tid) {
#pragma unroll
    for (int i = 0; i < TileRegs<NCH, ROWS>::N; ++i) { const int c = tid + i * NTHR;
        if ((ROWS * NCH) % NTHR == 0 || c < ROWS * NCH) { const int row = c / NCH, ch = c % NCH; *(LAS v4u*)(dst + row * lp + ch * 16) = T.r[i]; } }
}

struct CausalArgs { const bf16* Q; int qp; const bf16* K0; int kp0; const bf16* K1; int kp1; const bf16* V; int vp; const float* cum; bf16* O; int op; float scale2; };
template <int DK, bool FOX, int VAR = 0> __device__ __forceinline__ void causal_unit(LAS unsigned char* lds, int tid, int qt, const CausalArgs& A) {
    constexpr int KP = DK * 2 + 16, VP = 64 * 2 + 64, NCHK = DK / 8, BUF = 128 * KP + 128 * VP + 512;
    asm volatile("" : "+v"(tid));
    const int lane = tid & 63, w = __builtin_amdgcn_readfirstlane(tid >> 6), r32 = lane & 31, hi = lane >> 5;
    const int t0 = 256 * qt + 32 * w, tq = t0 + r32;
    bf16x8 qf[DK / 16];
#pragma unroll
    for (int d0 = 0; d0 < DK / 16; ++d0) qf[d0] = scale_frag(*(const GAS bf16x8*)(A.Q + (size_t)tq * A.qp + d0 * 16 + hi * 8), A.scale2);
    f32x16 o[2];
#pragma unroll
    for (int b = 0; b < 2; ++b)
#pragma unroll
        for (int r = 0; r < 16; ++r) o[b][r] = 0.f;
    float m = NEGBIG, l = 0.f;
    const int nkt = 2 * (qt + 1);
    TileRegs<NCHK, 128> kr; TileRegs<8, 128> vr; float cr = 0.f;
    { const size_t r0 = (size_t)(128 * (nkt - 1));
      tile_issue<NCHK, 128>(kr, A.K0 + r0 * A.kp0, A.kp0, A.K1 ? A.K1 + r0 * A.kp1 : nullptr, A.kp1, tid); tile_issue<8, 128>(vr, A.V + r0 * A.vp, A.vp, nullptr, 0, tid); if (FOX && tid < 128) cr = A.cum[r0 + tid]; }
    __syncthreads();
    for (int kt = nkt - 1; kt >= 0; --kt) {
        LAS unsigned char* Kl = lds + (kt & 1) * BUF; LAS unsigned char* Vl = Kl + 128 * KP; LAS float* Cl = (LAS float*)(Vl + 128 * VP);
        tile_commit<NCHK, 128>(kr, Kl, KP, tid); tile_commit<8, 128>(vr, Vl, VP, tid); if (FOX && tid < 128) Cl[tid] = cr * LOG2E;
        __syncthreads();
        if (kt > 0) { const size_t r0 = (size_t)(128 * (kt - 1));
            tile_issue<NCHK, 128>(kr, A.K0 + r0 * A.kp0, A.kp0, A.K1 ? A.K1 + r0 * A.kp1 : nullptr, A.kp1, tid); tile_issue<8, 128>(vr, A.V + r0 * A.vp, A.vp, nullptr, 0, tid);
            if (FOX && tid < 128) cr = A.cum[r0 + tid]; }
        const int kA = 128 * kt + 64, kB = 128 * kt;
        const bool doA = kA <= t0 + 31, doB = kB <= t0 + 31;
        f32x16 a0, a1, b0, b1;
        if (doA) qk64<DK>(Kl + 64 * KP, KP, qf, a0, a1, lane);
        if (doB) qk64<DK>(Kl, KP, qf, b0, b1, lane);
#pragma unroll
        for (int hf = 0; hf < 2; ++hf) {
            const bool doit = hf ? doB : doA; const int key0 = hf ? kB : kA;
            if (doit) {
                f32x16& s0 = hf ? b0 : a0; f32x16& s1 = hf ? b1 : a1;
                const LAS float* Ch = Cl + (hf ? 0 : 64);
                if (FOX) {
#pragma unroll
                    for (int g = 0; g < 4; ++g) { const f32x4 c0 = *(const LAS f32x4*)(Ch + 8 * g + 4 * hi), c1 = *(const LAS f32x4*)(Ch + 32 + 8 * g + 4 * hi);
#pragma unroll
                        for (int e = 0; e < 4; ++e) { s0[4 * g + e] -= c0[e]; s1[4 * g + e] -= c1[e]; } }
                }
                if (key0 + 63 > t0) {
#pragma unroll
                    for (int r = 0; r < 16; ++r) { const int kr_ = krow(r, hi); if (key0 + kr_ > tq) s0[r] = NEGBIG; if (key0 + 32 + kr_ > tq) s1[r] = NEGBIG; }
                }
                const float tmx = tile_max64(s0, s1);
                if (!(FOX && __all(tmx < m - 40.f))) {
                    softmax64m<2>(s0, s1, tmx, m, l, o);
                    pv64<64>(o, Vl + (hf ? 0 : 64) * VP, VP, s0, s1, lane);
                }
            }
        }
    }
    store_ot<2>(o, __builtin_amdgcn_rcpf(fmaxf(l, 1e-30f)), A.O + (size_t)tq * A.op, lane);
    __builtin_amdgcn_s_setprio(0);
}

struct XaArgs { const bf16* Q; const bf16* K; const bf16* V; bf16* O; };
template <int VAR = 0> __device__ __forceinline__ void xattn_unit(LAS unsigned char* lds, int tid, const XaArgs& A) {
    constexpr int KP = 256 * 2 + 16, VP = 128 * 2 + 64, BUF = 64 * KP + 64 * VP;
    asm volatile("" : "+v"(tid));
    const int lane = tid & 63, w = __builtin_amdgcn_readfirstlane(tid >> 6), r32 = lane & 31, hi = lane >> 5;
    const int tq = 32 * w + r32;
    bf16x8 qf[16];
#pragma unroll
    for (int d0 = 0; d0 < 16; ++d0) qf[d0] = scale_frag(*(const GAS bf16x8*)(A.Q + (size_t)tq * 1024 + d0 * 16 + hi * 8), 0.0625f * LOG2E);
    f32x16 o[4];
#pragma unroll
    for (int b = 0; b < 4; ++b)
#pragma unroll
        for (int r = 0; r < 16; ++r) o[b][r] = 0.f;
    float m = NEGBIG, l = 0.f;
    TileRegs<32> kr; TileRegs<16> vr;
    if (VAR != 4) tile_issue<32>(kr, A.K, 2048, nullptr, 0, tid); if (VAR != 5) tile_issue<16>(vr, A.V, 2048, nullptr, 0, tid);
    __syncthreads();
    for (int kt = 0; kt < 4; ++kt) {
        LAS unsigned char* Kl = lds + (kt & 1) * BUF; LAS unsigned char* Vl = Kl + 64 * KP;
        if (VAR != 4) tile_commit<32>(kr, Kl, KP, tid); if (VAR != 5) tile_commit<16>(vr, Vl, VP, tid);
        __syncthreads();
        if (kt + 1 < 4) { if (VAR != 4) tile_issue<32>(kr, A.K + (size_t)(64 * (kt + 1)) * 2048, 2048, nullptr, 0, tid); if (VAR != 5) tile_issue<16>(vr, A.V + (size_t)(64 * (kt + 1)) * 2048, 2048, nullptr, 0, tid); }
        { f32x16 s0, s1;
          if (VAR != 3) qk64<256, 2>(Kl, KP, qf, s0, s1, lane);
          else {
#pragma unroll
              for (int r = 0; r < 16; ++r) { s0[r] = (float)(r + kt); s1[r] = (float)(r - kt); } }
          __builtin_amdgcn_sched_barrier(0);
          if (VAR != 2) softmax64<4>(s0, s1, m, l, o);
          __builtin_amdgcn_sched_barrier(0);
          if (VAR != 1 && VAR != 2) pv64<128, 1>(o, Vl, VP, s0, s1, lane);
          else { o[0][0] += s0[0] + s1[3]; o[1][1] += s0[5]; }
          __builtin_amdgcn_sched_barrier(0); }
    }
    store_ot<4>(o, __builtin_amdgcn_rcpf(fmaxf(l, 1e-30f)), A.O + (size_t)tq * 1024, lane);
}
struct NsaArgs { const bf16* PROJ; const bf16* KC; const bf16* VC; const float* gate_b; bf16* O; const float* gg; bf16* Mb; };
__device__ __forceinline__ void nsa_unit(LAS unsigned char* lds, int tid, int T0, const NsaArgs& A) {
    constexpr int KP = 144, VP = 192;
    asm volatile("" : "+v"(tid));
    LAS unsigned char* KCl = lds; LAS unsigned char* VCl = lds + 18432; LAS unsigned char* Kl = lds + 43008; LAS unsigned char* Vl = lds + 52224;
    LAS float* impA = (LAS float*)(lds + 86016); LAS float* impB = (LAS float*)(lds + 94464); LAS unsigned* selm = (LAS unsigned*)(lds + 102912); LAS unsigned* uni = (LAS unsigned*)(lds + 103168);
    const int lane = tid & 63, w = __builtin_amdgcn_readfirstlane(tid >> 6), r32 = lane & 31, hi = lane >> 5;
    const int tl = 8 * w + (r32 >> 2), head = r32 & 3, t = T0 + tl, cur = T0 >> 6;
    __syncthreads();
    stage_rows<8>(KCl, KP, 128, A.KC, 64, nullptr, 0, tid);
    stage_rows<8>(VCl, VP, 128, A.VC, 64, nullptr, 0, tid);
    for (int i = tid; i < 2 * 64 * 33; i += NTHR) impA[i] = 0.f;
    const bf16* prow = A.PROJ + (size_t)t * NIN;
    bf16x8 qf[4];
#pragma unroll
    for (int d0 = 0; d0 < 4; ++d0) qf[d0] = scale_frag(*(const GAS bf16x8*)(prow + PC_NQ + 64 * head + d0 * 16 + hi * 8), 0.125f * LOG2E);
    const float g0 = fast_sigmoid(b2f(prow[PC_GATE + head]) + A.gate_b[head]), g1 = fast_sigmoid(b2f(prow[PC_GATE + 4 + head]) + A.gate_b[4 + head]),
                g2 = fast_sigmoid(b2f(prow[PC_GATE + 8 + head]) + A.gate_b[8 + head]);
    f32x16 out[2], o[2];
#pragma unroll
    for (int b = 0; b < 2; ++b)
#pragma unroll
        for (int r = 0; r < 16; ++r) { out[b][r] = 0.f; o[b][r] = 0.f; }
    __syncthreads();
    {
        float mx = NEGBIG, sum = 0.f;
#pragma unroll 1
        for (int kt = 0; kt < 4; ++kt) { f32x16 s = qk_tile<64>(KCl + 32 * kt * KP, KP, qf, lane); float tm = NEGBIG;
#pragma unroll
            for (int r = 0; r < 16; ++r) { const int c = 32 * kt + krow(r, hi); const float v = (16 * c + 31 <= t) ? s[r] : NEGBIG; s[r] = v; tm = fmaxf(tm, v); }
            tm = xhalf_max(tm);
            const float mn = fmaxf(mx, tm); float ps = 0.f;
#pragma unroll
            for (int r = 0; r < 16; ++r) ps += (s[r] > -1e29f) ? __builtin_amdgcn_exp2f(s[r] - mn) : 0.f;
            ps = xhalf_sum(ps);
            sum = sum * __builtin_amdgcn_exp2f(mx - mn) + ps; mx = mn; }
        const float inv = __builtin_amdgcn_rcpf(fmaxf(sum, 1e-30f));
#pragma unroll 1
        for (int kt = 0; kt < 4; ++kt) { f32x16 s = qk_tile<64>(KCl + 32 * kt * KP, KP, qf, lane);
#pragma unroll
            for (int r = 0; r < 16; ++r) { const int c = 32 * kt + krow(r, hi); s[r] = (16 * c + 31 <= t) ? __builtin_amdgcn_exp2f(s[r] - mx) * inv : 0.f; }
#pragma unroll
            for (int g = 0; g < 4; ++g) { float gs = (s[4 * g] + s[4 * g + 1]) + (s[4 * g + 2] + s[4 * g + 3]), ls = s[4 * g + 3];
                gs += __shfl_xor(gs, 1); gs += __shfl_xor(gs, 2); ls += __shfl_xor(ls, 1); ls += __shfl_xor(ls, 2);
                const int j = 8 * kt + 2 * g + hi;
                if (head == 0) { impA[tl * 33 + j] = gs; impB[tl * 33 + j + 1] = ls; } }
            pv_tile<64>(o, VCl + 32 * kt * VP, VP, s, lane);
        }
#pragma unroll
        for (int b = 0; b < 2; ++b)
#pragma unroll
            for (int r = 0; r < 16; ++r) { out[b][r] = g0 * o[b][r]; o[b][r] = 0.f; }
    }
    __syncthreads();
    {
        const int tk = tid >> 3, sub = tid & 7; float sc[4];
#pragma unroll
        for (int i = 0; i < 4; ++i) { const int j = 4 * sub + i; float v = impA[tk * 33 + j] + impB[tk * 33 + j]; if (j == 0 || j == cur || j == cur - 1) v = 1e4f; if (j > cur) v = NEGBIG; sc[i] = v; }
        unsigned sel = 0u;
#pragma unroll 1
        for (int it = 0; it < 8; ++it) {
            float best = -3e38f; int bj = 64;
#pragma unroll
            for (int i = 0; i < 4; ++i) { const bool taken = (sel >> (4 * sub + i)) & 1u; if (!taken && sc[i] > best) { best = sc[i]; bj = 4 * sub + i; } }
#pragma unroll
            for (int o2 = 1; o2 < 8; o2 <<= 1) { const float ov = __shfl_xor(best, o2); const int oj = __shfl_xor(bj, o2); if (ov > best || (ov == best && oj < bj)) { best = ov; bj = oj; } }
            sel |= 1u << (bj & 31);
        }
        sel &= (cur >= 31) ? 0xffffffffu : ((1u << (cur + 1)) - 1u);
        if (sub == 0) selm[tk] = sel;
    }
    __syncthreads();
    if (tid < 64) { unsigned un2 = selm[tid];
#pragma unroll
        for (int o2 = 1; o2 < 64; o2 <<= 1) un2 |= __shfl_xor(un2, o2);
        if (tid == 0) uni[0] = un2; }
    __syncthreads();
    const unsigned un = __builtin_amdgcn_readfirstlane(uni[0]);
    const unsigned mysel = selm[tl];
    {
        constexpr int BUF = 64 * KP + 64 * VP;
        unsigned rem = un; int swj = (cur >= 4 ? cur - 4 : 0);
        int j0, md0, j1, md1;
#define NSA_NEXT(jj, mm) do { if (rem) { jj = __builtin_ctz(rem); rem &= rem - 1u; mm = 0; } else if (swj <= cur) { jj = swj++; mm = 1; } else { jj = 0; mm = 2; } } while (0)
        NSA_NEXT(j0, md0);
        TileRegs<8> kr, vr;
        tile_issue<8>(kr, A.PROJ + (size_t)(64 * j0) * NIN + (md0 ? PC_KSWA : PC_KSLC), NIN, nullptr, 0, tid);
        tile_issue<8>(vr, A.PROJ + (size_t)(64 * j0) * NIN + (md0 ? PC_VSWA : PC_VSLC), NIN, nullptr, 0, tid);
        float m = NEGBIG, l = 0.f; int bufi = 0; bool in_sel = true;
        while (md0 != 2) {
            LAS unsigned char* Kb = Kl + bufi * BUF; LAS unsigned char* Vb = Kb + 64 * KP;
            tile_commit<8>(kr, Kb, KP, tid); tile_commit<8>(vr, Vb, VP, tid);
            __syncthreads();
            NSA_NEXT(j1, md1);
            if (md1 != 2) { tile_issue<8>(kr, A.PROJ + (size_t)(64 * j1) * NIN + (md1 ? PC_KSWA : PC_KSLC), NIN, nullptr, 0, tid);
                            tile_issue<8>(vr, A.PROJ + (size_t)(64 * j1) * NIN + (md1 ? PC_VSWA : PC_VSLC), NIN, nullptr, 0, tid); }
            if (md0 == 1 && in_sel) {
                const float f = g1 / fmaxf(l, 1e-30f);
#pragma unroll
                for (int b = 0; b < 2; ++b)
#pragma unroll
                    for (int r = 0; r < 16; ++r) { out[b][r] += f * o[b][r]; o[b][r] = 0.f; }
                m = NEGBIG; l = 0.f; in_sel = false; }
            const bool selbit = md0 ? true : (((mysel >> j0) & 1u) != 0u);
            if (__any(selbit)) {
                f32x16 s0, s1; qk64<64>(Kb, KP, qf, s0, s1, lane);
#pragma unroll
                for (int r = 0; r < 16; ++r) { const int key = 64 * j0 + krow(r, hi);
                    const bool ok0 = md0 ? (key <= t && key > t - 256) : (selbit && key <= t), ok1 = md0 ? (key + 32 <= t && key + 32 > t - 256) : (selbit && key + 32 <= t);
                    s0[r] = ok0 ? s0[r] : NEGBIG; s1[r] = ok1 ? s1[r] : NEGBIG; }
                softmax64<2>(s0, s1, m, l, o);
                pv64<64>(o, Vb, VP, s0, s1, lane);
            }
            j0 = j1; md0 = md1; bufi ^= 1;
        }
#undef NSA_NEXT
        const float f = g2 / fmaxf(l, 1e-30f);
#pragma unroll
        for (int b = 0; b < 2; ++b)
#pragma unroll
            for (int r = 0; r < 16; ++r) out[b][r] += f * o[b][r];
    }
    {
        float ss = 0.f;
#pragma unroll
        for (int b = 0; b < 2; ++b)
#pragma unroll
            for (int r = 0; r < 16; ++r) ss += out[b][r] * out[b][r];
        ss = xhalf_sum(ss); ss += __shfl_xor(ss, 1); ss += __shfl_xor(ss, 2);
        const float rs = __builtin_amdgcn_rsqf(ss * (1.f / 256.f) + NORM_EPS);
#pragma unroll
        for (int b = 0; b < 2; ++b)
#pragma unroll
            for (int g = 0; g < 4; ++g) { const f32x4 gv = *(const GAS f32x4*)(A.gg + 256 + 64 * head + 32 * b + 8 * g + 4 * hi);
#pragma unroll
                for (int e = 0; e < 4; ++e) out[b][4 * g + e] *= rs * gv[e]; }
    }
    store_ot<2>(out, 1.f, A.O + (size_t)t * 1024 + 64 * head, lane);
    {
        const int tk = tid >> 3, part = tid & 7;
#pragma unroll
        for (int grp = 0; grp < 3; grp += 2) {
            bf16* ptr = A.Mb + (size_t)(T0 + tk) * 1024 + 256 * grp + 32 * part; const float* gp = A.gg + 256 * grp + 32 * part;
            v4u w[4]; f32x4 gv[8];
#pragma unroll
            for (int i = 0; i < 4; ++i) w[i] = ((const GAS v4u*)ptr)[i];
#pragma unroll
            for (int i = 0; i < 8; ++i) gv[i] = ((const GAS f32x4*)gp)[i];
            float v[32]; float ss = 0.f;
#pragma unroll
            for (int i = 0; i < 4; ++i) { v[8 * i] = bflo(w[i].x); v[8 * i + 1] = bfhi(w[i].x); v[8 * i + 2] = bflo(w[i].y); v[8 * i + 3] = bfhi(w[i].y); v[8 * i + 4] = bflo(w[i].z); v[8 * i + 5] = bfhi(w[i].z); v[8 * i + 6] = bflo(w[i].w); v[8 * i + 7] = bfhi(w[i].w); }
#pragma unroll
            for (int i = 0; i < 32; ++i) ss += v[i] * v[i];
            ss += __shfl_xor(ss, 1); ss += __shfl_xor(ss, 2); ss += __shfl_xor(ss, 4);
            const float rs = __builtin_amdgcn_rsqf(ss * (1.f / 256.f) + NORM_EPS);
#pragma unroll
            for (int i = 0; i < 4; ++i) { v4u o4; o4.x = pk2(v[8 * i] * rs * gv[2 * i][0], v[8 * i + 1] * rs * gv[2 * i][1]); o4.y = pk2(v[8 * i + 2] * rs * gv[2 * i][2], v[8 * i + 3] * rs * gv[2 * i][3]);
                o4.z = pk2(v[8 * i + 4] * rs * gv[2 * i + 1][0], v[8 * i + 5] * rs * gv[2 * i + 1][1]); o4.w = pk2(v[8 * i + 6] * rs * gv[2 * i + 1][2], v[8 * i + 7] * rs * gv[2 * i + 1][3]); ((GAS v4u*)ptr)[i] = o4; }
        }
    }
    __builtin_amdgcn_s_setprio(0);
}
__device__ __forceinline__ const float* karg_in(int i) { const char* ka = (const char*)__builtin_amdgcn_kernarg_segment_ptr(); asm volatile("" : "+s"(ka)); return *(const float* const*)(ka + 8 * i); }
#define KIN(i) karg_in(i)
#define Wgu1 ((bf16*)(ws + WS_WGU1))
#define Wd1 ((bf16*)(ws + WS_WD1))
#define Wgu2 ((bf16*)(ws + WS_WGU2))
#define Wd2 ((bf16*)(ws + WS_WD2))
#define Win ((bf16*)(ws + WS_WIN))
#define Wout ((bf16*)(ws + WS_WOUT))
#define Wxq ((bf16*)(ws + WS_WXQ))
#define Wxkv ((bf16*)(ws + WS_WXKV))
#define Wxo ((bf16*)(ws + WS_WXO))
#define Wphi ((bf16*)(ws + WS_WPHI))
#define Wuq ((bf16*)(ws + WS_WUQ))
#define Wukv ((bf16*)(ws + WS_WUKV))
#define Wglu ((bf16*)(ws + WS_WGLU))
#define FS5 ((bf16*)(ws + WS_FS5))
#define BTS5 ((bf16*)(ws + WS_BTS5))
#define PHIB ((float*)(ws + WS_MISC + MS_PHIB))
#define A64 ((float*)(ws + WS_MISC + MS_A64))
#define PHIP ((float*)(ws + WS_MISC + MS_PHIP))
#define RSV ((float*)(ws + WS_BIG + BG_SSH))
#define SSYV ((float*)(ws + WS_BIG + BG_SSY))
#define GRPCNT(i) ((unsigned*)(ws + WS_CTL) + CW_GRP + (L * 4 + (i)) * 128)
#define XLN ((PG8_LAS float*)(lds + XCH_OFF))
#define XRN ((const PG8_LAS float*)(lds + XR_OFF))
#define Wphi2 ((bf16*)(ws + WS_MISC + MS_WPHI2))
#define ROPEM ((float*)(ws + WS_MISC + MS_ROPEM))
#define ROPEN ((float*)(ws + WS_MISC + MS_ROPEN))
#define U ((bf16*)(ws + WS_U))
#define ACT ((bf16*)(ws + WS_BIG + BG_ACT))
#define Y ((bf16*)(ws + WS_BIG + BG_Y))
#define HB ((bf16*)(ws + WS_H))
#define PROJ ((bf16*)H)
#define QM ((bf16*)(ws + WS_BIG + BG_QM))
#define KVM ((bf16*)(ws + WS_BIG + BG_KVM))
#define SSQ ((float*)(ws + WS_BIG + BG_SSQ))
#define SSKV ((float*)(ws + WS_BIG + BG_SSKV))
#define US5 ((bf16*)(ws + WS_BIG + BG_US5))
#define S5OUT ((float*)(ws + WS_BIG + BG_S5OUT))
#define YS5 ((bf16*)(ws + WS_BIG + BG_YS5))
#define KCMP ((bf16*)(ws + WS_BIG + BG_KCMP))
#define VCMP ((bf16*)(ws + WS_BIG + BG_VCMP))
#define HIDK ((bf16*)(ws + WS_BIG + BG_HIDK))
#define HIDV ((bf16*)(ws + WS_BIG + BG_HIDV))
#define KC ((bf16*)(ws + WS_BIG + BG_KC))
#define VC ((bf16*)(ws + WS_BIG + BG_VC))
#define XIN ((bf16*)(ws + WS_BIG + BG_XIN))
#define LOGF ((float*)(ws + WS_BIG + BG_LOGF))
#define CUM ((float*)(ws + WS_BIG + BG_CUM))
#define XQ ((bf16*)(ws + WS_BIG + BG_XQ))
#define XO ((bf16*)(ws + WS_BIG + BG_XO))
#define KH ((bf16*)(ws + WS_BIG + BG_KH))
#define VT ((bf16*)(ws + WS_BIG + BG_VT))
#define PX ((bf16*)(ws + WS_BIG + BG_PX))
#define VWO ((bf16*)(ws + WS_VWO))
#define MEMN ((bf16*)(ws + WS_BIG + BG_MEMN))
#define Wxkv1 ((bf16*)(ws + WS_BIG + BG_WXKV1))
#define MEMN1 ((bf16*)(ws + WS_BIG + BG_MEMN1))
#define KH1 ((bf16*)(ws + WS_BIG + BG_KH1))
#define VT1 ((bf16*)(ws + WS_BIG + BG_VT1))
#define KHL ((L == 0) ? KH : KH1)
#define VTL ((L == 0) ? VT : VT1)
#define MIX U
#define ffn1_pre_g (KIN(2) + (size_t)L * (DMODEL))
#define ffn1_wg (KIN(3) + (size_t)L * (DMODEL * FFD))
#define ffn1_wu (KIN(4) + (size_t)L * (DMODEL * FFD))
#define ffn1_wd (KIN(5) + (size_t)L * (FFD * DMODEL))
#define ffn1_post_g (KIN(6) + (size_t)L * (DMODEL))
#define mix_pre_g (KIN(7) + (size_t)L * (DMODEL))
#define mix_w_in (KIN(8) + (size_t)L * (DMODEL * NIN_SRC))
#define mla_qg (KIN(9) + (size_t)L * (192))
#define mla_wuq (KIN(10) + (size_t)L * (192 * 384))
#define mla_kvg (KIN(11) + (size_t)L * (128))
#define mla_wukv (KIN(12) + (size_t)L * (128 * 512))
#define nsa_pos (KIN(13) + (size_t)L * (2 * 2048))
#define nsa_w1 (KIN(14) + (size_t)L * (2 * 2048 * 256))
#define nsa_b1 (KIN(15) + (size_t)L * (2 * 256))
#define nsa_w2 (KIN(16) + (size_t)L * (2 * 256 * 64))
#define nsa_gb (KIN(17) + (size_t)L * (12))
#define fox_fb (KIN(18) + (size_t)L * (4))
#define s5_lre (KIN(19) + (size_t)L * (1024))
#define s5_lim (KIN(20) + (size_t)L * (1024))
#define s5_ldt (KIN(21) + (size_t)L * (16))
#define s5_bre (KIN(22) + (size_t)L * (16384))
#define s5_bim (KIN(23) + (size_t)L * (16384))
#define s5_cre (KIN(24) + (size_t)L * (16384))
#define s5_cim (KIN(25) + (size_t)L * (16384))
#define s5_d (KIN(26) + (size_t)L * (256))
#define s5_gluw (KIN(27) + (size_t)L * (65536))
#define s5_glub (KIN(28) + (size_t)L * (256))
#define mix_gg (KIN(29) + (size_t)L * (1024))
#define mix_wout (KIN(30) + (size_t)L * (DMODEL * DMODEL))
#define mix_post_g (KIN(31) + (size_t)L * (DMODEL))
#define xa_pre_g (KIN(32) + (size_t)L * (DMODEL))
#define xa_mem_g (KIN(33) + (size_t)L * (DMODEL))
#define xa_wq (KIN(34) + (size_t)L * (DMODEL * DMODEL))
#define xa_wkv (KIN(35) + (size_t)L * (DMODEL * 2048))
#define xa_wo (KIN(36) + (size_t)L * (DMODEL * DMODEL))
#define xa_post_g (KIN(37) + (size_t)L * (DMODEL))
#define ffn2_pre_g (KIN(38) + (size_t)L * (DMODEL))
#define ffn2_wg (KIN(39) + (size_t)L * (DMODEL * FFD))
#define ffn2_wu (KIN(40) + (size_t)L * (DMODEL * FFD))
#define ffn2_wd (KIN(41) + (size_t)L * (FFD * DMODEL))
#define ffn2_post_g (KIN(42) + (size_t)L * (DMODEL))
constexpr int NPH = 21, NPHASES = NPH * DEPTH;
struct Args { const float* in[43]; float* out; unsigned char* ws; int ph_lo, ph_hi; };
static_assert(sizeof(Args) == 43 * 8 + 8 + 8 + 8, "Args has no padding");

__global__ void __launch_bounds__(NTHR, 2) fwd_kernel(Args args) {
    extern __shared__ __attribute__((aligned(16))) unsigned char lds_raw[];
    LAS unsigned char* lds = (LAS unsigned char*)lds_raw;
    volatile LAS unsigned* MISC = (volatile LAS unsigned*)(lds + MISC_OFF);
    const int tid0 = threadIdx.x;
    const int G0 = gridDim.x; const int bx0 = blockIdx.x; const int vcu0 = (G0 % 8 == 0) ? (bx0 % 8) * (G0 / 8) + bx0 / 8 : bx0;
    unsigned char* ws0 = args.ws;
#define PH_LOCALS unsigned char* ws = ws0; int tid = tid0, G = G0, bx = bx0, vcu = vcu0; asm volatile("" : "+s"(ws), "+v"(tid), "+s"(G), "+s"(bx), "+s"(vcu)); \
                  const int lane = tid & 63, wave = __builtin_amdgcn_readfirstlane(tid >> 6); \
                  const int gw = vcu * NWAVES + wave, NGW = G * NWAVES; float* H = (float*)karg_in(43); (void)lane; (void)gw; (void)NGW; (void)H; (void)ws; (void)bx
    gu32* ctl = (gu32*)(ws0 + WS_CTL);
    for (int u = tid0; u < (LDS_BYTES - LDSCTL_OFF) / 4; u += NTHR) ((LAS unsigned*)(lds + LDSCTL_OFF))[u] = 0u;
    __syncthreads();
    XcdBarrier bar; bar.bar = (unsigned*)ctl + CW_BAR; bar.x = 0; bar.st = nullptr;
    if (MK_ONE_LAUNCH) bar = xcd_barrier_post((unsigned*)ctl + CW_BAR, MISC + 8);
    const int lo = args.ph_lo, hi = args.ph_hi;

#ifdef MK_ONLY_PHASE
#define IN(k) ((((k) % NPH) == MK_ONLY_PHASE) && lo <= (k) && (k) < hi)
#else
#define IN(k) (lo <= (k) && (k) < hi)
#endif
#ifdef MK_ONLY_SUB
#define SUB(i) (MK_ONLY_SUB == (i))
#else
#define SUB(i) 1
#endif
#ifdef MK_REPEAT_PHASE
#define REPS(k) (((k) == MK_REPEAT_PHASE) ? MK_REPEAT_N : 1)
#else
#define REPS(k) 1
#endif
#ifdef MK_REPEAT_P0PART
#define P0REP(i) (((i) == MK_REPEAT_P0PART) ? 2 : 1)
#else
#define P0REP(i) 1
#endif
#define SEAM(k) do { if (MK_ONE_LAUNCH && IN((k) + 1)) xcd_barrier(bar); } while (0)
#define GEMM_CALL(EPI, SCHED, gg, SS, EE) pg8::gemm_phase<EPI, SCHED, true, true>(lds + RING_OFF, gg, SS, EE)

    {
        constexpr int L = 0;
        const int pb = L * NPH;
        if (L == 0) {
        if (IN(pb + 0)) for (int rep = 0; rep < REPS(0); ++rep) { PH_LOCALS;
#define PRO_SKIP_WD2 0
#define PRO_XKV 0
            {
                S5W W{s5_lre, s5_lim, s5_ldt, s5_bre, s5_bim, s5_cre, s5_cim, BTS5, FS5, A64};
                for (int rp = 0; rp < P0REP(1); ++rp) for (int u = vcu; u < 256; u += G) { const int g = u >> 4, q = u & 15; s5_item((LAS float*)(lds + RING_OFF), tid, g, 4 * q, q == 15 ? 64 : 4 * q + 3, W); }
                __syncthreads();
            }
            LAS float* scr = (LAS float*)(lds + RING_OFF + wave * 16384);
            constexpr int I_G = (DMODEL / 64) * (FFD / 32), I_D = (FFD / 64) * (DMODEL / 32), I_IN = (DMODEL / 64) * (NIN / 32), I_SQ = (DMODEL / 64) * (DMODEL / 32), I_XKV = (DMODEL / 64) * (2048 / 32);
            constexpr int I_UQ = (256 / 64) * (512 / 32), I_UKV = (128 / 64) * (512 / 32), I_PHI = (2048 / 64) * (256 / 32), I_GLU = (256 / 64) * (256 / 32);
            constexpr int I_P2 = (256 / 64) * (256 / 32);
            constexpr int NITEMS = 4 * I_G + 2 * I_D + I_IN + 3 * I_SQ + I_XKV + I_UQ + I_UKV + 2 * I_PHI + 2 * I_P2 + I_GLU;
            for (int rp = 0; rp < P0REP(2); ++rp) for (int it = gw; it < NITEMS; it += NGW) {
                int r = it;
                if (r < I_G) { tr_item(ffn1_wg, DMODEL, FFD, Wgu1, DMODEL, FFD, MAP_GATE, scr, r, lane, ffn1_pre_g); continue; } r -= I_G;
                if (r < I_G) { tr_item(ffn1_wu, DMODEL, FFD, Wgu1, DMODEL, FFD, MAP_UP, scr, r, lane, ffn1_pre_g); continue; } r -= I_G;
                if (r < I_G) { tr_item(ffn2_wg, DMODEL, FFD, Wgu2, DMODEL, FFD, MAP_GATE, scr, r, lane, ffn2_pre_g); continue; } r -= I_G;
                if (r < I_G) { tr_item(ffn2_wu, DMODEL, FFD, Wgu2, DMODEL, FFD, MAP_UP, scr, r, lane, ffn2_pre_g); continue; } r -= I_G;
                if (r < I_D) { tr_item(ffn1_wd, FFD, DMODEL, Wd1, FFD, DMODEL, MAP_ID, scr, r, lane); continue; } r -= I_D;
                if (r < I_D) { if (!PRO_SKIP_WD2) tr_item(ffn2_wd, FFD, DMODEL, Wd2, FFD, DMODEL, MAP_ID, scr, r, lane); continue; } r -= I_D;
                if (r < I_IN) { tr_item(mix_w_in, DMODEL, NIN_SRC, Win, DMODEL, NIN, MAP_WIN, scr, r, lane, mix_pre_g); continue; } r -= I_IN;
                if (r < I_SQ) { tr_item(mix_wout, DMODEL, DMODEL, Wout, DMODEL, DMODEL, MAP_ID, scr, r, lane); continue; } r -= I_SQ;
                if (r < I_SQ) { tr_item(xa_wq, DMODEL, DMODEL, Wxq, DMODEL, DMODEL, MAP_ID, scr, r, lane, xa_pre_g); continue; } r -= I_SQ;
                if (r < I_SQ) { tr_item(xa_wo, DMODEL, DMODEL, Wxo, DMODEL, DMODEL, MAP_ID, scr, r, lane); continue; } r -= I_SQ;
                if (r < I_XKV) { if (PRO_XKV == 0) tr_item(xa_wkv, DMODEL, 2048, Wxkv, DMODEL, 2048, MAP_ID, scr, r, lane);
                    continue; } r -= I_XKV;
                if (r < I_UQ) { tr_item(mla_wuq, 192, 384, Wuq, 256, 512, MAP_UQ, scr, r, lane, mla_qg); continue; } r -= I_UQ;
                if (r < I_UKV) { tr_item(mla_wukv, 128, 512, Wukv, 128, 512, MAP_ID, scr, r, lane, mla_kvg); continue; } r -= I_UKV;
                if (r < I_PHI) { tr_item(nsa_w1, 2048, 256, Wphi, 2048, 256, MAP_ID, scr, r, lane); continue; } r -= I_PHI;
                if (r < I_PHI) { tr_item(nsa_w1 + 2048 * 256, 2048, 256, Wphi + 256 * 2048, 2048, 256, MAP_ID, scr, r, lane); continue; } r -= I_PHI;
                if (r < I_P2) { tr_item(nsa_w2, 256, 64, Wphi2, 256, 256, MAP_ID, scr, r, lane); continue; } r -= I_P2;
                if (r < I_P2) { tr_item(nsa_w2 + 256 * 64, 256, 64, Wphi2 + 256 * 256, 256, 256, MAP_ID, scr, r, lane); continue; } r -= I_P2;
                tr_item(s5_gluw, 256, 256, Wglu, 256, 256, MAP_ID, scr, r, lane);
            }
            if (PRO_XKV == 0) for (int it = gw; it < I_XKV; it += NGW) tr_item(KIN(35) + (size_t)(DMODEL * 2048), DMODEL, 2048, Wxkv1, DMODEL, 2048, MAP_ID, scr, it, lane);
            for (int it = gw; it < 512; it += NGW) phib_part(it, lane, nsa_pos, nsa_w1, PHIP);
#undef PRO_XKV
#undef PRO_SKIP_WD2
            for (int i = bx * NTHR + tid; i < 2048 * 16; i += G * NTHR) rope_fill(ROPEM, 16, i);
            for (int i = bx * NTHR + tid; i < 2048 * 32; i += G * NTHR) rope_fill(ROPEN, 32, i);
            for (int rp = 0; rp < P0REP(3); ++rp) for (int m = gw; m < MTOK; m += 2 * NGW) { const int m2 = m + NGW;
                if (m2 < MTOK) xpass_rows2(lane, KIN(0) + (size_t)m * DMODEL, KIN(0) + (size_t)m2 * DMODEL, HB + (size_t)m * DMODEL, HB + (size_t)m2 * DMODEL, RSV + 4 * (size_t)m, RSV + 4 * (size_t)m2);
                else norm_row(lane, nullptr, nullptr, KIN(0) + (size_t)m * DMODEL, HB + (size_t)m * DMODEL, nullptr, nullptr, 0.f, RSV + 4 * (size_t)m); }
        }
        SEAM(pb + 0);
        }
        if (IN(pb + 1)) for (int rep = 0; rep < REPS(1); ++rep) { PH_LOCALS; pg8::Gemm g{HB, Wgu1, MTOK, 2 * FFD, DMODEL, DMODEL}; pg8::StaticOrder S; S.init(MTOK, 2 * FFD, G, bx); pg8::EpiSwiGLU E{ACT, FFD, RSV, XRN};
            GEMM_CALL(pg8::EpiSwiGLU, pg8::StaticOrder, g, S, E); }
        if (L > 0 && IN(pb + 1)) { PH_LOCALS; LAS float* scr = (LAS float*)(lds + RING_OFF + wave * 16384);
            for (int it = gw; it < (FFD / 64) * (DMODEL / 32); it += NGW) tr_item(ffn2_wd, FFD, DMODEL, Wd2, FFD, DMODEL, MAP_ID, scr, it, lane); }
        SEAM(pb + 1);
        if (IN(pb + 2)) { PH_LOCALS; pg8::Gemm g{ACT, Wd1, MTOK, DMODEL, FFD, FFD}; pg8::StaticOrder S; S.init(MTOK, DMODEL, G, bx); pg8::EpiNormRes E{HB, HB, nullptr, ffn1_post_g, 0.5f, SSYV, RSV, GRPCNT(0), XLN};
            GEMM_CALL(pg8::EpiNormRes, pg8::StaticOrder, g, S, E); }
        SEAM(pb + 3);
        if (IN(pb + 4)) for (int rep = 0; rep < REPS(4); ++rep) { PH_LOCALS; pg8::Gemm g{HB, Win, MTOK, NIN, DMODEL, DMODEL}; pg8::StaticOrder S; S.init(MTOK, NIN, G, bx);
            pg8::EpiWin E{PROJ, KCMP, VCMP, US5, LOGF, SSQ, SSKV, ROPEM, ROPEN, fox_fb, MTOK, RSV, XRN};
            GEMM_CALL(pg8::EpiWin, pg8::StaticOrder, g, S, E);
            for (int i = bx * NTHR + tid; i < 32 * 64; i += G * NTHR) { KCMP[(size_t)MTOK * 64 + i] = 0; VCMP[(size_t)MTOK * 64 + i] = 0; }
            for (int i = bx * NTHR + tid; i < 512; i += G * NTHR) phib_final(i, PHIP, nsa_b1, PHIB); }
        SEAM(pb + 4);
        if (IN(pb + 6)) for (int rep = 0; rep < REPS(6); ++rep) { PH_LOCALS;
            const int c0 = (G * 80) / 256, c1 = c0 + (G * 64) / 256, c2 = c1 + (G * 96) / 256, c3 = c2 + (G * 8) / 256;
            const int far = 1 << 28;
            if (SUB(0)) { pg8::Gemm g{PROJ + PC_CQ, Wuq, MTOK, 512, 256, NIN}; pg8::StaticOrder S; S.init(MTOK, 512, c0, bx < c0 ? bx : far); pg8::EpiRowScale<true> E{QM, 512, SSQ, 6, 1.f / 192.f, ROPEM}; GEMM_CALL(pg8::EpiRowScale<true>, pg8::StaticOrder, g, S, E); }
            if (SUB(1)) { pg8::Gemm g{PROJ + PC_CKV, Wukv, MTOK, 512, 128, NIN}; pg8::StaticOrder S; S.init(MTOK, 512, c1 - c0, (bx >= c0 && bx < c1) ? bx - c0 : far); pg8::EpiRowScale<false> E{KVM, 512, SSKV, 4, 1.f / 128.f, nullptr}; GEMM_CALL(pg8::EpiRowScale<false>, pg8::StaticOrder, g, S, E); }
            if (SUB(2)) { pg8::Gemm g{US5, BTS5, 16 * 512, 16 * 1280, 1024, 1024}; pg8::BatchOrder S; S.init(16, 2, 5, c2 - c1, (bx >= c1 && bx < c2) ? bx - c1 : far); pg8::EpiS5Loc E{S5OUT}; GEMM_CALL(pg8::EpiS5Loc, pg8::BatchOrder, g, S, E);
                asm volatile("s_waitcnt vmcnt(0)" ::: "memory"); __syncthreads();
                if (bx >= c1 && bx < c2) for (int L2 = bx - c1; L2 < 160; L2 += c2 - c1) { const int bt = L2 / 10, r = L2 % 10; if (r % 5 == 4) s5_carry_blk(tid, bt, r / 5, S5OUT, A64, XIN); } }
            if (SUB(3)) { pg8::Gemm g{KCMP, Wphi, 2048, 256, 2048, 1024}; pg8::StaticOrder S; S.init(2048, 256, c3 - c2, (bx >= c2 && bx < c3) ? bx - c2 : far); pg8::EpiGeluBias E{HIDK, 256, PHIB}; GEMM_CALL(pg8::EpiGeluBias, pg8::StaticOrder, g, S, E); }
            if (SUB(4)) { pg8::Gemm g{VCMP, Wphi + 256 * 2048, 2048, 256, 2048, 1024}; pg8::StaticOrder S; S.init(2048, 256, G - c3, bx >= c3 ? bx - c3 : far); pg8::EpiGeluBias E{HIDV, 256, PHIB + 256}; GEMM_CALL(pg8::EpiGeluBias, pg8::StaticOrder, g, S, E); }
            if (SUB(5)) for (int s = gw; s < 64; s += NGW) cumsum_seq(lane, LOGF + (size_t)s * SEQ, CUM + (size_t)s * SEQ);
        }
        SEAM(pb + 6);
        if (IN(pb + 8)) for (int rep = 0; rep < REPS(8); ++rep) { PH_LOCALS;
            { pg8::Gemm g{HIDK, Wphi2, 2048, 256, 256, 256}; pg8::StaticOrder S; S.init(2048, 256, G, (bx + 16) % G); pg8::EpiStoreN64 E{KC}; GEMM_CALL(pg8::EpiStoreN64, pg8::StaticOrder, g, S, E); }
            { pg8::Gemm g{HIDV, Wphi2 + 256 * 256, 2048, 256, 256, 256}; pg8::StaticOrder S; S.init(2048, 256, G, (bx + 8) % G); pg8::EpiStoreN64 E{VC}; GEMM_CALL(pg8::EpiStoreN64, pg8::StaticOrder, g, S, E); }
            if (SUB(0)) { pg8::Gemm g{XIN, FS5, 16 * 512, 16 * 1024, 128, 128}; pg8::BatchOrder S; S.init(16, 2, 4, G, bx); pg8::EpiS5Carry E{S5OUT, US5, s5_d, YS5, MTOK}; GEMM_CALL(pg8::EpiS5Carry, pg8::BatchOrder, g, S, E); }
            if (SUB(1)) for (int it = vcu; it < 256; it += G) { const int b = it >> 4, h = (it >> 2) & 3, pp = it & 3; const size_t rb = (size_t)b * SEQ;
                CausalArgs A{QM + rb * 512 + 96 * h, 512, KVM + rb * 512 + 128 * h, 512, PROJ + rb * NIN + PC_KPE, NIN, KVM + rb * 512 + 128 * h + 64, 512, nullptr, MIX + rb * 1024 + 64 * h, 1024, 0.10206207261596575f * LOG2E};
                causal_unit<96, false>(lds + RING_OFF, tid, pp, A); causal_unit<96, false>(lds + RING_OFF, tid, 7 - pp, A); }
            if (SUB(2)) for (int it = vcu; it < 256; it += G) { const int b = it >> 4, h = (it >> 2) & 3, pp = it & 3; const size_t rb = (size_t)b * SEQ;
                CausalArgs A{PROJ + rb * NIN + PC_FQ + 64 * h, NIN, PROJ + rb * NIN + PC_FK + 64 * h, NIN, nullptr, 0, PROJ + rb * NIN + PC_FV + 64 * h, NIN, CUM + ((size_t)b * 4 + h) * SEQ, MIX + rb * 1024 + 512 + 64 * h, 1024, 0.125f * LOG2E};
                causal_unit<64, true>(lds + RING_OFF, tid, pp, A); causal_unit<64, true>(lds + RING_OFF, tid, 7 - pp, A); }
            __syncthreads();
        }
        SEAM(pb + 8);
        if (IN(pb + 9)) for (int rep = 0; rep < REPS(9); ++rep) { PH_LOCALS;
            if (SUB(0)) { pg8::Gemm g{YS5, Wglu, MTOK, 256, 256, 256}; pg8::StaticOrder S; S.init(MTOK, 256, G, bx); pg8::EpiGLUNorm E{YS5, s5_glub, mix_gg + 768, MIX, 1024, 768, (PG8_LAS float*)(lds + XCH_OFF)}; GEMM_CALL(pg8::EpiGLUNorm, pg8::StaticOrder, g, S, E); }
            if (SUB(1)) for (int it = vcu; it < 512; it += G) { const int i2 = it & 255, b = i2 >> 4, T0 = (it < 256 ? (i2 & 15) : 31 - (i2 & 15)) * 64; const size_t rb = (size_t)b * SEQ;
                NsaArgs A{PROJ + rb * NIN, KC + (size_t)b * 128 * 64, VC + (size_t)b * 128 * 64, nsa_gb, MIX + rb * 1024 + 256, mix_gg, MIX + rb * 1024};
                nsa_unit(lds + RING_OFF, tid, T0, A); }
            __syncthreads();
        }
        SEAM(pb + 9);
        if (IN(pb + 11)) { PH_LOCALS; pg8::Gemm g{MIX, Wout, MTOK, DMODEL, DMODEL, DMODEL}; pg8::StaticOrder S; S.init(MTOK, DMODEL, G, bx); pg8::EpiNormRes E{HB, HB, nullptr, mix_post_g, 1.0f, SSYV, RSV, GRPCNT(1), XLN};
            GEMM_CALL(pg8::EpiNormRes, pg8::StaticOrder, g, S, E);
            if (L == 0) for (int m = gw; m < MROWS; m += NGW) { norm_only_row(lane, KIN(1) + (size_t)m * DMODEL, xa_mem_g, MEMN + (size_t)m * DMODEL);
                norm_only_row(lane, KIN(1) + (size_t)m * DMODEL, KIN(33) + (size_t)DMODEL, MEMN1 + (size_t)m * DMODEL); }
        }
        SEAM(pb + 12);
        if (IN(pb + 13)) for (int rep = 0; rep < REPS(13); ++rep) { PH_LOCALS;
            if (SUB(0)) { pg8::Gemm g{HB, Wxq, MTOK, DMODEL, DMODEL, DMODEL}; pg8::StaticOrder S; S.init(MTOK, DMODEL, G, bx); pg8::EpiStoreScaled E{XQ, DMODEL, RSV, 0.0625f * LOG2E, XRN}; GEMM_CALL(pg8::EpiStoreScaled, pg8::StaticOrder, g, S, E); }
            if (L == 0 && SUB(1)) { pg8::Gemm g{MEMN, Wxkv, MROWS, DMODEL, DMODEL, DMODEL}; pg8::StaticOrder S; S.init(MROWS, DMODEL, G, bx); pg8::EpiKH E{KH, MROWS}; GEMM_CALL(pg8::EpiKH, pg8::StaticOrder, g, S, E); }
            if (L == 0 && SUB(2)) { pg8::Gemm g{MEMN, Wxkv + (size_t)DMODEL * DMODEL, MROWS, DMODEL, DMODEL, DMODEL}; pg8::StaticOrder S; S.init(MROWS, DMODEL, G, (bx + 64) % G); pg8::EpiKH E{VT, MROWS}; GEMM_CALL(pg8::EpiKH, pg8::StaticOrder, g, S, E); }
        }
        if (L == 0 && IN(pb + 13)) { PH_LOCALS;
            { pg8::Gemm g{MEMN1, Wxkv1, MROWS, DMODEL, DMODEL, DMODEL}; pg8::StaticOrder S; S.init(MROWS, DMODEL, G, (bx + 192) % G); pg8::EpiKH E{KH1, MROWS}; GEMM_CALL(pg8::EpiKH, pg8::StaticOrder, g, S, E); }
            { pg8::Gemm g{MEMN1, Wxkv1 + (size_t)DMODEL * DMODEL, MROWS, DMODEL, DMODEL, DMODEL}; pg8::StaticOrder S; S.init(MROWS, DMODEL, G, (bx + 128) % G); pg8::EpiKH E{VT1, MROWS}; GEMM_CALL(pg8::EpiKH, pg8::StaticOrder, g, S, E); }
        }
        SEAM(pb + 13);
        if (IN(pb + 14)) for (int rep = 0; rep < REPS(14); ++rep) { PH_LOCALS; const int q4 = G / 4, far = 1 << 28;
#pragma unroll
            for (int h = 0; h < 4; ++h) { const int lo4 = h * q4, hi4 = (h == 3) ? G : lo4 + q4;
                pg8::Gemm g{XQ + 256 * h, KHL + (size_t)h * MROWS * 256, MTOK, MROWS, 256, DMODEL}; pg8::BatchOrder S; S.init(16, 8, 1, hi4 - lo4, (bx >= lo4 && bx < hi4) ? bx - lo4 : far);
                pg8::EpiSoftmaxP E{PX, DMODEL, 256 * h, (PG8_LAS float*)(lds + XCH_OFF)}; GEMM_CALL(pg8::EpiSoftmaxP, pg8::BatchOrder, g, S, E); }
#pragma unroll
            for (int h = 0; h < 4; ++h) { const int lo4 = h * q4, hi4 = (h == 3) ? G : lo4 + q4;
                pg8::Gemm g{Wxo + 256 * h, VTL + (size_t)h * MROWS * 256, DMODEL, MROWS, 256, DMODEL}; pg8::StaticOrder S; S.init(DMODEL, MROWS, hi4 - lo4, (bx >= lo4 && bx < hi4) ? bx - lo4 : far);
                pg8::EpiVWo E{VWO, h}; GEMM_CALL(pg8::EpiVWo, pg8::StaticOrder, g, S, E); }
        }
        SEAM(pb + 14);
        if (IN(pb + 15)) { PH_LOCALS;
            pg8::Gemm g{PX, VWO, MTOK, 16 * DMODEL, DMODEL, DMODEL}; pg8::BatchOrderCM S; S.init(16, 8, 4, G, bx); pg8::EpiNormRes E{HB, HB, nullptr, xa_post_g, 1.0f, SSYV, RSV, GRPCNT(2), XLN}; GEMM_CALL(pg8::EpiNormRes, pg8::BatchOrderCM, g, S, E); }
        SEAM(pb + 17);
        if (IN(pb + 18)) for (int rep = 0; rep < REPS(18); ++rep) { PH_LOCALS; pg8::Gemm g{HB, Wgu2, MTOK, 2 * FFD, DMODEL, DMODEL}; pg8::StaticOrder S; S.init(MTOK, 2 * FFD, G, bx); pg8::EpiSwiGLU E{ACT, FFD, RSV, XRN};
            GEMM_CALL(pg8::EpiSwiGLU, pg8::StaticOrder, g, S, E); }
        SEAM(pb + 18);
        if (IN(pb + 19)) { PH_LOCALS; pg8::Gemm g{ACT, Wd2, MTOK, DMODEL, FFD, FFD}; pg8::StaticOrder S; S.init(MTOK, DMODEL, G, bx);
            pg8::EpiNormRes E{HB, (L + 1 < DEPTH) ? HB : nullptr, (L + 1 < DEPTH) ? nullptr : H, ffn2_post_g, 0.5f, SSYV, (L + 1 < DEPTH) ? RSV : nullptr, GRPCNT(3), XLN};
            GEMM_CALL(pg8::EpiNormRes, pg8::StaticOrder, g, S, E); }
        if (L + 1 < DEPTH) {
        if (IN(pb + 20)) { PH_LOCALS;
            { constexpr int Lnext = L + 1; { constexpr int L = Lnext;
#define PRO_SKIP_WD2 1
#define PRO_XKV 1
            {
                S5W W{s5_lre, s5_lim, s5_ldt, s5_bre, s5_bim, s5_cre, s5_cim, BTS5, FS5, A64};
                for (int rp = 0; rp < P0REP(1); ++rp) for (int u = vcu; u < 256; u += G) { const int g = u >> 4, q = u & 15; s5_item((LAS float*)(lds + RING_OFF), tid, g, 4 * q, q == 15 ? 64 : 4 * q + 3, W); }
                __syncthreads();
            }
            LAS float* scr = (LAS float*)(lds + RING_OFF + wave * 16384);
            constexpr int I_G = (DMODEL / 64) * (FFD / 32), I_D = (FFD / 64) * (DMODEL / 32), I_IN = (DMODEL / 64) * (NIN / 32), I_SQ = (DMODEL / 64) * (DMODEL / 32), I_XKV = (DMODEL / 64) * (2048 / 32);
            constexpr int I_UQ = (256 / 64) * (512 / 32), I_UKV = (128 / 64) * (512 / 32), I_PHI = (2048 / 64) * (256 / 32), I_GLU = (256 / 64) * (256 / 32);
            constexpr int I_P2 = (256 / 64) * (256 / 32);
            constexpr int NITEMS = 4 * I_G + 2 * I_D + I_IN + 3 * I_SQ + I_XKV + I_UQ + I_UKV + 2 * I_PHI + 2 * I_P2 + I_GLU;
            for (int rp = 0; rp < P0REP(2); ++rp) for (int it = gw; it < NITEMS; it += NGW) {
                int r = it;
                if (r < I_G) { tr_item(ffn1_wg, DMODEL, FFD, Wgu1, DMODEL, FFD, MAP_GATE, scr, r, lane, ffn1_pre_g); continue; } r -= I_G;
                if (r < I_G) { tr_item(ffn1_wu, DMODEL, FFD, Wgu1, DMODEL, FFD, MAP_UP, scr, r, lane, ffn1_pre_g); continue; } r -= I_G;
                if (r < I_G) { tr_item(ffn2_wg, DMODEL, FFD, Wgu2, DMODEL, FFD, MAP_GATE, scr, r, lane, ffn2_pre_g); continue; } r -= I_G;
                if (r < I_G) { tr_item(ffn2_wu, DMODEL, FFD, Wgu2, DMODEL, FFD, MAP_UP, scr, r, lane, ffn2_pre_g); continue; } r -= I_G;
                if (r < I_D) { tr_item(ffn1_wd, FFD, DMODEL, Wd1, FFD, DMODEL, MAP_ID, scr, r, lane); continue; } r -= I_D;
                if (r < I_D) { if (!PRO_SKIP_WD2) tr_item(ffn2_wd, FFD, DMODEL, Wd2, FFD, DMODEL, MAP_ID, scr, r, lane); continue; } r -= I_D;
                if (r < I_IN) { tr_item(mix_w_in, DMODEL, NIN_SRC, Win, DMODEL, NIN, MAP_WIN, scr, r, lane, mix_pre_g); continue; } r -= I_IN;
                if (r < I_SQ) { tr_item(mix_wout, DMODEL, DMODEL, Wout, DMODEL, DMODEL, MAP_ID, scr, r, lane); continue; } r -= I_SQ;
                if (r < I_SQ) { tr_item(xa_wq, DMODEL, DMODEL, Wxq, DMODEL, DMODEL, MAP_ID, scr, r, lane, xa_pre_g); continue; } r -= I_SQ;
                if (r < I_SQ) { tr_item(xa_wo, DMODEL, DMODEL, Wxo, DMODEL, DMODEL, MAP_ID, scr, r, lane); continue; } r -= I_SQ;
                if (r < I_XKV) { if (PRO_XKV == 0) tr_item(xa_wkv, DMODEL, 2048, Wxkv, DMODEL, 2048, MAP_ID, scr, r, lane);
                    continue; } r -= I_XKV;
                if (r < I_UQ) { tr_item(mla_wuq, 192, 384, Wuq, 256, 512, MAP_UQ, scr, r, lane, mla_qg); continue; } r -= I_UQ;
                if (r < I_UKV) { tr_item(mla_wukv, 128, 512, Wukv, 128, 512, MAP_ID, scr, r, lane, mla_kvg); continue; } r -= I_UKV;
                if (r < I_PHI) { tr_item(nsa_w1, 2048, 256, Wphi, 2048, 256, MAP_ID, scr, r, lane); continue; } r -= I_PHI;
                if (r < I_PHI) { tr_item(nsa_w1 + 2048 * 256, 2048, 256, Wphi + 256 * 2048, 2048, 256, MAP_ID, scr, r, lane); continue; } r -= I_PHI;
                if (r < I_P2) { tr_item(nsa_w2, 256, 64, Wphi2, 256, 256, MAP_ID, scr, r, lane); continue; } r -= I_P2;
                if (r < I_P2) { tr_item(nsa_w2 + 256 * 64, 256, 64, Wphi2 + 256 * 256, 256, 256, MAP_ID, scr, r, lane); continue; } r -= I_P2;
                tr_item(s5_gluw, 256, 256, Wglu, 256, 256, MAP_ID, scr, r, lane);
            }
            if (PRO_XKV == 0) for (int it = gw; it < I_XKV; it += NGW) tr_item(KIN(35) + (size_t)(DMODEL * 2048), DMODEL, 2048, Wxkv1, DMODEL, 2048, MAP_ID, scr, it, lane);
            for (int it = gw; it < 512; it += NGW) phib_part(it, lane, nsa_pos, nsa_w1, PHIP);
#undef PRO_XKV
#undef PRO_SKIP_WD2
            } }
        }
        SEAM(pb + 20);
        }
    }
    {
        constexpr int L = 1;
        const int pb = L * NPH;
        if (L == 0) {
        if (IN(pb + 0)) for (int rep = 0; rep < REPS(0); ++rep) { PH_LOCALS;
#define PRO_SKIP_WD2 0
#define PRO_XKV 0
            {
                S5W W{s5_lre, s5_lim, s5_ldt, s5_bre, s5_bim, s5_cre, s5_cim, BTS5, FS5, A64};
                for (int rp = 0; rp < P0REP(1); ++rp) for (int u = vcu; u < 256; u += G) { const int g = u >> 4, q = u & 15; s5_item((LAS float*)(lds + RING_OFF), tid, g, 4 * q, q == 15 ? 64 : 4 * q + 3, W); }
                __syncthreads();
            }
            LAS float* scr = (LAS float*)(lds + RING_OFF + wave * 16384);
            constexpr int I_G = (DMODEL / 64) * (FFD / 32), I_D = (FFD / 64) * (DMODEL / 32), I_IN = (DMODEL / 64) * (NIN / 32), I_SQ = (DMODEL / 64) * (DMODEL / 32), I_XKV = (DMODEL / 64) * (2048 / 32);
            constexpr int I_UQ = (256 / 64) * (512 / 32), I_UKV = (128 / 64) * (512 / 32), I_PHI = (2048 / 64) * (256 / 32), I_GLU = (256 / 64) * (256 / 32);
            constexpr int I_P2 = (256 / 64) * (256 / 32);
            constexpr int NITEMS = 4 * I_G + 2 * I_D + I_IN + 3 * I_SQ + I_XKV + I_UQ + I_UKV + 2 * I_PHI + 2 * I_P2 + I_GLU;
            for (int rp = 0; rp < P0REP(2); ++rp) for (int it = gw; it < NITEMS; it += NGW) {
                int r = it;
                if (r < I_G) { tr_item(ffn1_wg, DMODEL, FFD, Wgu1, DMODEL, FFD, MAP_GATE, scr, r, lane, ffn1_pre_g); continue; } r -= I_G;
                if (r < I_G) { tr_item(ffn1_wu, DMODEL, FFD, Wgu1, DMODEL, FFD, MAP_UP, scr, r, lane, ffn1_pre_g); continue; } r -= I_G;
                if (r < I_G) { tr_item(ffn2_wg, DMODEL, FFD, Wgu2, DMODEL, FFD, MAP_GATE, scr, r, lane, ffn2_pre_g); continue; } r -= I_G;
                if (r < I_G) { tr_item(ffn2_wu, DMODEL, FFD, Wgu2, DMODEL, FFD, MAP_UP, scr, r, lane, ffn2_pre_g); continue; } r -= I_G;
                if (r < I_D) { tr_item(ffn1_wd, FFD, DMODEL, Wd1, FFD, DMODEL, MAP_ID, scr, r, lane); continue; } r -= I_D;
                if (r < I_D) { if (!PRO_SKIP_WD2) tr_item(ffn2_wd, FFD, DMODEL, Wd2, FFD, DMODEL, MAP_ID, scr, r, lane); continue; } r -= I_D;
                if (r < I_IN) { tr_item(mix_w_in, DMODEL, NIN_SRC, Win, DMODEL, NIN, MAP_WIN, scr, r, lane, mix_pre_g); continue; } r -= I_IN;
                if (r < I_SQ) { tr_item(mix_wout, DMODEL, DMODEL, Wout, DMODEL, DMODEL, MAP_ID, scr, r, lane); continue; } r -= I_SQ;
                if (r < I_SQ) { tr_item(xa_wq, DMODEL, DMODEL, Wxq, DMODEL, DMODEL, MAP_ID, scr, r, lane, xa_pre_g); continue; } r -= I_SQ;
                if (r < I_SQ) { tr_item(xa_wo, DMODEL, DMODEL, Wxo, DMODEL, DMODEL, MAP_ID, scr, r, lane); continue; } r -= I_SQ;
                if (r < I_XKV) { if (PRO_XKV == 0) tr_item(xa_wkv, DMODEL, 2048, Wxkv, DMODEL, 2048, MAP_ID, scr, r, lane);
                    continue; } r -= I_XKV;
                if (r < I_UQ) { tr_item(mla_wuq, 192, 384, Wuq, 256, 512, MAP_UQ, scr, r, lane, mla_qg); continue; } r -= I_UQ;
                if (r < I_UKV) { tr_item(mla_wukv, 128, 512, Wukv, 128, 512, MAP_ID, scr, r, lane, mla_kvg); continue; } r -= I_UKV;
                if (r < I_PHI) { tr_item(nsa_w1, 2048, 256, Wphi, 2048, 256, MAP_ID, scr, r, lane); continue; } r -= I_PHI;
                if (r < I_PHI) { tr_item(nsa_w1 + 2048 * 256, 2048, 256, Wphi + 256 * 2048, 2048, 256, MAP_ID, scr, r, lane); continue; } r -= I_PHI;
                if (r < I_P2) { tr_item(nsa_w2, 256, 64, Wphi2, 256, 256, MAP_ID, scr, r, lane); continue; } r -= I_P2;
                if (r < I_P2) { tr_item(nsa_w2 + 256 * 64, 256, 64, Wphi2 + 256 * 256, 256, 256, MAP_ID, scr, r, lane); continue; } r -= I_P2;
                tr_item(s5_gluw, 256, 256, Wglu, 256, 256, MAP_ID, scr, r, lane);
            }
            if (PRO_XKV == 0) for (int it = gw; it < I_XKV; it += NGW) tr_item(KIN(35) + (size_t)(DMODEL * 2048), DMODEL, 2048, Wxkv1, DMODEL, 2048, MAP_ID, scr, it, lane);
            for (int it = gw; it < 512; it += NGW) phib_part(it, lane, nsa_pos, nsa_w1, PHIP);
#undef PRO_XKV
#undef PRO_SKIP_WD2
            for (int i = bx * NTHR + tid; i < 2048 * 16; i += G * NTHR) rope_fill(ROPEM, 16, i);
            for (int i = bx * NTHR + tid; i < 2048 * 32; i += G * NTHR) rope_fill(ROPEN, 32, i);
            for (int rp = 0; rp < P0REP(3); ++rp) for (int m = gw; m < MTOK; m += 2 * NGW) { const int m2 = m + NGW;
                if (m2 < MTOK) xpass_rows2(lane, KIN(0) + (size_t)m * DMODEL, KIN(0) + (size_t)m2 * DMODEL, HB + (size_t)m * DMODEL, HB + (size_t)m2 * DMODEL, RSV + 4 * (size_t)m, RSV + 4 * (size_t)m2);
                else norm_row(lane, nullptr, nullptr, KIN(0) + (size_t)m * DMODEL, HB + (size_t)m * DMODEL, nullptr, nullptr, 0.f, RSV + 4 * (size_t)m); }
        }
        SEAM(pb + 0);
        }
        if (IN(pb + 1)) for (int rep = 0; rep < REPS(1); ++rep) { PH_LOCALS; pg8::Gemm g{HB, Wgu1, MTOK, 2 * FFD, DMODEL, DMODEL}; pg8::StaticOrder S; S.init(MTOK, 2 * FFD, G, bx); pg8::EpiSwiGLU E{ACT, FFD, RSV, XRN};
            GEMM_CALL(pg8::EpiSwiGLU, pg8::StaticOrder, g, S, E); }
        if (L > 0 && IN(pb + 1)) { PH_LOCALS; LAS float* scr = (LAS float*)(lds + RING_OFF + wave * 16384);
            for (int it = gw; it < (FFD / 64) * (DMODEL / 32); it += NGW) tr_item(ffn2_wd, FFD, DMODEL, Wd2, FFD, DMODEL, MAP_ID, scr, it, lane); }
        SEAM(pb + 1);
        if (IN(pb + 2)) { PH_LOCALS; pg8::Gemm g{ACT, Wd1, MTOK, DMODEL, FFD, FFD}; pg8::StaticOrder S; S.init(MTOK, DMODEL, G, bx); pg8::EpiNormRes E{HB, HB, nullptr, ffn1_post_g, 0.5f, SSYV, RSV, GRPCNT(0), XLN};
            GEMM_CALL(pg8::EpiNormRes, pg8::StaticOrder, g, S, E); }
        SEAM(pb + 3);
        if (IN(pb + 4)) for (int rep = 0; rep < REPS(4); ++rep) { PH_LOCALS; pg8::Gemm g{HB, Win, MTOK, NIN, DMODEL, DMODEL}; pg8::StaticOrder S; S.init(MTOK, NIN, G, bx);
            pg8::EpiWin E{PROJ, KCMP, VCMP, US5, LOGF, SSQ, SSKV, ROPEM, ROPEN, fox_fb, MTOK, RSV, XRN};
            GEMM_CALL(pg8::EpiWin, pg8::StaticOrder, g, S, E);
            for (int i = bx * NTHR + tid; i < 32 * 64; i += G * NTHR) { KCMP[(size_t)MTOK * 64 + i] = 0; VCMP[(size_t)MTOK * 64 + i] = 0; }
            for (int i = bx * NTHR + tid; i < 512; i += G * NTHR) phib_final(i, PHIP, nsa_b1, PHIB); }
        SEAM(pb + 4);
        if (IN(pb + 6)) for (int rep = 0; rep < REPS(6); ++rep) { PH_LOCALS;
            const int c0 = (G * 80) / 256, c1 = c0 + (G * 64) / 256, c2 = c1 + (G * 96) / 256, c3 = c2 + (G * 8) / 256;
            const int far = 1 << 28;
            if (SUB(0)) { pg8::Gemm g{PROJ + PC_CQ, Wuq, MTOK, 512, 256, NIN}; pg8::StaticOrder S; S.init(MTOK, 512, c0, bx < c0 ? bx : far); pg8::EpiRowScale<true> E{QM, 512, SSQ, 6, 1.f / 192.f, ROPEM}; GEMM_CALL(pg8::EpiRowScale<true>, pg8::StaticOrder, g, S, E); }
            if (SUB(1)) { pg8::Gemm g{PROJ + PC_CKV, Wukv, MTOK, 512, 128, NIN}; pg8::StaticOrder S; S.init(MTOK, 512, c1 - c0, (bx >= c0 && bx < c1) ? bx - c0 : far); pg8::EpiRowScale<false> E{KVM, 512, SSKV, 4, 1.f / 128.f, nullptr}; GEMM_CALL(pg8::EpiRowScale<false>, pg8::StaticOrder, g, S, E); }
            if (SUB(2)) { pg8::Gemm g{US5, BTS5, 16 * 512, 16 * 1280, 1024, 1024}; pg8::BatchOrder S; S.init(16, 2, 5, c2 - c1, (bx >= c1 && bx < c2) ? bx - c1 : far); pg8::EpiS5Loc E{S5OUT}; GEMM_CALL(pg8::EpiS5Loc, pg8::BatchOrder, g, S, E);
                asm volatile("s_waitcnt vmcnt(0)" ::: "memory"); __syncthreads();
                if (bx >= c1 && bx < c2) for (int L2 = bx - c1; L2 < 160; L2 += c2 - c1) { const int bt = L2 / 10, r = L2 % 10; if (r % 5 == 4) s5_carry_blk(tid, bt, r / 5, S5OUT, A64, XIN); } }
            if (SUB(3)) { pg8::Gemm g{KCMP, Wphi, 2048, 256, 2048, 1024}; pg8::StaticOrder S; S.init(2048, 256, c3 - c2, (bx >= c2 && bx < c3) ? bx - c2 : far); pg8::EpiGeluBias E{HIDK, 256, PHIB}; GEMM_CALL(pg8::EpiGeluBias, pg8::StaticOrder, g, S, E); }
            if (SUB(4)) { pg8::Gemm g{VCMP, Wphi + 256 * 2048, 2048, 256, 2048, 1024}; pg8::StaticOrder S; S.init(2048, 256, G - c3, bx >= c3 ? bx - c3 : far); pg8::EpiGeluBias E{HIDV, 256, PHIB + 256}; GEMM_CALL(pg8::EpiGeluBias, pg8::StaticOrder, g, S, E); }
            if (SUB(5)) for (int s = gw; s < 64; s += NGW) cumsum_seq(lane, LOGF + (size_t)s * SEQ, CUM + (size_t)s * SEQ);
        }
        SEAM(pb + 6);
        if (IN(pb + 8)) for (int rep = 0; rep < REPS(8); ++rep) { PH_LOCALS;
            { pg8::Gemm g{HIDK, Wphi2, 2048, 256, 256, 256}; pg8::StaticOrder S; S.init(2048, 256, G, (bx + 16) % G); pg8::EpiStoreN64 E{KC}; GEMM_CALL(pg8::EpiStoreN64, pg8::StaticOrder, g, S, E); }
            { pg8::Gemm g{HIDV, Wphi2 + 256 * 256, 2048, 256, 256, 256}; pg8::StaticOrder S; S.init(2048, 256, G, (bx + 8) % G); pg8::EpiStoreN64 E{VC}; GEMM_CALL(pg8::EpiStoreN64, pg8::StaticOrder, g, S, E); }
            if (SUB(0)) { pg8::Gemm g{XIN, FS5, 16 * 512, 16 * 1024, 128, 128}; pg8::BatchOrder S; S.init(16, 2, 4, G, bx); pg8::EpiS5Carry E{S5OUT, US5, s5_d, YS5, MTOK}; GEMM_CALL(pg8::EpiS5Carry, pg8::BatchOrder, g, S, E); }
            if (SUB(1)) for (int it = vcu; it < 256; it += G) { const int b = it >> 4, h = (it >> 2) & 3, pp = it & 3; const size_t rb = (size_t)b * SEQ;
                CausalArgs A{QM + rb * 512 + 96 * h, 512, KVM + rb * 512 + 128 * h, 512, PROJ + rb * NIN + PC_KPE, NIN, KVM + rb * 512 + 128 * h + 64, 512, nullptr, MIX + rb * 1024 + 64 * h, 1024, 0.10206207261596575f * LOG2E};
                causal_unit<96, false>(lds + RING_OFF, tid, pp, A); causal_unit<96, false>(lds + RING_OFF, tid, 7 - pp, A); }
            if (SUB(2)) for (int it = vcu; it < 256; it += G) { const int b = it >> 4, h = (it >> 2) & 3, pp = it & 3; const size_t rb = (size_t)b * SEQ;
                CausalArgs A{PROJ + rb * NIN + PC_FQ + 64 * h, NIN, PROJ + rb * NIN + PC_FK + 64 * h, NIN, nullptr, 0, PROJ + rb * NIN + PC_FV + 64 * h, NIN, CUM + ((size_t)b * 4 + h) * SEQ, MIX + rb * 1024 + 512 + 64 * h, 1024, 0.125f * LOG2E};
                causal_unit<64, true>(lds + RING_OFF, tid, pp, A); causal_unit<64, true>(lds + RING_OFF, tid, 7 - pp, A); }
            __syncthreads();
        }
        SEAM(pb + 8);
        if (IN(pb + 9)) for (int rep = 0; rep < REPS(9); ++rep) { PH_LOCALS;
            if (SUB(0)) { pg8::Gemm g{YS5, Wglu, MTOK, 256, 256, 256}; pg8::StaticOrder S; S.init(MTOK, 256, G, bx); pg8::EpiGLUNorm E{YS5, s5_glub, mix_gg + 768, MIX, 1024, 768, (PG8_LAS float*)(lds + XCH_OFF)}; GEMM_CALL(pg8::EpiGLUNorm, pg8::StaticOrder, g, S, E); }
            if (SUB(1)) for (int it = vcu; it < 512; it += G) { const int i2 = it & 255, b = i2 >> 4, T0 = (it < 256 ? (i2 & 15) : 31 - (i2 & 15)) * 64; const size_t rb = (size_t)b * SEQ;
                NsaArgs A{PROJ + rb * NIN, KC + (size_t)b * 128 * 64, VC + (size_t)b * 128 * 64, nsa_gb, MIX + rb * 1024 + 256, mix_gg, MIX + rb * 1024};
                nsa_unit(lds + RING_OFF, tid, T0, A); }
            __syncthreads();
        }
        SEAM(pb + 9);
        if (IN(pb + 11)) { PH_LOCALS; pg8::Gemm g{MIX, Wout, MTOK, DMODEL, DMODEL, DMODEL}; pg8::StaticOrder S; S.init(MTOK, DMODEL, G, bx); pg8::EpiNormRes E{HB, HB, nullptr, mix_post_g, 1.0f, SSYV, RSV, GRPCNT(1), XLN};
            GEMM_CALL(pg8::EpiNormRes, pg8::StaticOrder, g, S, E);
            if (L == 0) for (int m = gw; m < MROWS; m += NGW) { norm_only_row(lane, KIN(1) + (size_t)m * DMODEL, xa_mem_g, MEMN + (size_t)m * DMODEL);
                norm_only_row(lane, KIN(1) + (size_t)m * DMODEL, KIN(33) + (size_t)DMODEL, MEMN1 + (size_t)m * DMODEL); }
        }
        SEAM(pb + 12);
        if (IN(pb + 13)) for (int rep = 0; rep < REPS(13); ++rep) { PH_LOCALS;
            if (SUB(0)) { pg8::Gemm g{HB, Wxq, MTOK, DMODEL, DMODEL, DMODEL}; pg8::StaticOrder S; S.init(MTOK, DMODEL, G, bx); pg8::EpiStoreScaled E{XQ, DMODEL, RSV, 0.0625f * LOG2E, XRN}; GEMM_CALL(pg8::EpiStoreScaled, pg8::StaticOrder, g, S, E); }
            if (L == 0 && SUB(1)) { pg8::Gemm g{MEMN, Wxkv, MROWS, DMODEL, DMODEL, DMODEL}; pg8::StaticOrder S; S.init(MROWS, DMODEL, G, bx); pg8::EpiKH E{KH, MROWS}; GEMM_CALL(pg8::EpiKH, pg8::StaticOrder, g, S, E); }
            if (L == 0 && SUB(2)) { pg8::Gemm g{MEMN, Wxkv + (size_t)DMODEL * DMODEL, MROWS, DMODEL, DMODEL, DMODEL}; pg8::StaticOrder S; S.init(MROWS, DMODEL, G, (bx + 64) % G); pg8::EpiKH E{VT, MROWS}; GEMM_CALL(pg8::EpiKH, pg8::StaticOrder, g, S, E); }
        }
        if (L == 0 && IN(pb + 13)) { PH_LOCALS;
            { pg8::Gemm g{MEMN1, Wxkv1, MROWS, DMODEL, DMODEL, DMODEL}; pg8::StaticOrder S; S.init(MROWS, DMODEL, G, (bx + 192) % G); pg8::EpiKH E{KH1, MROWS}; GEMM_CALL(pg8::EpiKH, pg8::StaticOrder, g, S, E); }
            { pg8::Gemm g{MEMN1, Wxkv1 + (size_t)DMODEL * DMODEL, MROWS, DMODEL, DMODEL, DMODEL}; pg8::StaticOrder S; S.init(MROWS, DMODEL, G, (bx + 128) % G); pg8::EpiKH E{VT1, MROWS}; GEMM_CALL(pg8::EpiKH, pg8::StaticOrder, g, S, E); }
        }
        SEAM(pb + 13);
        if (IN(pb + 14)) for (int rep = 0; rep < REPS(14); ++rep) { PH_LOCALS; const int q4 = G / 4, far = 1 << 28;
#pragma unroll
            for (int h = 0; h < 4; ++h) { const int lo4 = h * q4, hi4 = (h == 3) ? G : lo4 + q4;
                pg8::Gemm g{XQ + 256 * h, KHL + (size_t)h * MROWS * 256, MTOK, MROWS, 256, DMODEL}; pg8::BatchOrder S; S.init(16, 8, 1, hi4 - lo4, (bx >= lo4 && bx < hi4) ? bx - lo4 : far);
                pg8::EpiSoftmaxP E{PX, DMODEL, 256 * h, (PG8_LAS float*)(lds + XCH_OFF)}; GEMM_CALL(pg8::EpiSoftmaxP, pg8::BatchOrder, g, S, E); }
#pragma unroll
            for (int h = 0; h < 4; ++h) { const int lo4 = h * q4, hi4 = (h == 3) ? G : lo4 + q4;
                pg8::Gemm g{Wxo + 256 * h, VTL + (size_t)h * MROWS * 256, DMODEL, MROWS, 256, DMODEL}; pg8::StaticOrder S; S.init(DMODEL, MROWS, hi4 - lo4, (bx >= lo4 && bx < hi4) ? bx - lo4 : far);
                pg8::EpiVWo E{VWO, h}; GEMM_CALL(pg8::EpiVWo, pg8::StaticOrder, g, S, E); }
        }
        SEAM(pb + 14);
        if (IN(pb + 15)) { PH_LOCALS;
            pg8::Gemm g{PX, VWO, MTOK, 16 * DMODEL, DMODEL, DMODEL}; pg8::BatchOrderCM S; S.init(16, 8, 4, G, bx); pg8::EpiNormRes E{HB, HB, nullptr, xa_post_g, 1.0f, SSYV, RSV, GRPCNT(2), XLN}; GEMM_CALL(pg8::EpiNormRes, pg8::BatchOrderCM, g, S, E); }
        SEAM(pb + 17);
        if (IN(pb + 18)) for (int rep = 0; rep < REPS(18); ++rep) { PH_LOCALS; pg8::Gemm g{HB, Wgu2, MTOK, 2 * FFD, DMODEL, DMODEL}; pg8::StaticOrder S; S.init(MTOK, 2 * FFD, G, bx); pg8::EpiSwiGLU E{ACT, FFD, RSV, XRN};
            GEMM_CALL(pg8::EpiSwiGLU, pg8::StaticOrder, g, S, E); }
        SEAM(pb + 18);
        if (IN(pb + 19)) { PH_LOCALS; pg8::Gemm g{ACT, Wd2, MTOK, DMODEL, FFD, FFD}; pg8::StaticOrder S; S.init(MTOK, DMODEL, G, bx);
            pg8::EpiNormRes E{HB, (L + 1 < DEPTH) ? HB : nullptr, (L + 1 < DEPTH) ? nullptr : H, ffn2_post_g, 0.5f, SSYV, (L + 1 < DEPTH) ? RSV : nullptr, GRPCNT(3), XLN};
            GEMM_CALL(pg8::EpiNormRes, pg8::StaticOrder, g, S, E); }
        if (L + 1 < DEPTH) {
        if (IN(pb + 20)) { PH_LOCALS;
            { constexpr int Lnext = L + 1; { constexpr int L = Lnext;
#define PRO_SKIP_WD2 1
#define PRO_XKV 1
            {
                S5W W{s5_lre, s5_lim, s5_ldt, s5_bre, s5_bim, s5_cre, s5_cim, BTS5, FS5, A64};
                for (int rp = 0; rp < P0REP(1); ++rp) for (int u = vcu; u < 256; u += G) { const int g = u >> 4, q = u & 15; s5_item((LAS float*)(lds + RING_OFF), tid, g, 4 * q, q == 15 ? 64 : 4 * q + 3, W); }
                __syncthreads();
            }
            LAS float* scr = (LAS float*)(lds + RING_OFF + wave * 16384);
            constexpr int I_G = (DMODEL / 64) * (FFD / 32), I_D = (FFD / 64) * (DMODEL / 32), I_IN = (DMODEL / 64) * (NIN / 32), I_SQ = (DMODEL / 64) * (DMODEL / 32), I_XKV = (DMODEL / 64) * (2048 / 32);
            constexpr int I_UQ = (256 / 64) * (512 / 32), I_UKV = (128 / 64) * (512 / 32), I_PHI = (2048 / 64) * (256 / 32), I_GLU = (256 / 64) * (256 / 32);
            constexpr int I_P2 = (256 / 64) * (256 / 32);
            constexpr int NITEMS = 4 * I_G + 2 * I_D + I_IN + 3 * I_SQ + I_XKV + I_UQ + I_UKV + 2 * I_PHI + 2 * I_P2 + I_GLU;
            for (int rp = 0; rp < P0REP(2); ++rp) for (int it = gw; it < NITEMS; it += NGW) {
                int r = it;
                if (r < I_G) { tr_item(ffn1_wg, DMODEL, FFD, Wgu1, DMODEL, FFD, MAP_GATE, scr, r, lane, ffn1_pre_g); continue; } r -= I_G;
                if (r < I_G) { tr_item(ffn1_wu, DMODEL, FFD, Wgu1, DMODEL, FFD, MAP_UP, scr, r, lane, ffn1_pre_g); continue; } r -= I_G;
                if (r < I_G) { tr_item(ffn2_wg, DMODEL, FFD, Wgu2, DMODEL, FFD, MAP_GATE, scr, r, lane, ffn2_pre_g); continue; } r -= I_G;
                if (r < I_G) { tr_item(ffn2_wu, DMODEL, FFD, Wgu2, DMODEL, FFD, MAP_UP, scr, r, lane, ffn2_pre_g); continue; } r -= I_G;
                if (r < I_D) { tr_item(ffn1_wd, FFD, DMODEL, Wd1, FFD, DMODEL, MAP_ID, scr, r, lane); continue; } r -= I_D;
                if (r < I_D) { if (!PRO_SKIP_WD2) tr_item(ffn2_wd, FFD, DMODEL, Wd2, FFD, DMODEL, MAP_ID, scr, r, lane); continue; } r -= I_D;
                if (r < I_IN) { tr_item(mix_w_in, DMODEL, NIN_SRC, Win, DMODEL, NIN, MAP_WIN, scr, r, lane, mix_pre_g); continue; } r -= I_IN;
                if (r < I_SQ) { tr_item(mix_wout, DMODEL, DMODEL, Wout, DMODEL, DMODEL, MAP_ID, scr, r, lane); continue; } r -= I_SQ;
                if (r < I_SQ) { tr_item(xa_wq, DMODEL, DMODEL, Wxq, DMODEL, DMODEL, MAP_ID, scr, r, lane, xa_pre_g); continue; } r -= I_SQ;
                if (r < I_SQ) { tr_item(xa_wo, DMODEL, DMODEL, Wxo, DMODEL, DMODEL, MAP_ID, scr, r, lane); continue; } r -= I_SQ;
                if (r < I_XKV) { if (PRO_XKV == 0) tr_item(xa_wkv, DMODEL, 2048, Wxkv, DMODEL, 2048, MAP_ID, scr, r, lane);
                    continue; } r -= I_XKV;
                if (r < I_UQ) { tr_item(mla_wuq, 192, 384, Wuq, 256, 512, MAP_UQ, scr, r, lane, mla_qg); continue; } r -= I_UQ;
                if (r < I_UKV) { tr_item(mla_wukv, 128, 512, Wukv, 128, 512, MAP_ID, scr, r, lane, mla_kvg); continue; } r -= I_UKV;
                if (r < I_PHI) { tr_item(nsa_w1, 2048, 256, Wphi, 2048, 256, MAP_ID, scr, r, lane); continue; } r -= I_PHI;
                if (r < I_PHI) { tr_item(nsa_w1 + 2048 * 256, 2048, 256, Wphi + 256 * 2048, 2048, 256, MAP_ID, scr, r, lane); continue; } r -= I_PHI;
                if (r < I_P2) { tr_item(nsa_w2, 256, 64, Wphi2, 256, 256, MAP_ID, scr, r, lane); continue; } r -= I_P2;
                if (r < I_P2) { tr_item(nsa_w2 + 256 * 64, 256, 64, Wphi2 + 256 * 256, 256, 256, MAP_ID, scr, r, lane); continue; } r -= I_P2;
                tr_item(s5_gluw, 256, 256, Wglu, 256, 256, MAP_ID, scr, r, lane);
            }
            if (PRO_XKV == 0) for (int it = gw; it < I_XKV; it += NGW) tr_item(KIN(35) + (size_t)(DMODEL * 2048), DMODEL, 2048, Wxkv1, DMODEL, 2048, MAP_ID, scr, it, lane);
            for (int it = gw; it < 512; it += NGW) phib_part(it, lane, nsa_pos, nsa_w1, PHIP);
#undef PRO_XKV
#undef PRO_SKIP_WD2
            } }
        }
        SEAM(pb + 20);
        }
    }
#undef IN
#undef SEAM
#undef GEMM_CALL
}

extern "C" void kernel_launch(void* const* d_in, const int* in_sizes, int n_in, void* d_out, int out_size, void* d_ws, size_t ws_size, hipStream_t stream) {
    static int grid = 0;
    if (grid == 0) {
        if (n_in != 43 || out_size != MTOK * DMODEL || ws_size < WS_END) { fprintf(stderr, "kernel_launch: unexpected problem (n_in %d, out %d, ws %zu)\n", n_in, out_size, ws_size); grid = -1; return; }
        int dev = 0, cus = 0, per_cu = 0;
        if (hipGetDevice(&dev) != hipSuccess || hipDeviceGetAttribute(&cus, hipDeviceAttributeMultiprocessorCount, dev) != hipSuccess) { grid = -1; return; }
        if (hipFuncSetAttribute((const void*)fwd_kernel, hipFuncAttributeMaxDynamicSharedMemorySize, LDS_BYTES) != hipSuccess) { fprintf(stderr, "kernel_launch: hipFuncSetAttribute failed\n"); grid = -1; return; }
        if (hipOccupancyMaxActiveBlocksPerMultiprocessor(&per_cu, (const void*)fwd_kernel, NTHR, LDS_BYTES) != hipSuccess || per_cu < 1) { fprintf(stderr, "kernel_launch: occupancy query says %d\n", per_cu); }
        (void)hipGetLastError();
        grid = cus;
    }
    if (grid < 0) return;
    (void)hipMemsetAsync((char*)d_ws + WS_CTL, 0, CTL_ZERO_BYTES, stream);
    Args a{};
    for (int i = 0; i < 43; ++i) a.in[i] = (const float*)d_in[i];
    a.out = (float*)d_out; a.ws = (unsigned char*)d_ws;
    const int stop = (MK_STOP_PHASE < NPHASES) ? MK_STOP_PHASE : NPHASES;
#if MK_ONE_LAUNCH
    a.ph_lo = 0; a.ph_hi = stop;
    hipLaunchKernelGGL(fwd_kernel, dim3(grid), dim3(NTHR), LDS_BYTES, stream, a);
#else
    for (int p = 0; p < stop; ++p) { a.ph_lo = p; a.ph_hi = p + 1; hipLaunchKernelGGL(fwd_kernel, dim3(grid), dim3(NTHR), LDS_BYTES, stream, a); }
#endif
}
```
